# Optimizing an MI355X kernel written in HIP

```python
import math
import jax, jax.numpy as jnp
from jax import lax
import numpy as np

D_MODEL = 1024
BATCH = 16
SEQ = 2048
DEPTH = 4

SB_HEADS = 4
SB_HD = 128
SB_W = SB_HEADS * SB_HD
SB_BLOCK = 128
GDN_HEADS = 4
GDN_HD = 128
GDN_W = GDN_HEADS * GDN_HD
GDN_CONV = 4
GDN_CHUNK = 64
GLA_HEADS = 4
GLA_KD = 128
GLA_VD = 256
GLA_KW = GLA_HEADS * GLA_KD
GLA_VW = GLA_HEADS * GLA_VD
GLA_RANK = 16
GLA_TAU = 16.0
GLA_CHUNK = 64
N_BRANCH = 3
RMS_EPS = 1e-6
L2_EPS = 1e-6

IN_SPLITS = (SB_W, SB_W, SB_W, SB_W,
             GDN_W, GDN_W, GDN_W, GDN_W, GDN_HEADS, GDN_HEADS,
             GLA_KW, GLA_KW, GLA_VW, GLA_VW, GLA_RANK,
             N_BRANCH * D_MODEL)
N_IN = sum(IN_SPLITS)

kernel_name = "hybrid_sb_gdn_gla_adaln"


def rms_norm(x, g):
    xf = x.astype(jnp.float32)
    y = xf * lax.rsqrt(jnp.mean(xf * xf, axis=-1, keepdims=True) + RMS_EPS)
    return (y * g.astype(jnp.float32)).astype(x.dtype)


def l2_norm(x):
    xf = x.astype(jnp.float32)
    return xf * lax.rsqrt(jnp.sum(xf * xf, axis=-1, keepdims=True) + L2_EPS)


def split_heads(t, n_heads):
    b, s, w = t.shape
    return t.reshape(b, s, n_heads, w // n_heads).transpose(0, 2, 1, 3)


def merge_heads(t):
    b, h, s, d = t.shape
    return t.transpose(0, 2, 1, 3).reshape(b, s, h * d)


def causal_depthwise_conv(x, w):
    kw = w.shape[0]
    return lax.conv_general_dilated(
        x, w[:, None, :].astype(x.dtype), window_strides=(1,), padding=[(kw - 1, 0)],
        dimension_numbers=('NWC', 'WIO', 'NWC'), feature_group_count=x.shape[-1])


def stick_breaking_attention(q, k, v):
    b, h, s, d = q.shape
    nb = s // SB_BLOCK
    scale = d ** -0.5
    key_pos = jnp.arange(s)
    qb = q.reshape(b, h, nb, SB_BLOCK, d).transpose(2, 0, 1, 3, 4)

    def block(args):
        q_blk, i = args
        z = jnp.einsum('bhqd,bhkd->bhqk', q_blk, k) * scale
        q_pos = i * SB_BLOCK + jnp.arange(SB_BLOCK)
        mask = key_pos[None, :] < q_pos[:, None]
        log_1m = jnp.where(mask, jax.nn.log_sigmoid(-z), 0.0)
        tail = lax.cumsum(log_1m, axis=3, reverse=True) - log_1m
        w = jnp.where(mask, jnp.exp(jax.nn.log_sigmoid(z) + tail), 0.0)
        return jnp.einsum('bhqk,bhkd->bhqd', w, v)

    out = lax.map(block, (qb, jnp.arange(nb)))
    return out.transpose(1, 2, 0, 3, 4).reshape(b, h, s, d)


def gated_delta_rule(q, k, v, beta, g):
    b, h, s, dk = q.shape
    dv = v.shape[-1]
    c = GDN_CHUNK
    n = s // c
    q, k, v = (t.reshape(b, h, n, c, t.shape[-1]) for t in (q, k, v))
    beta = beta.reshape(b, h, n, c)
    gam = jnp.cumsum(g.reshape(b, h, n, c), axis=-1)
    tri_incl = jnp.tril(jnp.ones((c, c), bool))
    tri_strict = jnp.tril(jnp.ones((c, c), bool), -1)
    diff = gam[..., :, None] - gam[..., None, :]
    decay = jnp.where(tri_incl, jnp.exp(jnp.where(tri_incl, diff, 0.0)), 0.0)
    a_mat = jnp.where(tri_strict,
                      beta[..., None] * jnp.einsum('bhnid,bhnjd->bhnij', k, k) * decay, 0.0)
    rhs = jnp.concatenate([v * beta[..., None], k * (beta * jnp.exp(gam))[..., None]], axis=-1)
    sol = lax.linalg.triangular_solve(a_mat, rhs, left_side=True, lower=True, unit_diagonal=True)
    u_base, w_kc = sol[..., :dv], sol[..., dv:]
    qk = jnp.einsum('bhnid,bhnjd->bhnij', q, k) * decay
    q_dec = q * jnp.exp(gam)[..., None]
    k_dec = k * jnp.exp(gam[..., -1:] - gam)[..., None]
    chunk_decay = jnp.exp(gam[..., -1])
    xs = tuple(jnp.moveaxis(t, 2, 0) for t in (u_base, w_kc, qk, q_dec, k_dec, chunk_decay))

    def step(state, inp):
        u_b, w_c, qk_c, qd, kd, cd = inp
        u = u_b - jnp.einsum('bhck,bhkv->bhcv', w_c, state)
        o = jnp.einsum('bhck,bhkv->bhcv', qd, state) + jnp.einsum('bhij,bhjv->bhiv', qk_c, u)
        state = state * cd[..., None, None] + jnp.einsum('bhck,bhcv->bhkv', kd, u)
        return state, o

    s0 = jnp.zeros((b, h, dk, dv), jnp.float32)
    _, o = lax.scan(step, s0, xs)
    return jnp.moveaxis(o, 0, 2).reshape(b, h, s, dv)


def gla_chunked(q, k, v, log_a):
    b, h, s, dk = q.shape
    dv = v.shape[-1]
    c = GLA_CHUNK
    n = s // c
    to_chunks = lambda t: jnp.moveaxis(t.reshape(b, h, n, c, t.shape[-1]), 2, 0)
    gam = jnp.cumsum(log_a.reshape(b, h, n, c, dk), axis=3)
    xs = (to_chunks(q), to_chunks(k), to_chunks(v), jnp.moveaxis(gam, 2, 0))
    tri = jnp.tril(jnp.ones((c, c), bool))

    def step(state, inp):
        qc, kc, vc, gc = inp
        diff = gc[:, :, :, None, :] - gc[:, :, None, :, :]
        pair = jnp.exp(jnp.where(tri[:, :, None], diff, -jnp.inf))
        att = jnp.einsum('bhid,bhjd,bhijd->bhij', qc, kc, pair)
        o = (jnp.einsum('bhik,bhkv->bhiv', qc * jnp.exp(gc), state)
             + jnp.einsum('bhij,bhjv->bhiv', att, vc))
        g_last = gc[:, :, -1:, :]
        state = (state * jnp.exp(g_last[:, :, 0, :, None])
                 + jnp.einsum('bhjk,bhjv->bhkv', kc * jnp.exp(g_last - gc), vc))
        return state, o

    s0 = jnp.zeros((b, h, dk, dv), jnp.float32)
    _, o = lax.scan(step, s0, xs)
    return jnp.moveaxis(o, 0, 2).reshape(b, h, s, dv)


def hybrid_layer(x, c_act, ada_w, ada_b, norm_g, w_in, sb_qnorm, sb_knorm, gdn_conv, gdn_a_log,
                 gdn_dt_bias, gdn_onorm, gla_w2, gla_b, gla_onorm, merge_b, proj_sb, proj_gdn,
                 proj_gla, w_out):
    f32 = jnp.float32
    shift, scale, gate = jnp.split(c_act @ ada_w + ada_b, 3, axis=-1)
    h = rms_norm(x, norm_g) * (1 + scale[:, None, :]) + shift[:, None, :]
    offsets = np.cumsum(IN_SPLITS)[:-1].tolist()
    (sq, sk, sv, sz, dq, dk_, dv_, dz, db, da,
     lq, lk, lv, lz, lr, mg) = jnp.split(h @ w_in, offsets, axis=-1)

    q = rms_norm(split_heads(sq, SB_HEADS), sb_qnorm).astype(f32)
    k = rms_norm(split_heads(sk, SB_HEADS), sb_knorm).astype(f32)
    o_sb = stick_breaking_attention(q, k, split_heads(sv, SB_HEADS).astype(f32))
    y_sb = merge_heads(o_sb).astype(x.dtype) * jax.nn.silu(sz)

    qkv = jax.nn.silu(causal_depthwise_conv(jnp.concatenate([dq, dk_, dv_], axis=-1), gdn_conv))
    gq, gk, gv = jnp.split(qkv, 3, axis=-1)
    gq = l2_norm(split_heads(gq, GDN_HEADS)) * (GDN_HD ** -0.5)
    gk = l2_norm(split_heads(gk, GDN_HEADS))
    beta = jax.nn.sigmoid(db.astype(f32)).transpose(0, 2, 1)
    g = (-jnp.exp(gdn_a_log.astype(f32))
         * jax.nn.softplus(da.astype(f32) + gdn_dt_bias.astype(f32))).transpose(0, 2, 1)
    o_gdn = gated_delta_rule(gq, gk, split_heads(gv, GDN_HEADS).astype(f32), beta, g)
    y_gdn = merge_heads(rms_norm(o_gdn, gdn_onorm)).astype(x.dtype) * jax.nn.silu(dz)

    log_a = jax.nn.log_sigmoid((lr @ gla_w2 + gla_b).astype(f32)) / GLA_TAU
    o_gla = gla_chunked(split_heads(lq, GLA_HEADS).astype(f32) * (GLA_KD ** -0.5),
                        split_heads(lk, GLA_HEADS).astype(f32),
                        split_heads(lv, GLA_HEADS).astype(f32),
                        split_heads(log_a, GLA_HEADS))
    y_gla = merge_heads(rms_norm(o_gla, gla_onorm)).astype(x.dtype) * jax.nn.silu(lz)

    g_sb, g_gdn, g_gla = jnp.split(jax.nn.sigmoid(mg + merge_b), 3, axis=-1)
    merged = g_sb * (y_sb @ proj_sb) + g_gdn * (y_gdn @ proj_gdn) + g_gla * (y_gla @ proj_gla)
    return x + gate[:, None, :] * (merged @ w_out)


def setup_inputs(seed: int = 0) -> dict:
    key = jax.random.key(seed)
    ks = jax.random.split(key, 24)
    L, D = DEPTH, D_MODEL
    nrm = lambda k, shape, s: jax.random.normal(k, shape, jnp.float32) * s
    dt = jnp.exp(jax.random.uniform(ks[10], (L, GDN_HEADS), jnp.float32,
                                    minval=math.log(1e-3), maxval=math.log(1e-1)))
    return {
        "x": nrm(ks[0], (BATCH, SEQ, D), 1.0),
        "c": nrm(ks[1], (BATCH, D), 1.0),
        "ada_w": nrm(ks[2], (L, D, 3 * D), 0.5 * D ** -0.5),
        "ada_b": nrm(ks[3], (L, 3 * D), 0.02),
        "norm_g": 1.0 + nrm(ks[4], (L, D), 0.02),
        "w_in": nrm(ks[5], (L, D, N_IN), D ** -0.5),
        "sb_qnorm": 1.0 + nrm(ks[6], (L, SB_HD), 0.02),
        "sb_knorm": 1.0 + nrm(ks[7], (L, SB_HD), 0.02),
        "gdn_conv": nrm(ks[8], (L, GDN_CONV, 3 * GDN_W), GDN_CONV ** -0.5),
        "gdn_a_log": jnp.log(jax.random.uniform(ks[9], (L, GDN_HEADS), jnp.float32,
                                                minval=1.0, maxval=16.0)),
        "gdn_dt_bias": dt + jnp.log(-jnp.expm1(-dt)),
        "gdn_onorm": 1.0 + nrm(ks[11], (L, GDN_HD), 0.02),
        "gla_w2": nrm(ks[12], (L, GLA_RANK, GLA_KW), GLA_RANK ** -0.5),
        "gla_b": nrm(ks[13], (L, GLA_KW), 0.1),
        "gla_onorm": 1.0 + nrm(ks[14], (L, GLA_VD), 0.02),
        "merge_b": nrm(ks[15], (L, N_BRANCH * D), 0.1),
        "proj_sb": nrm(ks[16], (L, SB_W, D), SB_W ** -0.5),
        "proj_gdn": nrm(ks[17], (L, GDN_W, D), GDN_W ** -0.5),
        "proj_gla": nrm(ks[18], (L, GLA_VW, D), GLA_VW ** -0.5),
        "w_out": nrm(ks[19], (L, D, D), D ** -0.5),
    }


def reference(x, c, ada_w, ada_b, norm_g, w_in, sb_qnorm, sb_knorm, gdn_conv, gdn_a_log,
              gdn_dt_bias, gdn_onorm, gla_w2, gla_b, gla_onorm, merge_b, proj_sb, proj_gdn,
              proj_gla, w_out):
    c_act = jax.nn.silu(c)
    for l in range(DEPTH):
        x = hybrid_layer(x, c_act, ada_w[l], ada_b[l], norm_g[l], w_in[l], sb_qnorm[l],
                         sb_knorm[l], gdn_conv[l], gdn_a_log[l], gdn_dt_bias[l], gdn_onorm[l],
                         gla_w2[l], gla_b[l], gla_onorm[l], merge_b[l], proj_sb[l], proj_gdn[l],
                         proj_gla[l], w_out[l])
    return x
```

```cpp
#include <hip/hip_runtime.h>
#include <cstdio>
#include <cstdint>

#define GAS __attribute__((address_space(1)))
#define LAS __attribute__((address_space(3)))

#define XB_TMO      128
#define XB_XCNT(j)  (256  + 64 * (j))
#define XB_XSUB(j)  (1280 + 64 * (j))
#define XB_XGEN(j)  (2304 + 64 * (j))
#define XB_TOP      3328
#define XB_TOPGEN   3392
#define XCD_BAR_WORDS 3456
#define XB_SPIN_CAP (1u << 24)

__device__ __forceinline__ unsigned xb_ld(unsigned* p)              { return __hip_atomic_load(p, __ATOMIC_RELAXED, __HIP_MEMORY_SCOPE_AGENT); }
__device__ __forceinline__ unsigned xb_add(unsigned* p, unsigned v) { return __hip_atomic_fetch_add(p, v, __ATOMIC_RELAXED, __HIP_MEMORY_SCOPE_AGENT); }
__device__ __forceinline__ unsigned xb_xcc_id() { return (unsigned)__builtin_amdgcn_s_getreg((3 << 11) | 20) & 0xFu; }
#define XB_SPIN(cond, bar) do { unsigned _sp = 0; while (cond) { __builtin_amdgcn_s_sleep(1); \
    if ((++_sp & 255u) == 0u) { if (xb_ld(&(bar)[XB_TMO])) break; if (_sp > XB_SPIN_CAP) { atomicAdd(&(bar)[XB_TMO], 1u); break; } } } } while (0)

struct XcdBarrier { unsigned* bar; unsigned x; volatile LAS unsigned* st; };

__device__ __forceinline__ XcdBarrier xcd_barrier_post(unsigned* bar, volatile LAS unsigned* st) {
    XcdBarrier b; b.bar = bar; b.x = xb_xcc_id(); b.st = st;
    if (threadIdx.x == 0) (void)xb_add(&bar[XB_XCNT(b.x)], 1u);
    return b;
}
__device__ __forceinline__ void xcd_barrier_complete(unsigned* bar, unsigned x, unsigned& nloc, unsigned& nx) {
    const unsigned G = gridDim.x * gridDim.y * gridDim.z;
    unsigned sum, cnt, mine, sp = 0u;
    for (;;) {
        sum = 0u; cnt = 0u; mine = 0u;
#pragma unroll
        for (unsigned j = 0; j < 16; ++j) { const unsigned c = xb_ld(&bar[XB_XCNT(j)]); sum += c; cnt += (c > 0u) ? 1u : 0u; mine = (j == x) ? c : mine; }
        if (sum == G) break;
        __builtin_amdgcn_s_sleep(1);
        if ((++sp & 255u) == 0u) { if (xb_ld(&bar[XB_TMO])) break; if (sp > XB_SPIN_CAP) { atomicAdd(&bar[XB_TMO], 1u); break; } }
    }
    nloc = mine > 0u ? mine : 1u; nx = cnt > 0u ? cnt : 1u;
}
__device__ __forceinline__ void xcd_barrier(const XcdBarrier& b) {
    asm volatile("s_waitcnt vmcnt(0)" ::: "memory");
    __syncthreads();
    if (threadIdx.x == 0) {
        unsigned* bar = b.bar;
        __builtin_amdgcn_s_waitcnt(0);
        unsigned nloc = b.st[0], nx = b.st[1];
        if (nloc == 0u) { xcd_barrier_complete(bar, b.x, nloc, nx); b.st[0] = nloc; b.st[1] = nx; }
        const unsigned old = xb_add(&bar[XB_XSUB(b.x)], 1u);
        const unsigned gen = old / nloc;
        if (old + 1u == (gen + 1u) * nloc) {
            __builtin_amdgcn_fence(__ATOMIC_RELEASE, "agent");
            asm volatile("s_waitcnt vmcnt(0)" ::: "memory");
            const unsigned og = xb_add(&bar[XB_TOP], 1u);
            const unsigned tg = og / nx;
            if (og + 1u == (tg + 1u) * nx) xb_add(&bar[XB_TOPGEN], 1u);
            else XB_SPIN(xb_ld(&bar[XB_TOPGEN]) == tg, bar);
            __builtin_amdgcn_fence(__ATOMIC_ACQUIRE, "agent");
            xb_add(&bar[XB_XGEN(b.x)], 1u);
            asm volatile("s_waitcnt vmcnt(0)" ::: "memory");
        } else {
            XB_SPIN(xb_ld(&bar[XB_XGEN(b.x)]) == gen, bar);
            __builtin_amdgcn_fence(__ATOMIC_ACQUIRE, "agent");
            asm volatile("s_waitcnt vmcnt(0)" ::: "memory");
        }
    }
    __syncthreads();
}
namespace pg8 {
#define PG8_LAS __attribute__((address_space(3)))
typedef unsigned short bf16_t;
typedef short bf16x8 __attribute__((ext_vector_type(8)));
typedef float f32x4 __attribute__((ext_vector_type(4)));
typedef unsigned u32x4 __attribute__((ext_vector_type(4)));
typedef unsigned u32x2 __attribute__((ext_vector_type(2)));
constexpr int BM = 256, BK = 64, HALF = 128, HTB = HALF * BK * 2, STAGE_BYTES = 8 * HTB, NXCD = 8, WGM = 8;

__host__ __device__ __forceinline__ int lds_byte(int r, int c) { const int st = (r >> 4) * 2 + (c >> 5), rr = r & 15, cc = c & 31, ob = rr * 64 + cc * 2; return st * 1024 + (ob ^ (((ob >> 9) & 1) << 5)); }
__host__ __device__ __forceinline__ void stage_rc(int b, int& R, int& C) { const int st = b / 1024, sb = b % 1024, swz = sb ^ (((sb >> 9) & 1) << 5); R = (st >> 1) * 16 + swz / 64; C = (st & 1) * 32 + (swz % 64) / 2; }
__host__ __device__ __forceinline__ int perm32(int rho) { const int n = rho >> 4, i = rho & 15; return 8 * (i >> 2) + 4 * n + (i & 3); }

struct Unit { int pm, pn; };
struct Gemm { const bf16_t* A; const bf16_t* Bt; int lda, ldb, K; };

struct StaticOrder {
    int nM, nN, nwg, G, c;
    __host__ __device__ void init(int M, int N, int G_, int c_) { nM = M / BM; nN = N / BM; nwg = nM * nN; G = G_; c = c_; }
    __host__ __device__ bool next(int i, Unit& u) const {
        const long L = (long)i * G + c; if (L >= nwg) return false;
        int wgid = (int)L; { const int q = nwg / NXCD, r = nwg % NXCD, xcd = wgid % NXCD, off = wgid / NXCD; wgid = (xcd < r ? xcd * (q + 1) : r * (q + 1) + (xcd - r) * q) + off; }
        const int nig = WGM * nN, gid = wgid / nig, fm = gid * WGM, gsz = (nM - fm) < WGM ? (nM - fm) : WGM;
        u.pm = fm + ((wgid % nig) % gsz); u.pn = (wgid % nig) / gsz; return true;
    }
    __device__ __forceinline__ void a_ready(const Unit&) const {}
    __device__ __forceinline__ void done(const Unit&) const {}
};

__device__ __forceinline__ unsigned cvt_pk_bf16(float lo, float hi) { unsigned r; asm volatile("v_cvt_pk_bf16_f32 %0, %1, %2" : "=v"(r) : "v"(lo), "v"(hi)); return r; }

template <class Epi, class Sched, bool ALIGN_EPI>
__device__ __forceinline__ void gemm_phase(PG8_LAS unsigned char* lds, const Gemm g, const Sched& S, const Epi& E) {
    int tid = threadIdx.x; asm volatile("" : "+v"(tid));
    const int wid = __builtin_amdgcn_readfirstlane(tid >> 6), lane = tid & 63, wr = wid >> 2, wc = wid & 3, fr = lane & 15, fq = lane >> 4;
    const int K = g.K, nt = K / BK;
    unsigned voffA[2], voffB[2];
#pragma unroll
    for (int i = 0; i < 2; ++i) { int R, C; stage_rc(tid * 16 + i * 8192, R, C); const int Rb = Epi::PERM ? ((R & ~31) + perm32(R & 31)) : R;
        voffA[i] = (unsigned)(R * g.lda + C) * 2u; voffB[i] = (unsigned)(Rb * g.ldb + C) * 2u; }
    const size_t kstep = (size_t)(BK * 2);
    const size_t hstepA = (size_t)HALF * g.lda * 2, hstepB = (size_t)HALF * g.ldb * 2;
    const size_t tstepA = 2 * hstepA, tstepB = 2 * hstepB;
    const unsigned ldsw = (unsigned)wid * 1024u;
    const int aoff = lds_byte(wr * 64 + fr, fq * 8), boff = lds_byte(wc * 32 + fr, fq * 8);
#define PG8_SA(b, h) (((b) * 2 + (h)) * HTB)
#define PG8_SB(b, h) ((4 + (b) * 2 + (h)) * HTB)
#define PG8_STAGE(bufoff, gbase, voff) do { _Pragma("unroll") for (int _i = 0; _i < 2; ++_i) \
        __builtin_amdgcn_global_load_lds((const unsigned*)((const char*)(gbase) + (voff)[_i]), (PG8_LAS unsigned*)(lds + (bufoff) + ldsw + _i * 8192), 16, 0, 0); } while (0)
#define PG8_LDA(dst, b, h) do { _Pragma("unroll") for (int m = 0; m < 4; ++m) _Pragma("unroll") for (int k = 0; k < 2; ++k) dst[m][k] = *(const PG8_LAS bf16x8*)(lds + PG8_SA(b, h) + aoff + m * 2048 + k * 1024); } while (0)
#define PG8_LDB(dst, b, h) do { _Pragma("unroll") for (int n = 0; n < 2; ++n) _Pragma("unroll") for (int k = 0; k < 2; ++k) dst[n][k] = *(const PG8_LAS bf16x8*)(lds + PG8_SB(b, h) + boff + n * 2048 + k * 1024); } while (0)
#define PG8_MMA(ai, bj, At, Bt) do { __builtin_amdgcn_s_setprio(1); _Pragma("unroll") for (int m = 0; m < 4; ++m) _Pragma("unroll") for (int n = 0; n < 2; ++n) _Pragma("unroll") for (int k = 0; k < 2; ++k) \
        acc[ai][bj][m][n] = __builtin_amdgcn_mfma_f32_16x16x32_bf16(Bt[n][k], At[m][k], acc[ai][bj][m][n], 0, 0, 0); __builtin_amdgcn_s_setprio(0); } while (0)
#define PG8_WAIT_V(n) asm volatile("s_waitcnt vmcnt(" #n ")" ::: "memory")
#define PG8_WAIT_L(n) asm volatile("s_waitcnt lgkmcnt(" #n ")" ::: "memory")
#define PG8_BAR __builtin_amdgcn_s_barrier()
#define PG8_SCHED __builtin_amdgcn_sched_barrier(0)
    Unit cur, nxt; int ui = 0;
    if (!S.next(0, cur)) return;
    f32x4 acc[2][2][4][2];
#pragma unroll
    for (int a = 0; a < 2; ++a)
#pragma unroll
        for (int b = 0; b < 2; ++b)
#pragma unroll
            for (int m = 0; m < 4; ++m)
#pragma unroll
                for (int n = 0; n < 2; ++n) acc[a][b][m][n] = (f32x4){0.f, 0.f, 0.f, 0.f};
    bf16x8 At[4][2], B0[2][2], B1[2][2];
    const char* cA = (const char*)g.A + (size_t)cur.pm * tstepA; const char* cB = (const char*)g.Bt + (size_t)cur.pn * tstepB;
    S.a_ready(cur);
    PG8_STAGE(PG8_SB(0, 0), cB, voffB); PG8_STAGE(PG8_SB(0, 1), cB + hstepB, voffB); PG8_STAGE(PG8_SA(0, 0), cA, voffA); PG8_STAGE(PG8_SA(0, 1), cA + hstepA, voffA);
    if (wr == 1) PG8_BAR;
    PG8_WAIT_V(2); PG8_BAR;
    PG8_STAGE(PG8_SB(1, 0), cB + kstep, voffB); PG8_STAGE(PG8_SA(1, 0), cA + kstep, voffA); PG8_STAGE(PG8_SB(1, 1), cB + hstepB + kstep, voffB);
    PG8_WAIT_V(6); PG8_BAR;
    for (;;) {
        const bool has_next = S.next(ui + 1, nxt);
        const char* nA = has_next ? (const char*)g.A + (size_t)nxt.pm * tstepA : cA; const char* nB = has_next ? (const char*)g.Bt + (size_t)nxt.pn * tstepB : cB;
        for (int t = 0; t < nt; t += 2) {
            const bool last = (t == nt - 2);
            const char* a1 = cA + (size_t)(t + 1) * kstep;
            const char* a2 = last ? nA : cA + (size_t)(t + 2) * kstep; const char* b2 = last ? nB : cB + (size_t)(t + 2) * kstep;
            const char* a3 = a2 + kstep; const char* b3 = b2 + kstep;
            if (last && has_next) S.a_ready(nxt);
            PG8_LDB(B0, 0, 0); PG8_LDB(B1, 0, 1); PG8_SCHED; PG8_LDA(At, 0, 0); PG8_STAGE(PG8_SA(1, 1), a1 + hstepA, voffA);
            PG8_WAIT_V(8); PG8_WAIT_L(0); PG8_BAR; PG8_MMA(0, 0, At, B0); PG8_MMA(0, 1, At, B1); PG8_BAR; PG8_SCHED;
            PG8_LDA(At, 0, 1); PG8_STAGE(PG8_SB(0, 0), b2, voffB); PG8_STAGE(PG8_SB(0, 1), b2 + hstepB, voffB); PG8_STAGE(PG8_SA(0, 0), a2, voffA);
            PG8_WAIT_V(8); PG8_WAIT_L(0); PG8_BAR; PG8_MMA(1, 0, At, B0); PG8_MMA(1, 1, At, B1); PG8_BAR; PG8_SCHED;
            PG8_LDB(B0, 1, 0); PG8_LDB(B1, 1, 1); PG8_SCHED; PG8_LDA(At, 1, 0); PG8_STAGE(PG8_SA(0, 1), a2 + hstepA, voffA);
            PG8_WAIT_V(8); PG8_WAIT_L(0); PG8_BAR; PG8_MMA(0, 0, At, B0); PG8_MMA(0, 1, At, B1); PG8_BAR; PG8_SCHED;
            PG8_LDA(At, 1, 1); PG8_STAGE(PG8_SB(1, 0), b3, voffB); PG8_STAGE(PG8_SB(1, 1), b3 + hstepB, voffB); PG8_STAGE(PG8_SA(1, 0), a3, voffA);
            PG8_WAIT_V(8); PG8_WAIT_L(0); PG8_BAR; PG8_MMA(1, 0, At, B0); PG8_MMA(1, 1, At, B1); PG8_BAR; PG8_SCHED;
        }
        if constexpr (ALIGN_EPI) { if (wr == 0) PG8_BAR; }
        E(acc, cur, wr, wc, fr, fq);
        if (!has_next) break;
#pragma unroll
        for (int a = 0; a < 2; ++a)
#pragma unroll
            for (int b = 0; b < 2; ++b)
#pragma unroll
                for (int m = 0; m < 4; ++m)
#pragma unroll
                    for (int n = 0; n < 2; ++n) acc[a][b][m][n] = (f32x4){0.f, 0.f, 0.f, 0.f};
        cur = nxt; cA = nA; cB = nB; ++ui;
        if constexpr (ALIGN_EPI) { if (wr == 1) PG8_BAR; }
    }
    PG8_WAIT_V(0);
    if constexpr (!ALIGN_EPI) { if (wr == 0) PG8_BAR; }
    PG8_BAR;
#undef PG8_SA
#undef PG8_SB
#undef PG8_STAGE
#undef PG8_LDA
#undef PG8_LDB
#undef PG8_MMA
#undef PG8_WAIT_V
#undef PG8_WAIT_L
#undef PG8_BAR
#undef PG8_SCHED
}
}
constexpr int D = 1024, BATCH = 16, SEQ = 2048, DEPTH = 4, T = BATCH * SEQ;
constexpr int NGRP = 2, TG = T / NGRP, BG = BATCH / NGRP;
constexpr int N_IN = 10264, NP = 10240, NWT = 10496;
constexpr int PC_SQ = 0, PC_SK = 512, PC_SV = 1024, PC_SZ = 1536, PC_DQ = 2048, PC_DZ = 3584, PC_LQ = 4096, PC_LK = 4608, PC_LV = 5120, PC_LZ = 6144, PC_MG = 7168;
constexpr int YC_SB = 0, YC_GDN = 512, YC_GLA = 1024, YW = 2048;
constexpr int NTHREADS = 512, NWAVES = 8;
constexpr float RMS_EPS = 1e-6f, L2_EPS = 1e-6f;

constexpr size_t MiB = 1u << 20;
constexpr size_t WS_CTL = 0, CTL_ZERO_BYTES = 1 * MiB;
constexpr size_t WS_MODP = 2 * MiB;
constexpr size_t WS_MOD = 8 * MiB;
constexpr size_t WS_WIN = 10 * MiB;
constexpr size_t WS_WP = 92 * MiB;
constexpr size_t WS_WO = 108 * MiB;
constexpr size_t WS_H = 116 * MiB;
constexpr size_t WS_MGB = 148 * MiB;
constexpr size_t WS_P = 180 * MiB;
constexpr size_t WS_PS = 500 * MiB;
constexpr size_t WS_Y = 502 * MiB;
constexpr size_t WS_MGF = 566 * MiB;
constexpr size_t WS_END = 630 * MiB;
constexpr int CW_BAR = 4096;

constexpr int RING_BYTES = 131072;
constexpr int MISC_OFF = RING_BYTES + 320;
constexpr int LDS_BYTES = 147456;

typedef unsigned short bf16;
typedef unsigned v4u __attribute__((ext_vector_type(4)));
typedef unsigned v2u __attribute__((ext_vector_type(2)));
typedef float f32x4 __attribute__((ext_vector_type(4)));
#define LDS_WAIT() asm volatile("s_waitcnt lgkmcnt(0)" ::: "memory")

__device__ __forceinline__ float bf2f(unsigned v) { return __uint_as_float(v << 16); }
__device__ __forceinline__ float bflo(unsigned w) { return __uint_as_float(w << 16); }
__device__ __forceinline__ float bfhi(unsigned w) { return __uint_as_float(w & 0xffff0000u); }
__device__ __forceinline__ unsigned f2bf(float f) { unsigned u = __float_as_uint(f); return (u + 0x7fffu + ((u >> 16) & 1u)) >> 16; }
__device__ __forceinline__ unsigned pk2(float lo, float hi) { return f2bf(lo) | (f2bf(hi) << 16); }
__device__ __forceinline__ float sigmoidf_(float x) { return 1.f / (1.f + __expf(-x)); }
__device__ __forceinline__ float siluf_(float x) { return x / (1.f + __expf(-x)); }
__device__ __forceinline__ float softplusf_(float x) { return fmaxf(x, 0.f) + log1pf(expf(-fabsf(x))); }
__device__ __forceinline__ float logsigf_(float x) { return fminf(x, 0.f) - log1pf(expf(-fabsf(x))); }

__device__ __forceinline__ int opq(int v) { asm volatile("" : "+v"(v)); return v; }
struct Args {
    const float* in[20];
    float* out; unsigned char* ws;
    int ph_lo, ph_hi;
};
struct Frame {
    LAS unsigned char* lds;
    int tid, lane, wave, G;
    const float *x, *c, *ada_w, *ada_b, *norm_g, *w_in, *sb_qnorm, *sb_knorm, *gdn_conv, *gdn_a_log, *gdn_dt_bias, *gdn_onorm, *gla_w2, *gla_b, *gla_onorm, *merge_b, *proj_sb, *proj_gdn, *proj_gla, *w_out;
    float* out;
    float *MODP, *MODA, *MODB, *MODG, *PS, *MGF;
    bf16 *WIN, *WP, *WO, *H, *MGB, *P, *Y, *GQKV;
};

struct EpiG1 {
    static constexpr bool PERM = true;
    bf16* P; float* PS; const float* mb;
    __device__ __forceinline__ void operator()(const pg8::f32x4 (&acc)[2][2][4][2], const pg8::Unit& u, int wr, int wc, int fr, int fq) const {
        const int row0 = u.pm * 256 + wr * 64 + fr, pn = u.pn;
        if (pn < 40) {
            const int mode = (pn == 6 || pn == 7 || pn == 14 || pn == 15 || (pn >= 24 && pn < 28)) ? 1 : (pn >= 28 ? 2 : 0);
            const int col0 = pn * 256 + wc * 32 + 8 * fq;
            pg8::f32x4 bv[2][2];
#pragma unroll
            for (int bj = 0; bj < 2; ++bj)
#pragma unroll
                for (int n = 0; n < 2; ++n) bv[bj][n] = (mode == 2) ? *(const pg8::f32x4*)(mb + (col0 - PC_MG) + bj * 128 + 4 * n) : (pg8::f32x4){0.f, 0.f, 0.f, 0.f};
#pragma unroll
            for (int ai = 0; ai < 2; ++ai)
#pragma unroll
                for (int m = 0; m < 4; ++m) { bf16* rowp = P + (size_t)(row0 + ai * 128 + m * 16) * NP + col0;
#pragma unroll
                    for (int bj = 0; bj < 2; ++bj) { pg8::f32x4 v0 = acc[ai][bj][m][0], v1 = acc[ai][bj][m][1];
                        if (mode == 1) {
#pragma unroll
                            for (int j = 0; j < 4; ++j) { v0[j] = siluf_(v0[j]); v1[j] = siluf_(v1[j]); } }
                        else if (mode == 2) { v0 = v0 + bv[bj][0]; v1 = v1 + bv[bj][1];
#pragma unroll
                            for (int j = 0; j < 4; ++j) { v0[j] = sigmoidf_(v0[j]); v1[j] = sigmoidf_(v1[j]); } }
                        pg8::u32x4 w; w.x = pg8::cvt_pk_bf16(v0[0], v0[1]); w.y = pg8::cvt_pk_bf16(v0[2], v0[3]); w.z = pg8::cvt_pk_bf16(v1[0], v1[1]); w.w = pg8::cvt_pk_bf16(v1[2], v1[3]);
                        *(pg8::u32x4*)(rowp + bj * 128) = w; } }
        } else if (wc == 0 && fq < 3) {
#pragma unroll
            for (int ai = 0; ai < 2; ++ai)
#pragma unroll
                for (int m = 0; m < 4; ++m) { float* rowp = PS + (size_t)(row0 + ai * 128 + m * 16) * 32 + 8 * fq;
                    *(pg8::f32x4*)(rowp) = acc[ai][0][m][0]; *(pg8::f32x4*)(rowp + 4) = acc[ai][0][m][1]; }
        }
    }
};
template <int MODE> struct EpiG2 {
    static constexpr bool PERM = false;
    const bf16* P; int gcol0; float* MGF; bf16* MGB;
    __device__ __forceinline__ void operator()(const pg8::f32x4 (&acc)[2][2][4][2], const pg8::Unit& u, int wr, int wc, int fr, int fq) const {
        const int row0 = u.pm * 256 + wr * 64 + fr, col0 = u.pn * 256 + wc * 32 + 4 * fq;
#pragma unroll
        for (int ai = 0; ai < 2; ++ai)
#pragma unroll
            for (int m = 0; m < 4; ++m) { const size_t r = (size_t)(row0 + ai * 128 + m * 16);
#pragma unroll
                for (int bj = 0; bj < 2; ++bj)
#pragma unroll
                    for (int n = 0; n < 2; ++n) { const int c = col0 + bj * 128 + n * 16;
                        const pg8::u32x2 gw = *(const pg8::u32x2*)(P + r * NP + gcol0 + c);
                        pg8::f32x4 v = acc[ai][bj][m][n];
                        v[0] *= bflo(gw.x); v[1] *= bfhi(gw.x); v[2] *= bflo(gw.y); v[3] *= bfhi(gw.y);
                        float* mp = MGF + r * D + c;
                        if (MODE == 0) *(pg8::f32x4*)mp = v;
                        else if (MODE == 1) *(pg8::f32x4*)mp = *(const pg8::f32x4*)mp + v;
                        else { v = v + *(const pg8::f32x4*)mp; pg8::u32x2 w; w.x = pg8::cvt_pk_bf16(v[0], v[1]); w.y = pg8::cvt_pk_bf16(v[2], v[3]); *(pg8::u32x2*)(MGB + r * D + c) = w; } } }
    }
};
struct EpiG3 {
    static constexpr bool PERM = false;
    const float* xin; float* out; const float* gate; int grow0;
    __device__ __forceinline__ void operator()(const pg8::f32x4 (&acc)[2][2][4][2], const pg8::Unit& u, int wr, int wc, int fr, int fq) const {
        const int row0 = grow0 + u.pm * 256 + wr * 64 + fr, col0 = u.pn * 256 + wc * 32 + 4 * fq;
        const float* gp = gate + (size_t)((grow0 + u.pm * 256) / SEQ) * D;
        pg8::f32x4 gv[2][2];
#pragma unroll
        for (int bj = 0; bj < 2; ++bj)
#pragma unroll
            for (int n = 0; n < 2; ++n) gv[bj][n] = *(const pg8::f32x4*)(gp + col0 + bj * 128 + n * 16);
#pragma unroll
        for (int ai = 0; ai < 2; ++ai)
#pragma unroll
            for (int m = 0; m < 4; ++m) { const size_t off = (size_t)(row0 + ai * 128 + m * 16) * D + col0;
#pragma unroll
                for (int bj = 0; bj < 2; ++bj)
#pragma unroll
                    for (int n = 0; n < 2; ++n) { const pg8::f32x4 xv = *(const pg8::f32x4*)(xin + off + bj * 128 + n * 16);
                        *(pg8::f32x4*)(out + off + bj * 128 + n * 16) = xv + gv[bj][n] * acc[ai][bj][m][n]; } }
    }
};

__device__ __forceinline__ void transpose_item(const float* W, int ldw, int col0, bf16* WT, int ldd, int drow0, int dk0, int nblk, LAS float* scr, int item, int lane) {
    const int kb = item / nblk, nb = item % nblk, k0 = 64 * kb, n0 = 32 * nb;
#pragma unroll 8
    for (int i = 0; i < 32; ++i) { const int kk = 2 * i + (lane >> 5); scr[kk * 33 + (lane & 31)] = W[(size_t)(k0 + kk) * ldw + col0 + n0 + (lane & 31)]; }
    LDS_WAIT(); asm volatile("" ::: "memory");
    const int c = lane & 7;
#pragma unroll
    for (int j = 0; j < 4; ++j) { const int n = (lane >> 3) + 8 * j; const LAS float* s = scr + (8 * c) * 33 + n;
        v4u o; o.x = pk2(s[0 * 33], s[1 * 33]); o.y = pk2(s[2 * 33], s[3 * 33]); o.z = pk2(s[4 * 33], s[5 * 33]); o.w = pk2(s[6 * 33], s[7 * 33]);
        *(v4u*)(WT + (size_t)(drow0 + n0 + n) * ldd + dk0 + k0 + 8 * c) = o; }
    LDS_WAIT(); asm volatile("" ::: "memory");
}
__device__ __forceinline__ void p0_prologue(Frame& F) {
    LAS float* cact = (LAS float*)F.lds;
    for (int i = F.tid; i < BATCH * D; i += NTHREADS) cact[i] = siluf_(F.c[i]);
    __syncthreads();
    for (int it = blockIdx.x; it < 4 * 8 * 6; it += F.G) {
        const int l = it / 48, ks = (it % 48) / 6, jc = it % 6, j = jc * 512 + F.tid;
        float a[16];
#pragma unroll
        for (int b = 0; b < 16; ++b) a[b] = 0.f;
        const float* wp = F.ada_w + ((size_t)l * D + ks * 128) * 3072 + j;
#pragma unroll 4
        for (int k = 0; k < 128; ++k) { const float w = wp[(size_t)k * 3072];
#pragma unroll
            for (int b = 0; b < 16; ++b) a[b] += cact[b * D + ks * 128 + k] * w; }
#pragma unroll
        for (int b = 0; b < 16; ++b) F.MODP[((size_t)(ks * 4 + l) * 16 + b) * 3072 + j] = a[b];
    }
    __syncthreads();
    LAS float* scr = (LAS float*)(F.lds + F.wave * 16384);
    const int gw = blockIdx.x * NWAVES + F.wave, NGW = F.G * NWAVES;
    constexpr int I_A = 16 * 128, I_B = 16 * 96, I_C = 16 * 96, I_SB = 8 * 32, I_GDN = 8 * 32, I_GLA = 16 * 32, I_WO = 16 * 32;
    constexpr int I_L = I_A + I_B + I_C + I_SB + I_GDN + I_GLA + I_WO;
    for (int it = gw; it < DEPTH * I_L; it += NGW) {
        const int l = it / I_L; int r = it % I_L;
        const float* win = F.w_in + (size_t)l * D * N_IN; bf16* wint = F.WIN + (size_t)l * NWT * D;
        bf16* wpt = F.WP + (size_t)l * D * 2048; bf16* wot = F.WO + (size_t)l * D * D;
        if (r < I_A) { transpose_item(win, N_IN, 0, wint, D, 0, 0, 128, scr, r, F.lane); continue; } r -= I_A;
        if (r < I_B) { transpose_item(win, N_IN, 4104, wint, D, 4096, 0, 96, scr, r, F.lane); continue; } r -= I_B;
        if (r < I_C) { transpose_item(win, N_IN, 7192, wint, D, 7168, 0, 96, scr, r, F.lane); continue; } r -= I_C;
        if (r < I_SB) { transpose_item(F.proj_sb + (size_t)l * 512 * D, D, 0, wpt, 2048, 0, 0, 32, scr, r, F.lane); continue; } r -= I_SB;
        if (r < I_GDN) { transpose_item(F.proj_gdn + (size_t)l * 512 * D, D, 0, wpt, 2048, 0, 512, 32, scr, r, F.lane); continue; } r -= I_GDN;
        if (r < I_GLA) { transpose_item(F.proj_gla + (size_t)l * D * D, D, 0, wpt, 2048, 0, 1024, 32, scr, r, F.lane); continue; } r -= I_GLA;
        transpose_item(F.w_out + (size_t)l * D * D, D, 0, wot, D, 0, 0, 32, scr, r, F.lane);
    }
    for (size_t i = (size_t)blockIdx.x * NTHREADS + F.tid; i < (size_t)DEPTH * 256 * D; i += (size_t)F.G * NTHREADS) {
        const int l = (int)(i / (256 * D)), r = (int)((i / D) % 256), k = (int)(i % D);
        float v = 0.f;
        if (r < 8) v = F.w_in[((size_t)l * D + k) * N_IN + 4096 + r];
        else if (r < 24) v = F.w_in[((size_t)l * D + k) * N_IN + 7176 + (r - 8)];
        F.WIN[((size_t)l * NWT + 10240 + r) * D + k] = (bf16)f2bf(v);
    }
}
__device__ __forceinline__ void p1_mod(Frame& F) {
    for (int i = blockIdx.x * NTHREADS + F.tid; i < DEPTH * BATCH * D; i += F.G * NTHREADS) {
        const int l = i / (BATCH * D), b = (i / D) % BATCH, c = i % D;
        float sh = F.ada_b[l * 3072 + c], sc = F.ada_b[l * 3072 + D + c], gt = F.ada_b[l * 3072 + 2 * D + c];
#pragma unroll
        for (int ks = 0; ks < 8; ++ks) { const float* p = F.MODP + ((size_t)(ks * 4 + l) * 16 + b) * 3072; sh += p[c]; sc += p[D + c]; gt += p[2 * D + c]; }
        F.MODA[i] = F.norm_g[l * D + c] * (1.f + sc); F.MODB[i] = sh; F.MODG[i] = gt;
    }
}
__device__ __forceinline__ float wave_sum(float v) {
#pragma unroll
    for (int o = 1; o < 64; o <<= 1) v += __shfl_xor(v, o);
    return v;
}
__device__ __forceinline__ void phase_norm(Frame& F, const float* xin, int l, int g) {
    const int gw = blockIdx.x * NWAVES + F.wave, NGW = F.G * NWAVES, lane = opq(F.lane);
    for (int m = gw; m < TG; m += NGW) {
        const int grow = g * TG + m, b = grow / SEQ;
        const f32x4* xr = (const f32x4*)(xin + (size_t)grow * D) + lane;
        const f32x4* ma = (const f32x4*)(F.MODA + (size_t)(l * BATCH + b) * D) + lane;
        const f32x4* mb = (const f32x4*)(F.MODB + (size_t)(l * BATCH + b) * D) + lane;
        f32x4 v[4]; float s = 0.f;
#pragma unroll
        for (int j = 0; j < 4; ++j) { v[j] = xr[64 * j]; s += (v[j].x * v[j].x + v[j].y * v[j].y) + (v[j].z * v[j].z + v[j].w * v[j].w); }
        const float rstd = 1.f / sqrtf(wave_sum(s) * (1.f / D) + RMS_EPS);
        unsigned long long* o8 = (unsigned long long*)(F.H + (size_t)m * D) + lane;
#pragma unroll
        for (int j = 0; j < 4; ++j) { const f32x4 a = ma[64 * j], sh = mb[64 * j]; const f32x4 y = v[j] * rstd * a + sh;
            o8[64 * j] = (unsigned long long)pk2(y.x, y.y) | ((unsigned long long)pk2(y.z, y.w) << 32); }
    }
}
__device__ __forceinline__ void phase_prep(Frame& F, int l) {
    const int gw = blockIdx.x * NWAVES + F.wave, NGW = F.G * NWAVES, lane = opq(F.lane);
    for (int m = gw; m < TG; m += NGW) {
        {
            bf16* p = F.P + (size_t)m * NP + lane * 16;
            const v4u w0 = *(const v4u*)p, w1 = *(const v4u*)(p + 8);
            float x[16];
            x[0] = bflo(w0.x); x[1] = bfhi(w0.x); x[2] = bflo(w0.y); x[3] = bfhi(w0.y); x[4] = bflo(w0.z); x[5] = bfhi(w0.z); x[6] = bflo(w0.w); x[7] = bfhi(w0.w);
            x[8] = bflo(w1.x); x[9] = bfhi(w1.x); x[10] = bflo(w1.y); x[11] = bfhi(w1.y); x[12] = bflo(w1.z); x[13] = bfhi(w1.z); x[14] = bflo(w1.w); x[15] = bfhi(w1.w);
            float ss = 0.f;
#pragma unroll
            for (int i = 0; i < 16; ++i) ss += x[i] * x[i];
            ss += __shfl_xor(ss, 1); ss += __shfl_xor(ss, 2); ss += __shfl_xor(ss, 4);
            const float r = 1.f / sqrtf(ss * (1.f / 128.f) + RMS_EPS);
            const float* gn = (lane < 32 ? F.sb_qnorm : F.sb_knorm) + l * 128 + (lane & 7) * 16;
#pragma unroll
            for (int i = 0; i < 16; ++i) x[i] = x[i] * r * gn[i];
            v4u o0, o1;
            o0.x = pk2(x[0], x[1]); o0.y = pk2(x[2], x[3]); o0.z = pk2(x[4], x[5]); o0.w = pk2(x[6], x[7]);
            o1.x = pk2(x[8], x[9]); o1.y = pk2(x[10], x[11]); o1.z = pk2(x[12], x[13]); o1.w = pk2(x[14], x[15]);
            *(v4u*)p = o0; *(v4u*)(p + 8) = o1;
        }
        const int pos = m % SEQ;
#pragma unroll
        for (int ps = 0; ps < 3; ++ps) {
            const int ch = ps * 512 + lane * 8;
            float y[8];
#pragma unroll
            for (int i = 0; i < 8; ++i) y[i] = 0.f;
#pragma unroll
            for (int tap = 0; tap < 4; ++tap) {
                const int dt = tap - 3;
                if (pos + dt >= 0) {
                    const v4u w = *(const v4u*)(F.P + (size_t)(m + dt) * NP + PC_DQ + ch);
                    const float* cw = F.gdn_conv + ((size_t)l * 4 + tap) * 1536 + ch;
                    y[0] += cw[0] * bflo(w.x); y[1] += cw[1] * bfhi(w.x); y[2] += cw[2] * bflo(w.y); y[3] += cw[3] * bfhi(w.y);
                    y[4] += cw[4] * bflo(w.z); y[5] += cw[5] * bfhi(w.z); y[6] += cw[6] * bflo(w.w); y[7] += cw[7] * bfhi(w.w);
                }
            }
            float ss = 0.f;
#pragma unroll
            for (int i = 0; i < 8; ++i) { y[i] = siluf_(y[i]); ss += y[i] * y[i]; }
            if (ps < 2) {
                ss += __shfl_xor(ss, 1); ss += __shfl_xor(ss, 2); ss += __shfl_xor(ss, 4); ss += __shfl_xor(ss, 8);
                float r = 1.f / sqrtf(ss + L2_EPS); if (ps == 0) r *= 0.08838834764831845f;
#pragma unroll
                for (int i = 0; i < 8; ++i) y[i] *= r;
            }
            v4u o; o.x = pk2(y[0], y[1]); o.y = pk2(y[2], y[3]); o.z = pk2(y[4], y[5]); o.w = pk2(y[6], y[7]);
            *(v4u*)(F.GQKV + (size_t)m * 1536 + ch) = o;
        }
    }
}
__device__ __forceinline__ void gdn_chain_naive(Frame& F, int l, int bh) {
    const int bl = bh >> 2, h = bh & 3, tid = opq(F.tid), v = tid & 127, kq = tid >> 7;
    LAS float* qv = (LAS float*)F.lds; LAS float* kv = qv + 128; LAS float* vv = kv + 128; LAS float* sc = vv + 128; LAS float* red = sc + 128; LAS float* red2 = red + 512;
    float s[32];
#pragma unroll
    for (int i = 0; i < 32; ++i) s[i] = 0.f;
    const float Aexp = expf(F.gdn_a_log[l * 4 + h]), dtb = F.gdn_dt_bias[l * 4 + h];
    for (int t = 0; t < SEQ; ++t) {
        const size_t row = (size_t)bl * SEQ + t;
        if (tid < 128) { const bf16* gp = F.GQKV + row * 1536 + h * 128 + tid; qv[tid] = bf2f(gp[0]); kv[tid] = bf2f(gp[512]); vv[tid] = bf2f(gp[1024]); }
        if (tid == 128) { const float db = F.PS[row * 32 + h], da = F.PS[row * 32 + 4 + h]; sc[0] = sigmoidf_(db); sc[1] = expf(-Aexp * softplusf_(da + dtb)); }
        __syncthreads();
        const float eg = sc[1]; float part = 0.f;
#pragma unroll
        for (int i = 0; i < 32; ++i) { s[i] *= eg; part += kv[kq * 32 + i] * s[i]; }
        red[kq * 128 + v] = part;
        __syncthreads();
        const float kS = (red[v] + red[128 + v]) + (red[256 + v] + red[384 + v]);
        const float delta = sc[0] * (vv[v] - kS); float part2 = 0.f;
#pragma unroll
        for (int i = 0; i < 32; ++i) { s[i] += kv[kq * 32 + i] * delta; part2 += qv[kq * 32 + i] * s[i]; }
        red2[kq * 128 + v] = part2;
        __syncthreads();
        if (tid < 128) { const float o = (red2[tid] + red2[128 + tid]) + (red2[256 + tid] + red2[384 + tid]); F.Y[row * YW + YC_GDN + h * 128 + tid] = (bf16)f2bf(o); }
    }
}
__device__ __forceinline__ void gla_chain_naive(Frame& F, int l, int bh) {
    const int bl = bh >> 2, h = bh & 3, tid = opq(F.tid), v = tid & 255, kh = tid >> 8;
    LAS float* qv = (LAS float*)F.lds; LAS float* kv = qv + 128; LAS float* ea = kv + 128; LAS float* vv = ea + 128; LAS float* red = vv + 256;
    float s[64];
#pragma unroll
    for (int i = 0; i < 64; ++i) s[i] = 0.f;
    float w2r[16]; float bb = 0.f;
    if (tid < 128) { bb = F.gla_b[l * 512 + h * 128 + tid];
#pragma unroll
        for (int r = 0; r < 16; ++r) w2r[r] = F.gla_w2[((size_t)l * 16 + r) * 512 + h * 128 + tid]; }
    else {
#pragma unroll
        for (int r = 0; r < 16; ++r) w2r[r] = 0.f; }
    for (int t = 0; t < SEQ; ++t) {
        const size_t row = (size_t)bl * SEQ + t;
        if (tid < 128) {
            const bf16* pp = F.P + row * NP + h * 128 + tid;
            qv[tid] = bf2f(pp[PC_LQ]) * 0.08838834764831845f; kv[tid] = bf2f(pp[PC_LK]);
            float xg = bb;
#pragma unroll
            for (int r = 0; r < 16; ++r) xg += F.PS[row * 32 + 8 + r] * w2r[r];
            ea[tid] = expf(logsigf_(xg) * (1.f / 16.f));
        } else if (tid >= 256) { vv[tid - 256] = bf2f(F.P[row * NP + PC_LV + h * 256 + (tid - 256)]); }
        __syncthreads();
        const float vvv = vv[v]; float part = 0.f;
#pragma unroll
        for (int i = 0; i < 64; ++i) { const int k = kh * 64 + i; s[i] = ea[k] * s[i] + kv[k] * vvv; part += qv[k] * s[i]; }
        red[kh * 256 + v] = part;
        __syncthreads();
        if (tid < 256) F.Y[row * YW + YC_GLA + h * 256 + tid] = (bf16)f2bf(red[tid] + red[256 + tid]);
    }
}
__device__ __forceinline__ void sb_naive(Frame& F, int w, int NW) {
    const int lane = opq(F.lane);
    for (int qi = w; qi < BG * 4 * SEQ; qi += NW) {
        const int bh = __builtin_amdgcn_readfirstlane(qi >> 11), t = __builtin_amdgcn_readfirstlane(qi & 2047), bl = bh >> 2, h = bh & 3;
        const size_t row = (size_t)bl * SEQ + t;
        const v4u* qp = (const v4u*)(F.P + row * NP + PC_SQ + h * 128);
        v4u qr[16];
#pragma unroll
        for (int i = 0; i < 16; ++i) qr[i] = qp[i];
        float acc0 = 0.f, acc1 = 0.f, R = 0.f;
        for (int kb = (t - 1) >> 6; kb >= 0; --kb) {
            const int s = kb * 64 + lane; const bool valid = s < t; const int sc = valid ? s : (t - 1);
            const v4u* kp = (const v4u*)(F.P + ((size_t)bl * SEQ + sc) * NP + PC_SK + h * 128);
            float dot = 0.f;
#pragma unroll
            for (int i = 0; i < 16; ++i) { const v4u kw = kp[i]; const v4u qw = qr[i];
                dot += bflo(kw.x) * bflo(qw.x) + bfhi(kw.x) * bfhi(qw.x) + bflo(kw.y) * bflo(qw.y) + bfhi(kw.y) * bfhi(qw.y)
                     + bflo(kw.z) * bflo(qw.z) + bfhi(kw.z) * bfhi(qw.z) + bflo(kw.w) * bflo(qw.w) + bfhi(kw.w) * bfhi(qw.w); }
            const float z = dot * 0.08838834764831845f;
            const float l1m = valid ? logsigf_(-z) : 0.f;
            float incl = l1m;
#pragma unroll
            for (int off = 1; off < 64; off <<= 1) { const float tmp = __shfl_down(incl, off); incl += (lane + off < 64) ? tmp : 0.f; }
            const float tail = R + incl - l1m;
            const float wgt = valid ? expf(logsigf_(z) + tail) : 0.f;
            R += __shfl(incl, 0);
            const bf16* vbase = F.P + ((size_t)bl * SEQ + kb * 64) * NP + PC_SV + h * 128 + 2 * lane;
            for (int j = 0; j < 64; ++j) { const float wj = __shfl(wgt, j);
                if (wj != 0.f) { const unsigned vw = *(const unsigned*)(vbase + (size_t)j * NP); acc0 += wj * bflo(vw); acc1 += wj * bfhi(vw); } }
            if (R < -104.f) break;
        }
        const unsigned zw = *(const unsigned*)(F.P + row * NP + PC_SZ + h * 128 + 2 * lane);
        *(unsigned*)(F.Y + row * YW + YC_SB + h * 128 + 2 * lane) = pk2(acc0 * bflo(zw), acc1 * bfhi(zw));
    }
}
__device__ __forceinline__ void phase_mix_naive(Frame& F, int l) {
    const int bx = blockIdx.x;
    if (bx < 32) gdn_chain_naive(F, l, bx);
    else if (bx < 64) gla_chain_naive(F, l, bx - 32);
    else sb_naive(F, (bx - 64) * NWAVES + F.wave, (F.G - 64) * NWAVES);
}
__device__ __forceinline__ void phase_post(Frame& F, int l) {
    const int gw = blockIdx.x * NWAVES + F.wave, NGW = F.G * NWAVES, lane = opq(F.lane);
    for (int m = gw; m < TG; m += NGW) {
#pragma unroll
        for (int ps = 0; ps < 3; ++ps) {
            const int e = (ps == 0) ? lane * 8 : (ps - 1) * 512 + lane * 8;
            bf16* yp = F.Y + (size_t)m * YW + (ps == 0 ? YC_GDN : YC_GLA) + e;
            const bf16* zp = F.P + (size_t)m * NP + (ps == 0 ? PC_DZ : PC_LZ) + e;
            const v4u w = *(const v4u*)yp, zw = *(const v4u*)zp;
            float x[8] = {bflo(w.x), bfhi(w.x), bflo(w.y), bfhi(w.y), bflo(w.z), bfhi(w.z), bflo(w.w), bfhi(w.w)};
            const float zg[8] = {bflo(zw.x), bfhi(zw.x), bflo(zw.y), bfhi(zw.y), bflo(zw.z), bfhi(zw.z), bflo(zw.w), bfhi(zw.w)};
            float ss = 0.f;
#pragma unroll
            for (int i = 0; i < 8; ++i) ss += x[i] * x[i];
            ss += __shfl_xor(ss, 1); ss += __shfl_xor(ss, 2); ss += __shfl_xor(ss, 4); ss += __shfl_xor(ss, 8);
            float r; const float* gn;
            if (ps == 0) { r = 1.f / sqrtf(ss * (1.f / 128.f) + RMS_EPS); gn = F.gdn_onorm + l * 128 + (lane & 15) * 8; }
            else { ss += __shfl_xor(ss, 16); r = 1.f / sqrtf(ss * (1.f / 256.f) + RMS_EPS); gn = F.gla_onorm + l * 256 + (lane & 31) * 8; }
#pragma unroll
            for (int i = 0; i < 8; ++i) x[i] = x[i] * r * gn[i] * zg[i];
            v4u o; o.x = pk2(x[0], x[1]); o.y = pk2(x[2], x[3]); o.z = pk2(x[4], x[5]); o.w = pk2(x[6], x[7]);
            *(v4u*)yp = o;
        }
    }
}

__global__ void __launch_bounds__(NTHREADS, 2) fwd_kernel(Args args) {
    extern __shared__ __attribute__((aligned(16))) unsigned char lds_raw[];
    Frame F;
    F.lds = (LAS unsigned char*)lds_raw;
    volatile LAS unsigned* MISC = (volatile LAS unsigned*)(F.lds + MISC_OFF);
    F.tid = threadIdx.x; F.lane = F.tid & 63; F.wave = __builtin_amdgcn_readfirstlane(F.tid >> 6); F.G = gridDim.x;
    unsigned char* ws = args.ws;
    F.x = args.in[0]; F.c = args.in[1]; F.ada_w = args.in[2]; F.ada_b = args.in[3]; F.norm_g = args.in[4]; F.w_in = args.in[5]; F.sb_qnorm = args.in[6]; F.sb_knorm = args.in[7];
    F.gdn_conv = args.in[8]; F.gdn_a_log = args.in[9]; F.gdn_dt_bias = args.in[10]; F.gdn_onorm = args.in[11]; F.gla_w2 = args.in[12]; F.gla_b = args.in[13]; F.gla_onorm = args.in[14];
    F.merge_b = args.in[15]; F.proj_sb = args.in[16]; F.proj_gdn = args.in[17]; F.proj_gla = args.in[18]; F.w_out = args.in[19];
    F.out = args.out;
    F.MODP = (float*)(ws + WS_MODP); F.MODA = (float*)(ws + WS_MOD); F.MODB = F.MODA + DEPTH * BATCH * D; F.MODG = F.MODB + DEPTH * BATCH * D;
    F.PS = (float*)(ws + WS_PS); F.MGF = (float*)(ws + WS_MGF);
    F.WIN = (bf16*)(ws + WS_WIN); F.WP = (bf16*)(ws + WS_WP); F.WO = (bf16*)(ws + WS_WO); F.H = (bf16*)(ws + WS_H); F.MGB = (bf16*)(ws + WS_MGB);
    F.P = (bf16*)(ws + WS_P); F.Y = (bf16*)(ws + WS_Y); F.GQKV = (bf16*)(ws + WS_H);
    for (int u = F.tid; u < 32; u += NTHREADS) MISC[u] = 0u;
    __syncthreads();
    XcdBarrier bar = xcd_barrier_post((unsigned*)(ws + WS_CTL) + CW_BAR, MISC + 8);
#define GRID_BAR() xcd_barrier(bar)

#ifndef NO_P0
    p0_prologue(F);
#endif
    GRID_BAR();
    p1_mod(F);
    GRID_BAR();
    for (int l = 0; l < DEPTH; ++l) {
        const float* xin = (l == 0) ? F.x : F.out;
        for (int g = 0; g < NGRP; ++g) {
            phase_norm(F, xin, l, g);
            GRID_BAR();
#ifndef NO_G1
            {   pg8::Gemm gm{F.H, F.WIN + (size_t)l * NWT * D, D, D, D}; pg8::StaticOrder S; S.init(TG, NWT, F.G, (int)blockIdx.x);
                EpiG1 E{F.P, F.PS, F.merge_b + l * 3072};
                pg8::gemm_phase<EpiG1, pg8::StaticOrder, true>(F.lds, gm, S, E); }
#endif
            GRID_BAR();
            phase_prep(F, l);
            GRID_BAR();
#ifndef NO_MIX
            phase_mix_naive(F, l);
#endif
            GRID_BAR();
            phase_post(F, l);
            GRID_BAR();
#ifndef NO_G2
            {   pg8::StaticOrder S; S.init(TG, D, F.G, (int)blockIdx.x);
                const bf16* wp = F.WP + (size_t)l * D * 2048;
                {   pg8::Gemm gm{F.Y + YC_SB, wp, YW, 2048, 512}; EpiG2<0> E{F.P, PC_MG, F.MGF, F.MGB};
                    pg8::gemm_phase<EpiG2<0>, pg8::StaticOrder, false>(F.lds, gm, S, E); }
                {   pg8::Gemm gm{F.Y + YC_GDN, wp + 512, YW, 2048, 512}; EpiG2<1> E{F.P, PC_MG + D, F.MGF, F.MGB};
                    pg8::gemm_phase<EpiG2<1>, pg8::StaticOrder, false>(F.lds, gm, S, E); }
                {   pg8::Gemm gm{F.Y + YC_GLA, wp + 1024, YW, 2048, 1024}; EpiG2<2> E{F.P, PC_MG + 2 * D, F.MGF, F.MGB};
                    pg8::gemm_phase<EpiG2<2>, pg8::StaticOrder, false>(F.lds, gm, S, E); } }
#endif
            GRID_BAR();
#ifndef NO_G3
            {   pg8::Gemm gm{F.MGB, F.WO + (size_t)l * D * D, D, D, D}; pg8::StaticOrder S; S.init(TG, D, F.G, (int)blockIdx.x);
                EpiG3 E{xin, F.out, F.MODG + (size_t)l * BATCH * D, g * TG};
                pg8::gemm_phase<EpiG3, pg8::StaticOrder, false>(F.lds, gm, S, E); }
#endif
            GRID_BAR();
        }
    }
}

extern "C" void kernel_launch(void* const* d_in, const int* in_sizes, int n_in, void* d_out, int out_size, void* d_ws, size_t ws_size, hipStream_t stream) {
    static int grid = 0;
    if (grid == 0) {
        if (n_in != 20 || out_size != T * D || ws_size < WS_END) { fprintf(stderr, "kernel_launch: unexpected shapes / workspace (%d inputs, out %d, ws %zu)\n", n_in, out_size, ws_size); grid = -1; return; }
        int dev = 0, cus = 0, per_cu = 0;
        if (hipGetDevice(&dev) != hipSuccess || hipDeviceGetAttribute(&cus, hipDeviceAttributeMultiprocessorCount, dev) != hipSuccess) { grid = -1; return; }
        if (hipFuncSetAttribute((const void*)fwd_kernel, hipFuncAttributeMaxDynamicSharedMemorySize, LDS_BYTES) != hipSuccess) { grid = -1; return; }
        if (hipOccupancyMaxActiveBlocksPerMultiprocessor(&per_cu, (const void*)fwd_kernel, NTHREADS, LDS_BYTES) != hipSuccess || per_cu < 1) fprintf(stderr, "kernel_launch: occupancy query reports %d\n", per_cu);
        (void)hipGetLastError();
        grid = cus;
    }
    if (grid < 0) return;
    if (hipMemsetAsync((char*)d_ws + WS_CTL, 0, CTL_ZERO_BYTES, stream) != hipSuccess) return;
    Args a{};
    for (int i = 0; i < 20; ++i) a.in[i] = (const float*)d_in[i];
    a.out = (float*)d_out; a.ws = (unsigned char*)d_ws; a.ph_lo = 0; a.ph_hi = 0;
    hipLaunchKernelGGL(fwd_kernel, dim3(grid), dim3(NTHREADS), LDS_BYTES, stream, a);
}
```

```cpp
#include <hip/hip_runtime.h>
#include <cstdio>
#include <cstdint>

#define GAS __attribute__((address_space(1)))
#define LAS __attribute__((address_space(3)))

#define XB_TMO      128
#define XB_XCNT(j)  (256  + 64 * (j))
#define XB_XSUB(j)  (1280 + 64 * (j))
#define XB_XGEN(j)  (2304 + 64 * (j))
#define XB_TOP      3328
#define XB_TOPGEN   3392
#define XCD_BAR_WORDS 3456
#define XB_SPIN_CAP (1u << 24)

__device__ __forceinline__ unsigned xb_ld(unsigned* p)              { return __hip_atomic_load(p, __ATOMIC_RELAXED, __HIP_MEMORY_SCOPE_AGENT); }
__device__ __forceinline__ unsigned xb_add(unsigned* p, unsigned v) { return __hip_atomic_fetch_add(p, v, __ATOMIC_RELAXED, __HIP_MEMORY_SCOPE_AGENT); }
__device__ __forceinline__ unsigned xb_xcc_id() { return (unsigned)__builtin_amdgcn_s_getreg((3 << 11) | 20) & 0xFu; }
#define XB_SPIN(cond, bar) do { unsigned _sp = 0; while (cond) { __builtin_amdgcn_s_sleep(1); \
    if ((++_sp & 255u) == 0u) { if (xb_ld(&(bar)[XB_TMO])) break; if (_sp > XB_SPIN_CAP) { atomicAdd(&(bar)[XB_TMO], 1u); break; } } } } while (0)

struct XcdBarrier { unsigned* bar; unsigned x; volatile LAS unsigned* st; };

__device__ __forceinline__ XcdBarrier xcd_barrier_post(unsigned* bar, volatile LAS unsigned* st) {
    XcdBarrier b; b.bar = bar; b.x = xb_xcc_id(); b.st = st;
    if (threadIdx.x == 0) (void)xb_add(&bar[XB_XCNT(b.x)], 1u);
    return b;
}
__device__ __forceinline__ void xcd_barrier_complete(unsigned* bar, unsigned x, unsigned& nloc, unsigned& nx) {
    const unsigned G = gridDim.x * gridDim.y * gridDim.z;
    unsigned sum, cnt, mine, sp = 0u;
    for (;;) {
        sum = 0u; cnt = 0u; mine = 0u;
#pragma unroll
        for (unsigned j = 0; j < 16; ++j) { const unsigned c = xb_ld(&bar[XB_XCNT(j)]); sum += c; cnt += (c > 0u) ? 1u : 0u; mine = (j == x) ? c : mine; }
        if (sum == G) break;
        __builtin_amdgcn_s_sleep(1);
        if ((++sp & 255u) == 0u) { if (xb_ld(&bar[XB_TMO])) break; if (sp > XB_SPIN_CAP) { atomicAdd(&bar[XB_TMO], 1u); break; } }
    }
    nloc = mine > 0u ? mine : 1u; nx = cnt > 0u ? cnt : 1u;
}
__device__ __forceinline__ void xcd_barrier(const XcdBarrier& b) {
    asm volatile("s_waitcnt vmcnt(0)" ::: "memory");
    __syncthreads();
    if (threadIdx.x == 0) {
        unsigned* bar = b.bar;
        __builtin_amdgcn_s_waitcnt(0);
        unsigned nloc = b.st[0], nx = b.st[1];
        if (nloc == 0u) { xcd_barrier_complete(bar, b.x, nloc, nx); b.st[0] = nloc; b.st[1] = nx; }
        const unsigned old = xb_add(&bar[XB_XSUB(b.x)], 1u);
        const unsigned gen = old / nloc;
        if (old + 1u == (gen + 1u) * nloc) {
            __builtin_amdgcn_fence(__ATOMIC_RELEASE, "agent");
            asm volatile("s_waitcnt vmcnt(0)" ::: "memory");
            const unsigned og = xb_add(&bar[XB_TOP], 1u);
            const unsigned tg = og / nx;
            if (og + 1u == (tg + 1u) * nx) xb_add(&bar[XB_TOPGEN], 1u);
            else XB_SPIN(xb_ld(&bar[XB_TOPGEN]) == tg, bar);
            __builtin_amdgcn_fence(__ATOMIC_ACQUIRE, "agent");
            xb_add(&bar[XB_XGEN(b.x)], 1u);
            asm volatile("s_waitcnt vmcnt(0)" ::: "memory");
        } else {
            XB_SPIN(xb_ld(&bar[XB_XGEN(b.x)]) == gen, bar);
            __builtin_amdgcn_fence(__ATOMIC_ACQUIRE, "agent");
            asm volatile("s_waitcnt vmcnt(0)" ::: "memory");
        }
    }
    __syncthreads();
}
namespace pg8 {
#define PG8_LAS __attribute__((address_space(3)))
typedef unsigned short bf16_t;
typedef short bf16x8 __attribute__((ext_vector_type(8)));
typedef float f32x4 __attribute__((ext_vector_type(4)));
typedef unsigned u32x4 __attribute__((ext_vector_type(4)));
typedef unsigned u32x2 __attribute__((ext_vector_type(2)));
constexpr int BM = 256, BK = 64, HALF = 128, HTB = HALF * BK * 2, STAGE_BYTES = 8 * HTB, NXCD = 8, WGM = 8;

__host__ __device__ __forceinline__ int lds_byte(int r, int c) { const int st = (r >> 4) * 2 + (c >> 5), rr = r & 15, cc = c & 31, ob = rr * 64 + cc * 2; return st * 1024 + (ob ^ (((ob >> 9) & 1) << 5)); }
__host__ __device__ __forceinline__ void stage_rc(int b, int& R, int& C) { const int st = b / 1024, sb = b % 1024, swz = sb ^ (((sb >> 9) & 1) << 5); R = (st >> 1) * 16 + swz / 64; C = (st & 1) * 32 + (swz % 64) / 2; }
__host__ __device__ __forceinline__ int perm32(int rho) { const int n = rho >> 4, i = rho & 15; return 8 * (i >> 2) + 4 * n + (i & 3); }

struct Unit { int pm, pn; };
struct Gemm { const bf16_t* A; const bf16_t* Bt; int lda, ldb, K; };

struct StaticOrder {
    int nM, nN, nwg, G, c;
    __host__ __device__ void init(int M, int N, int G_, int c_) { nM = M / BM; nN = N / BM; nwg = nM * nN; G = G_; c = c_; }
    __host__ __device__ bool next(int i, Unit& u) const {
        const long L = (long)i * G + c; if (L >= nwg) return false;
        int wgid = (int)L; { const int q = nwg / NXCD, r = nwg % NXCD, xcd = wgid % NXCD, off = wgid / NXCD; wgid = (xcd < r ? xcd * (q + 1) : r * (q + 1) + (xcd - r) * q) + off; }
        const int nig = WGM * nN, gid = wgid / nig, fm = gid * WGM, gsz = (nM - fm) < WGM ? (nM - fm) : WGM;
        u.pm = fm + ((wgid % nig) % gsz); u.pn = (wgid % nig) / gsz; return true;
    }
    __device__ __forceinline__ void a_ready(const Unit&) const {}
    __device__ __forceinline__ void done(const Unit&) const {}
};

__device__ __forceinline__ unsigned cvt_pk_bf16(float lo, float hi) { unsigned r; asm volatile("v_cvt_pk_bf16_f32 %0, %1, %2" : "=v"(r) : "v"(lo), "v"(hi)); return r; }

template <class Epi, class Sched, bool ALIGN_EPI>
__device__ __forceinline__ void gemm_phase(PG8_LAS unsigned char* lds, const Gemm g, const Sched& S, const Epi& E) {
    int tid = threadIdx.x; asm volatile("" : "+v"(tid));
    const int wid = __builtin_amdgcn_readfirstlane(tid >> 6), lane = tid & 63, wr = wid >> 2, wc = wid & 3, fr = lane & 15, fq = lane >> 4;
    const int K = g.K, nt = K / BK;
    unsigned voffA[2], voffB[2];
#pragma unroll
    for (int i = 0; i < 2; ++i) { int R, C; stage_rc(tid * 16 + i * 8192, R, C); const int Rb = Epi::PERM ? ((R & ~31) + perm32(R & 31)) : R;
        voffA[i] = (unsigned)(R * g.lda + C) * 2u; voffB[i] = (unsigned)(Rb * g.ldb + C) * 2u; }
    const size_t kstep = (size_t)(BK * 2);
    const size_t hstepA = (size_t)HALF * g.lda * 2, hstepB = (size_t)HALF * g.ldb * 2;
    const size_t tstepA = 2 * hstepA, tstepB = 2 * hstepB;
    const unsigned ldsw = (unsigned)wid * 1024u;
    const int aoff = lds_byte(wr * 64 + fr, fq * 8), boff = lds_byte(wc * 32 + fr, fq * 8);
#define PG8_SA(b, h) (((b) * 2 + (h)) * HTB)
#define PG8_SB(b, h) ((4 + (b) * 2 + (h)) * HTB)
#define PG8_STAGE(bufoff, gbase, voff) do { _Pragma("unroll") for (int _i = 0; _i < 2; ++_i) \
        __builtin_amdgcn_global_load_lds((const unsigned*)((const char*)(gbase) + (voff)[_i]), (PG8_LAS unsigned*)(lds + (bufoff) + ldsw + _i * 8192), 16, 0, 0); } while (0)
#define PG8_LDA(dst, b, h) do { _Pragma("unroll") for (int m = 0; m < 4; ++m) _Pragma("unroll") for (int k = 0; k < 2; ++k) dst[m][k] = *(const PG8_LAS bf16x8*)(lds + PG8_SA(b, h) + aoff + m * 2048 + k * 1024); } while (0)
#define PG8_LDB(dst, b, h) do { _Pragma("unroll") for (int n = 0; n < 2; ++n) _Pragma("unroll") for (int k = 0; k < 2; ++k) dst[n][k] = *(const PG8_LAS bf16x8*)(lds + PG8_SB(b, h) + boff + n * 2048 + k * 1024); } while (0)
#define PG8_MMA(ai, bj, At, Bt) do { __builtin_amdgcn_s_setprio(1); _Pragma("unroll") for (int m = 0; m < 4; ++m) _Pragma("unroll") for (int n = 0; n < 2; ++n) _Pragma("unroll") for (int k = 0; k < 2; ++k) \
        acc[ai][bj][m][n] = __builtin_amdgcn_mfma_f32_16x16x32_bf16(Bt[n][k], At[m][k], acc[ai][bj][m][n], 0, 0, 0); __builtin_amdgcn_s_setprio(0); } while (0)
#define PG8_WAIT_V(n) asm volatile("s_waitcnt vmcnt(" #n ")" ::: "memory")
#define PG8_WAIT_L(n) asm volatile("s_waitcnt lgkmcnt(" #n ")" ::: "memory")
#define PG8_BAR __builtin_amdgcn_s_barrier()
#define PG8_SCHED __builtin_amdgcn_sched_barrier(0)
    Unit cur, nxt; int ui = 0;
    if (!S.next(0, cur)) return;
    f32x4 acc[2][2][4][2];
#pragma unroll
    for (int a = 0; a < 2; ++a)
#pragma unroll
        for (int b = 0; b < 2; ++b)
#pragma unroll
            for (int m = 0; m < 4; ++m)
#pragma unroll
                for (int n = 0; n < 2; ++n) acc[a][b][m][n] = (f32x4){0.f, 0.f, 0.f, 0.f};
    bf16x8 At[4][2], B0[2][2], B1[2][2];
    const char* cA = (const char*)g.A + (size_t)cur.pm * tstepA; const char* cB = (const char*)g.Bt + (size_t)cur.pn * tstepB;
    S.a_ready(cur);
    PG8_STAGE(PG8_SB(0, 0), cB, voffB); PG8_STAGE(PG8_SB(0, 1), cB + hstepB, voffB); PG8_STAGE(PG8_SA(0, 0), cA, voffA); PG8_STAGE(PG8_SA(0, 1), cA + hstepA, voffA);
    if (wr == 1) PG8_BAR;
    PG8_WAIT_V(2); PG8_BAR;
    PG8_STAGE(PG8_SB(1, 0), cB + kstep, voffB); PG8_STAGE(PG8_SA(1, 0), cA + kstep, voffA); PG8_STAGE(PG8_SB(1, 1), cB + hstepB + kstep, voffB);
    PG8_WAIT_V(6); PG8_BAR;
    for (;;) {
        const bool has_next = S.next(ui + 1, nxt);
        const char* nA = has_next ? (const char*)g.A + (size_t)nxt.pm * tstepA : cA; const char* nB = has_next ? (const char*)g.Bt + (size_t)nxt.pn * tstepB : cB;
        for (int t = 0; t < nt; t += 2) {
            const bool last = (t == nt - 2);
            const char* a1 = cA + (size_t)(t + 1) * kstep;
            const char* a2 = last ? nA : cA + (size_t)(t + 2) * kstep; const char* b2 = last ? nB : cB + (size_t)(t + 2) * kstep;
            const char* a3 = a2 + kstep; const char* b3 = b2 + kstep;
            if (last && has_next) S.a_ready(nxt);
            PG8_LDB(B0, 0, 0); PG8_LDB(B1, 0, 1); PG8_SCHED; PG8_LDA(At, 0, 0); PG8_STAGE(PG8_SA(1, 1), a1 + hstepA, voffA);
            PG8_WAIT_V(8); PG8_WAIT_L(0); PG8_BAR; PG8_MMA(0, 0, At, B0); PG8_MMA(0, 1, At, B1); PG8_BAR; PG8_SCHED;
            PG8_LDA(At, 0, 1); PG8_STAGE(PG8_SB(0, 0), b2, voffB); PG8_STAGE(PG8_SB(0, 1), b2 + hstepB, voffB); PG8_STAGE(PG8_SA(0, 0), a2, voffA);
            PG8_WAIT_V(8); PG8_WAIT_L(0); PG8_BAR; PG8_MMA(1, 0, At, B0); PG8_MMA(1, 1, At, B1); PG8_BAR; PG8_SCHED;
            PG8_LDB(B0, 1, 0); PG8_LDB(B1, 1, 1); PG8_SCHED; PG8_LDA(At, 1, 0); PG8_STAGE(PG8_SA(0, 1), a2 + hstepA, voffA);
            PG8_WAIT_V(8); PG8_WAIT_L(0); PG8_BAR; PG8_MMA(0, 0, At, B0); PG8_MMA(0, 1, At, B1); PG8_BAR; PG8_SCHED;
            PG8_LDA(At, 1, 1); PG8_STAGE(PG8_SB(1, 0), b3, voffB); PG8_STAGE(PG8_SB(1, 1), b3 + hstepB, voffB); PG8_STAGE(PG8_SA(1, 0), a3, voffA);
            PG8_WAIT_V(8); PG8_WAIT_L(0); PG8_BAR; PG8_MMA(1, 0, At, B0); PG8_MMA(1, 1, At, B1); PG8_BAR; PG8_SCHED;
        }
        if constexpr (ALIGN_EPI) { if (wr == 0) PG8_BAR; }
        E(acc, cur, wr, wc, fr, fq);
        if (!has_next) break;
#pragma unroll
        for (int a = 0; a < 2; ++a)
#pragma unroll
            for (int b = 0; b < 2; ++b)
#pragma unroll
                for (int m = 0; m < 4; ++m)
#pragma unroll
                    for (int n = 0; n < 2; ++n) acc[a][b][m][n] = (f32x4){0.f, 0.f, 0.f, 0.f};
        cur = nxt; cA = nA; cB = nB; ++ui;
        if constexpr (ALIGN_EPI) { if (wr == 1) PG8_BAR; }
    }
    PG8_WAIT_V(0);
    if constexpr (!ALIGN_EPI) { if (wr == 0) PG8_BAR; }
    PG8_BAR;
#undef PG8_SA
#undef PG8_SB
#undef PG8_STAGE
#undef PG8_LDA
#undef PG8_LDB
#undef PG8_MMA
#undef PG8_WAIT_V
#undef PG8_WAIT_L
#undef PG8_BAR
#undef PG8_SCHED
}
}
constexpr int D = 1024, BATCH = 16, SEQ = 2048, DEPTH = 4, T = BATCH * SEQ;
constexpr int NGRP = 2, TG = T / NGRP, BG = BATCH / NGRP;
constexpr int N_IN = 10264, NP = 10240, NWT = 10496;
constexpr int PC_SQ = 0, PC_SK = 512, PC_SV = 1024, PC_SZ = 1536, PC_DQ = 2048, PC_DZ = 3584, PC_LQ = 4096, PC_LK = 4608, PC_LV = 5120, PC_LZ = 6144, PC_MG = 7168;
constexpr int YC_SB = 0, YC_GDN = 512, YC_GLA = 1024, YW = 2048;
constexpr int NTHREADS = 512, NWAVES = 8;
constexpr float RMS_EPS = 1e-6f, L2_EPS = 1e-6f;

constexpr size_t MiB = 1u << 20;
constexpr size_t WS_CTL = 0, CTL_ZERO_BYTES = 1 * MiB;
constexpr size_t WS_MODP = 2 * MiB;
constexpr size_t WS_MOD = 8 * MiB;
constexpr size_t WS_WIN = 10 * MiB;
constexpr size_t WS_WP = 31 * MiB;
constexpr size_t WS_WO = 35 * MiB;
constexpr size_t WS_H = 40 * MiB;
constexpr size_t WS_MGB = 72 * MiB;
constexpr size_t WS_P = 104 * MiB;
constexpr size_t WS_PS = 424 * MiB;
constexpr size_t WS_Y = 426 * MiB;
constexpr size_t WS_MGF = 490 * MiB;
constexpr size_t WS_END = 640 * MiB;
constexpr size_t WS_GD_WN = 490 * MiB;
constexpr size_t WS_GD_BT = 522 * MiB;
constexpr size_t WS_GD_ST = 554 * MiB;
constexpr size_t WS_GD_QE = 586 * MiB;
constexpr size_t WS_GD_OL = 602 * MiB;
constexpr size_t WS_GD_CD = 618 * MiB;
constexpr int CW_BAR = 4096;

constexpr int RING_BYTES = 131072;
constexpr int MISC_OFF = RING_BYTES + 320;
constexpr int LDS_BYTES = 147456;

typedef unsigned short bf16;
typedef unsigned v4u __attribute__((ext_vector_type(4)));
typedef unsigned v2u __attribute__((ext_vector_type(2)));
typedef float f32x4 __attribute__((ext_vector_type(4)));
#define LDS_WAIT() asm volatile("s_waitcnt lgkmcnt(0)" ::: "memory")

__device__ __forceinline__ float bf2f(unsigned v) { return __uint_as_float(v << 16); }
__device__ __forceinline__ float bflo(unsigned w) { return __uint_as_float(w << 16); }
__device__ __forceinline__ float bfhi(unsigned w) { return __uint_as_float(w & 0xffff0000u); }
__device__ __forceinline__ unsigned f2bf(float f) { unsigned u = __float_as_uint(f); return (u + 0x7fffu + ((u >> 16) & 1u)) >> 16; }
__device__ __forceinline__ unsigned pk2(float lo, float hi) { return f2bf(lo) | (f2bf(hi) << 16); }
__device__ __forceinline__ float sigmoidf_(float x) { return 1.f / (1.f + __expf(-x)); }
__device__ __forceinline__ float siluf_(float x) { return x / (1.f + __expf(-x)); }
__device__ __forceinline__ float softplusf_(float x) { return fmaxf(x, 0.f) + log1pf(expf(-fabsf(x))); }
__device__ __forceinline__ float logsigf_(float x) { return fminf(x, 0.f) - log1pf(expf(-fabsf(x))); }

__device__ __forceinline__ int opq(int v) { asm volatile("" : "+v"(v)); return v; }
struct Args {
    const float* in[20];
    float* out; unsigned char* ws;
    int ph_lo, ph_hi;
};
struct Frame {
    LAS unsigned char* lds;
    int tid, lane, wave, G;
    const float *x, *c, *ada_w, *ada_b, *norm_g, *w_in, *sb_qnorm, *sb_knorm, *gdn_conv, *gdn_a_log, *gdn_dt_bias, *gdn_onorm, *gla_w2, *gla_b, *gla_onorm, *merge_b, *proj_sb, *proj_gdn, *proj_gla, *w_out;
    float* out; unsigned char* wsb;
    float *MODP, *MODA, *MODB, *MODG, *PS, *MGF;
    bf16 *WIN, *WP, *WO, *H, *MGB, *P, *Y, *GQKV;
};

struct EpiG1 {
    static constexpr bool PERM = true;
    bf16* P; float* PS; const float* mb;
    __device__ __forceinline__ void operator()(const pg8::f32x4 (&acc)[2][2][4][2], const pg8::Unit& u, int wr, int wc, int fr, int fq) const {
        const int row0 = u.pm * 256 + wr * 64 + fr, pn = u.pn;
        if (pn < 40) {
            const int mode = (pn == 6 || pn == 7 || pn == 14 || pn == 15 || (pn >= 24 && pn < 28)) ? 1 : (pn >= 28 ? 2 : 0);
            const int col0 = pn * 256 + wc * 32 + 8 * fq;
            pg8::f32x4 bv[2][2];
#pragma unroll
            for (int bj = 0; bj < 2; ++bj)
#pragma unroll
                for (int n = 0; n < 2; ++n) bv[bj][n] = (mode == 2) ? *(const pg8::f32x4*)(mb + (col0 - PC_MG) + bj * 128 + 4 * n) : (pg8::f32x4){0.f, 0.f, 0.f, 0.f};
#pragma unroll
            for (int ai = 0; ai < 2; ++ai)
#pragma unroll
                for (int m = 0; m < 4; ++m) { bf16* rowp = P + (size_t)(row0 + ai * 128 + m * 16) * NP + col0;
#pragma unroll
                    for (int bj = 0; bj < 2; ++bj) { pg8::f32x4 v0 = acc[ai][bj][m][0], v1 = acc[ai][bj][m][1];
                        if (mode == 1) {
#pragma unroll
                            for (int j = 0; j < 4; ++j) { v0[j] = siluf_(v0[j]); v1[j] = siluf_(v1[j]); } }
                        else if (mode == 2) { v0 = v0 + bv[bj][0]; v1 = v1 + bv[bj][1];
#pragma unroll
                            for (int j = 0; j < 4; ++j) { v0[j] = sigmoidf_(v0[j]); v1[j] = sigmoidf_(v1[j]); } }
                        pg8::u32x4 w; w.x = pg8::cvt_pk_bf16(v0[0], v0[1]); w.y = pg8::cvt_pk_bf16(v0[2], v0[3]); w.z = pg8::cvt_pk_bf16(v1[0], v1[1]); w.w = pg8::cvt_pk_bf16(v1[2], v1[3]);
                        *(pg8::u32x4*)(rowp + bj * 128) = w; } }
        } else if (wc == 0 && fq < 3) {
#pragma unroll
            for (int ai = 0; ai < 2; ++ai)
#pragma unroll
                for (int m = 0; m < 4; ++m) { float* rowp = PS + (size_t)(row0 + ai * 128 + m * 16) * 32 + 8 * fq;
                    *(pg8::f32x4*)(rowp) = acc[ai][0][m][0]; *(pg8::f32x4*)(rowp + 4) = acc[ai][0][m][1]; }
        }
    }
};
template <int MODE> struct EpiG2 {
    static constexpr bool PERM = false;
    const bf16* P; int gcol0; float* MGF; bf16* MGB;
    __device__ __forceinline__ void operator()(const pg8::f32x4 (&acc)[2][2][4][2], const pg8::Unit& u, int wr, int wc, int fr, int fq) const {
        const int row0 = u.pm * 256 + wr * 64 + fr, col0 = u.pn * 256 + wc * 32 + 4 * fq;
#pragma unroll
        for (int ai = 0; ai < 2; ++ai)
#pragma unroll
            for (int m = 0; m < 4; ++m) { const size_t r = (size_t)(row0 + ai * 128 + m * 16);
#pragma unroll
                for (int bj = 0; bj < 2; ++bj)
#pragma unroll
                    for (int n = 0; n < 2; ++n) { const int c = col0 + bj * 128 + n * 16;
                        const pg8::u32x2 gw = *(const pg8::u32x2*)(P + r * NP + gcol0 + c);
                        pg8::f32x4 v = acc[ai][bj][m][n];
                        v[0] *= bflo(gw.x); v[1] *= bfhi(gw.x); v[2] *= bflo(gw.y); v[3] *= bfhi(gw.y);
                        float* mp = MGF + r * D + c;
                        if (MODE == 0) *(pg8::f32x4*)mp = v;
                        else if (MODE == 1) *(pg8::f32x4*)mp = *(const pg8::f32x4*)mp + v;
                        else { v = v + *(const pg8::f32x4*)mp; pg8::u32x2 w; w.x = pg8::cvt_pk_bf16(v[0], v[1]); w.y = pg8::cvt_pk_bf16(v[2], v[3]); *(pg8::u32x2*)(MGB + r * D + c) = w; } } }
    }
};
struct EpiG3 {
    static constexpr bool PERM = false;
    const float* xin; float* out; const float* gate; int grow0;
    __device__ __forceinline__ void operator()(const pg8::f32x4 (&acc)[2][2][4][2], const pg8::Unit& u, int wr, int wc, int fr, int fq) const {
        const int row0 = grow0 + u.pm * 256 + wr * 64 + fr, col0 = u.pn * 256 + wc * 32 + 4 * fq;
        const float* gp = gate + (size_t)((grow0 + u.pm * 256) / SEQ) * D;
        pg8::f32x4 gv[2][2];
#pragma unroll
        for (int bj = 0; bj < 2; ++bj)
#pragma unroll
            for (int n = 0; n < 2; ++n) gv[bj][n] = *(const pg8::f32x4*)(gp + col0 + bj * 128 + n * 16);
#pragma unroll
        for (int ai = 0; ai < 2; ++ai)
#pragma unroll
            for (int m = 0; m < 4; ++m) { const size_t off = (size_t)(row0 + ai * 128 + m * 16) * D + col0;
#pragma unroll
                for (int bj = 0; bj < 2; ++bj)
#pragma unroll
                    for (int n = 0; n < 2; ++n) { const pg8::f32x4 xv = *(const pg8::f32x4*)(xin + off + bj * 128 + n * 16);
                        *(pg8::f32x4*)(out + off + bj * 128 + n * 16) = xv + gv[bj][n] * acc[ai][bj][m][n]; } }
    }
};

__device__ __forceinline__ void transpose_item(const float* W, int ldw, int col0, bf16* WT, int ldd, int drow0, int dk0, int nblk, LAS float* scr, int item, int lane) {
    const int kb = item / nblk, nb = item % nblk, k0 = 64 * kb, n0 = 32 * nb;
#pragma unroll 8
    for (int i = 0; i < 32; ++i) { const int kk = 2 * i + (lane >> 5); scr[kk * 33 + (lane & 31)] = W[(size_t)(k0 + kk) * ldw + col0 + n0 + (lane & 31)]; }
    LDS_WAIT(); asm volatile("" ::: "memory");
    const int c = lane & 7;
#pragma unroll
    for (int j = 0; j < 4; ++j) { const int n = (lane >> 3) + 8 * j; const LAS float* s = scr + (8 * c) * 33 + n;
        v4u o; o.x = pk2(s[0 * 33], s[1 * 33]); o.y = pk2(s[2 * 33], s[3 * 33]); o.z = pk2(s[4 * 33], s[5 * 33]); o.w = pk2(s[6 * 33], s[7 * 33]);
        *(v4u*)(WT + (size_t)(drow0 + n0 + n) * ldd + dk0 + k0 + 8 * c) = o; }
    LDS_WAIT(); asm volatile("" ::: "memory");
}
__device__ __forceinline__ void p0_ada(Frame& F) {
    LAS float* cact = (LAS float*)F.lds;
    for (int i = F.tid; i < BATCH * D; i += NTHREADS) cact[i] = siluf_(F.c[i]);
    __syncthreads();
    for (int it = blockIdx.x; it < 4 * 8 * 6; it += F.G) {
        const int l = it / 48, ks = (it % 48) / 6, jc = it % 6, j = jc * 512 + F.tid;
        float a[16];
#pragma unroll
        for (int b = 0; b < 16; ++b) a[b] = 0.f;
        const float* wp = F.ada_w + ((size_t)l * D + ks * 128) * 3072 + j;
#pragma unroll 4
        for (int k = 0; k < 128; ++k) { const float w = wp[(size_t)k * 3072];
#pragma unroll
            for (int b = 0; b < 16; ++b) a[b] += cact[b * D + ks * 128 + k] * w; }
#pragma unroll
        for (int b = 0; b < 16; ++b) F.MODP[((size_t)(ks * 4 + l) * 16 + b) * 3072 + j] = a[b];
    }
}
__device__ __forceinline__ void wconv_layer(Frame& F, int l) {
    const int lane = opq(F.lane);
    LAS float* scr = (LAS float*)(F.lds + F.wave * 16384);
    const int gw = blockIdx.x * NWAVES + F.wave, NGW = F.G * NWAVES;
    constexpr int I_A = 16 * 128, I_B = 16 * 96, I_C = 16 * 96, I_SB = 8 * 32, I_GDN = 8 * 32, I_GLA = 16 * 32, I_WO = 16 * 32;
    constexpr int I_L = I_A + I_B + I_C + I_SB + I_GDN + I_GLA + I_WO;
    const float* win = F.w_in + (size_t)l * D * N_IN;
    for (int it = gw; it < I_L; it += NGW) {
        int r = it;
        if (r < I_A) { transpose_item(win, N_IN, 0, F.WIN, D, 0, 0, 128, scr, r, lane); continue; } r -= I_A;
        if (r < I_B) { transpose_item(win, N_IN, 4104, F.WIN, D, 4096, 0, 96, scr, r, lane); continue; } r -= I_B;
        if (r < I_C) { transpose_item(win, N_IN, 7192, F.WIN, D, 7168, 0, 96, scr, r, lane); continue; } r -= I_C;
        if (r < I_SB) { transpose_item(F.proj_sb + (size_t)l * 512 * D, D, 0, F.WP, 2048, 0, 0, 32, scr, r, lane); continue; } r -= I_SB;
        if (r < I_GDN) { transpose_item(F.proj_gdn + (size_t)l * 512 * D, D, 0, F.WP, 2048, 0, 512, 32, scr, r, lane); continue; } r -= I_GDN;
        if (r < I_GLA) { transpose_item(F.proj_gla + (size_t)l * D * D, D, 0, F.WP, 2048, 0, 1024, 32, scr, r, lane); continue; } r -= I_GLA;
        transpose_item(F.w_out + (size_t)l * D * D, D, 0, F.WO, D, 0, 0, 32, scr, r, lane);
    }
    for (int i = blockIdx.x * NTHREADS + opq(F.tid); i < 256 * D; i += F.G * NTHREADS) {
        const int r = i / D, k = i % D;
        float v = 0.f;
        if (r < 8) v = win[(size_t)k * N_IN + 4096 + r];
        else if (r < 24) v = win[(size_t)k * N_IN + 7176 + (r - 8)];
        F.WIN[(size_t)(10240 + r) * D + k] = (bf16)f2bf(v);
    }
    __syncthreads();
}
__device__ __forceinline__ void p1_mod(Frame& F) {
    for (int i = blockIdx.x * NTHREADS + F.tid; i < DEPTH * BATCH * D; i += F.G * NTHREADS) {
        const int l = i / (BATCH * D), b = (i / D) % BATCH, c = i % D;
        float sh = F.ada_b[l * 3072 + c], sc = F.ada_b[l * 3072 + D + c], gt = F.ada_b[l * 3072 + 2 * D + c];
#pragma unroll
        for (int ks = 0; ks < 8; ++ks) { const float* p = F.MODP + ((size_t)(ks * 4 + l) * 16 + b) * 3072; sh += p[c]; sc += p[D + c]; gt += p[2 * D + c]; }
        F.MODA[i] = F.norm_g[l * D + c] * (1.f + sc); F.MODB[i] = sh; F.MODG[i] = gt;
    }
}
__device__ __forceinline__ float wave_sum(float v) {
#pragma unroll
    for (int o = 1; o < 64; o <<= 1) v += __shfl_xor(v, o);
    return v;
}
__device__ __forceinline__ void phase_norm(Frame& F, const float* xin, int l, int g) {
    const int gw = blockIdx.x * NWAVES + F.wave, NGW = F.G * NWAVES, lane = opq(F.lane);
    for (int m = gw; m < TG; m += NGW) {
        const int grow = g * TG + m, b = grow / SEQ;
        const f32x4* xr = (const f32x4*)(xin + (size_t)grow * D) + lane;
        const f32x4* ma = (const f32x4*)(F.MODA + (size_t)(l * BATCH + b) * D) + lane;
        const f32x4* mb = (const f32x4*)(F.MODB + (size_t)(l * BATCH + b) * D) + lane;
        f32x4 v[4]; float s = 0.f;
#pragma unroll
        for (int j = 0; j < 4; ++j) { v[j] = xr[64 * j]; s += (v[j].x * v[j].x + v[j].y * v[j].y) + (v[j].z * v[j].z + v[j].w * v[j].w); }
        const float rstd = 1.f / sqrtf(wave_sum(s) * (1.f / D) + RMS_EPS);
        unsigned long long* o8 = (unsigned long long*)(F.H + (size_t)m * D) + lane;
#pragma unroll
        for (int j = 0; j < 4; ++j) { const f32x4 a = ma[64 * j], sh = mb[64 * j]; const f32x4 y = v[j] * rstd * a + sh;
            o8[64 * j] = (unsigned long long)pk2(y.x, y.y) | ((unsigned long long)pk2(y.z, y.w) << 32); }
    }
}
__device__ __forceinline__ void phase_prep(Frame& F, int l) {
    const int gw = blockIdx.x * NWAVES + F.wave, NGW = F.G * NWAVES, lane = opq(F.lane);
    for (int m = gw; m < TG; m += NGW) {
        {
            bf16* p = F.P + (size_t)m * NP + lane * 16;
            const v4u w0 = *(const v4u*)p, w1 = *(const v4u*)(p + 8);
            float x[16];
            x[0] = bflo(w0.x); x[1] = bfhi(w0.x); x[2] = bflo(w0.y); x[3] = bfhi(w0.y); x[4] = bflo(w0.z); x[5] = bfhi(w0.z); x[6] = bflo(w0.w); x[7] = bfhi(w0.w);
            x[8] = bflo(w1.x); x[9] = bfhi(w1.x); x[10] = bflo(w1.y); x[11] = bfhi(w1.y); x[12] = bflo(w1.z); x[13] = bfhi(w1.z); x[14] = bflo(w1.w); x[15] = bfhi(w1.w);
            float ss = 0.f;
#pragma unroll
            for (int i = 0; i < 16; ++i) ss += x[i] * x[i];
            ss += __shfl_xor(ss, 1); ss += __shfl_xor(ss, 2); ss += __shfl_xor(ss, 4);
            const float r = 1.f / sqrtf(ss * (1.f / 128.f) + RMS_EPS);
            const float* gn = (lane < 32 ? F.sb_qnorm : F.sb_knorm) + l * 128 + (lane & 7) * 16;
#pragma unroll
            for (int i = 0; i < 16; ++i) x[i] = x[i] * r * gn[i];
            v4u o0, o1;
            o0.x = pk2(x[0], x[1]); o0.y = pk2(x[2], x[3]); o0.z = pk2(x[4], x[5]); o0.w = pk2(x[6], x[7]);
            o1.x = pk2(x[8], x[9]); o1.y = pk2(x[10], x[11]); o1.z = pk2(x[12], x[13]); o1.w = pk2(x[14], x[15]);
            *(v4u*)p = o0; *(v4u*)(p + 8) = o1;
        }
    }
}
__device__ __forceinline__ void gdn_chain_naive(Frame& F, int l, int bh) {
    const int bl = bh >> 2, h = bh & 3, tid = opq(F.tid), v = tid & 127, kq = tid >> 7;
    LAS float* qv = (LAS float*)F.lds; LAS float* kv = qv + 128; LAS float* vv = kv + 128; LAS float* sc = vv + 128; LAS float* red = sc + 128; LAS float* red2 = red + 512;
    float s[32];
#pragma unroll
    for (int i = 0; i < 32; ++i) s[i] = 0.f;
    const float Aexp = expf(F.gdn_a_log[l * 4 + h]), dtb = F.gdn_dt_bias[l * 4 + h];
    for (int t = 0; t < SEQ; ++t) {
        const size_t row = (size_t)bl * SEQ + t;
        if (tid < 128) { const bf16* gp = F.GQKV + row * 1536 + h * 128 + tid; qv[tid] = bf2f(gp[0]); kv[tid] = bf2f(gp[512]); vv[tid] = bf2f(gp[1024]); }
        if (tid == 128) { const float db = F.PS[row * 32 + h], da = F.PS[row * 32 + 4 + h]; sc[0] = sigmoidf_(db); sc[1] = expf(-Aexp * softplusf_(da + dtb)); }
        __syncthreads();
        const float eg = sc[1]; float part = 0.f;
#pragma unroll
        for (int i = 0; i < 32; ++i) { s[i] *= eg; part += kv[kq * 32 + i] * s[i]; }
        red[kq * 128 + v] = part;
        __syncthreads();
        const float kS = (red[v] + red[128 + v]) + (red[256 + v] + red[384 + v]);
        const float delta = sc[0] * (vv[v] - kS); float part2 = 0.f;
#pragma unroll
        for (int i = 0; i < 32; ++i) { s[i] += kv[kq * 32 + i] * delta; part2 += qv[kq * 32 + i] * s[i]; }
        red2[kq * 128 + v] = part2;
        __syncthreads();
        if (tid < 128) { const float o = (red2[tid] + red2[128 + tid]) + (red2[256 + tid] + red2[384 + tid]); F.Y[row * YW + YC_GDN + h * 128 + tid] = (bf16)f2bf(o); }
    }
}
__device__ __forceinline__ void gla_chain_naive(Frame& F, int l, int bh) {
    const int bl = bh >> 2, h = bh & 3, tid = opq(F.tid), v = tid & 255, kh = tid >> 8;
    LAS float* qv = (LAS float*)F.lds; LAS float* kv = qv + 128; LAS float* ea = kv + 128; LAS float* vv = ea + 128; LAS float* red = vv + 256;
    float s[64];
#pragma unroll
    for (int i = 0; i < 64; ++i) s[i] = 0.f;
    float w2r[16]; float bb = 0.f;
    if (tid < 128) { bb = F.gla_b[l * 512 + h * 128 + tid];
#pragma unroll
        for (int r = 0; r < 16; ++r) w2r[r] = F.gla_w2[((size_t)l * 16 + r) * 512 + h * 128 + tid]; }
    else {
#pragma unroll
        for (int r = 0; r < 16; ++r) w2r[r] = 0.f; }
    for (int t = 0; t < SEQ; ++t) {
        const size_t row = (size_t)bl * SEQ + t;
        if (tid < 128) {
            const bf16* pp = F.P + row * NP + h * 128 + tid;
            qv[tid] = bf2f(pp[PC_LQ]) * 0.08838834764831845f; kv[tid] = bf2f(pp[PC_LK]);
            float xg = bb;
#pragma unroll
            for (int r = 0; r < 16; ++r) xg += F.PS[row * 32 + 8 + r] * w2r[r];
            ea[tid] = expf(logsigf_(xg) * (1.f / 16.f));
        } else if (tid >= 256) { vv[tid - 256] = bf2f(F.P[row * NP + PC_LV + h * 256 + (tid - 256)]); }
        __syncthreads();
        const float vvv = vv[v]; float part = 0.f;
#pragma unroll
        for (int i = 0; i < 64; ++i) { const int k = kh * 64 + i; s[i] = ea[k] * s[i] + kv[k] * vvv; part += qv[k] * s[i]; }
        red[kh * 256 + v] = part;
        __syncthreads();
        if (tid < 256) F.Y[row * YW + YC_GLA + h * 256 + tid] = (bf16)f2bf(red[tid] + red[256 + tid]);
    }
}
__device__ __forceinline__ void sb_naive(Frame& F, int w, int NW) {
    const int lane = opq(F.lane);
    for (int qi = w; qi < BG * 4 * SEQ; qi += NW) {
        const int bh = __builtin_amdgcn_readfirstlane(qi >> 11), t = __builtin_amdgcn_readfirstlane(qi & 2047), bl = bh >> 2, h = bh & 3;
        const size_t row = (size_t)bl * SEQ + t;
        const v4u* qp = (const v4u*)(F.P + row * NP + PC_SQ + h * 128);
        v4u qr[16];
#pragma unroll
        for (int i = 0; i < 16; ++i) qr[i] = qp[i];
        float acc0 = 0.f, acc1 = 0.f, R = 0.f;
        for (int kb = (t - 1) >> 6; kb >= 0; --kb) {
            const int s = kb * 64 + lane; const bool valid = s < t; const int sc = valid ? s : (t - 1);
            const v4u* kp = (const v4u*)(F.P + ((size_t)bl * SEQ + sc) * NP + PC_SK + h * 128);
            float dot = 0.f;
#pragma unroll
            for (int i = 0; i < 16; ++i) { const v4u kw = kp[i]; const v4u qw = qr[i];
                dot += bflo(kw.x) * bflo(qw.x) + bfhi(kw.x) * bfhi(qw.x) + bflo(kw.y) * bflo(qw.y) + bfhi(kw.y) * bfhi(qw.y)
                     + bflo(kw.z) * bflo(qw.z) + bfhi(kw.z) * bfhi(qw.z) + bflo(kw.w) * bflo(qw.w) + bfhi(kw.w) * bfhi(qw.w); }
            const float z = dot * 0.08838834764831845f;
            const float l1m = valid ? logsigf_(-z) : 0.f;
            float incl = l1m;
#pragma unroll
            for (int off = 1; off < 64; off <<= 1) { const float tmp = __shfl_down(incl, off); incl += (lane + off < 64) ? tmp : 0.f; }
            const float tail = R + incl - l1m;
            const float wgt = valid ? expf(logsigf_(z) + tail) : 0.f;
            R += __shfl(incl, 0);
            const bf16* vbase = F.P + ((size_t)bl * SEQ + kb * 64) * NP + PC_SV + h * 128 + 2 * lane;
            for (int j = 0; j < 64; ++j) { const float wj = __shfl(wgt, j);
                if (wj != 0.f) { const unsigned vw = *(const unsigned*)(vbase + (size_t)j * NP); acc0 += wj * bflo(vw); acc1 += wj * bfhi(vw); } }
            if (R < -104.f) break;
        }
        const unsigned zw = *(const unsigned*)(F.P + row * NP + PC_SZ + h * 128 + 2 * lane);
        *(unsigned*)(F.Y + row * YW + YC_SB + h * 128 + 2 * lane) = pk2(acc0 * bflo(zw), acc1 * bfhi(zw));
    }
}
typedef short bf16x8 __attribute__((ext_vector_type(8)));
__device__ __forceinline__ f32x4 mm16(const LAS bf16* A, int lda, int m0, const LAS bf16* Bt, int ldb, int n0, int K, int lane, f32x4 acc) {
    const LAS bf16* ap = A + (m0 + (lane & 15)) * lda + (lane >> 4) * 8;
    const LAS bf16* bp = Bt + (n0 + (lane & 15)) * ldb + (lane >> 4) * 8;
#pragma unroll
    for (int k0 = 0; k0 < K; k0 += 32) acc = __builtin_amdgcn_mfma_f32_16x16x32_bf16(*(const LAS bf16x8*)(ap + k0), *(const LAS bf16x8*)(bp + k0), acc, 0, 0, 0);
    return acc;
}
__device__ __forceinline__ v2u pk4(const f32x4 a) { v2u r; r.x = pk2(a[0], a[1]); r.y = pk2(a[2], a[3]); return r; }

constexpr int GP_QS = 0, GP_KN = 17408, GP_AM = 34816, GP_QK = 54272, GP_TM = 63488, GP_VBT = 72704, GP_KBT = 91136, GP_KDT = 109568, GP_SC = 128000;
constexpr int GP_UBT = 17408, GP_WKT = 35840;
__device__ __forceinline__ void conv16(const Frame& F, const bf16* prow, int pos, const float* cw, float (&y)[16]) {
#pragma unroll
    for (int e = 0; e < 16; ++e) y[e] = 0.f;
#pragma unroll
    for (int tap = 0; tap < 4; ++tap) {
        const int dt = tap - 3;
        if (pos + dt >= 0) {
            const v4u w0 = *(const v4u*)(prow + (long)dt * NP), w1 = *(const v4u*)(prow + (long)dt * NP + 8);
            const f32x4 c0 = *(const f32x4*)(cw + tap * 1536), c1 = *(const f32x4*)(cw + tap * 1536 + 4), c2 = *(const f32x4*)(cw + tap * 1536 + 8), c3 = *(const f32x4*)(cw + tap * 1536 + 12);
            y[0] += c0[0] * bflo(w0.x); y[1] += c0[1] * bfhi(w0.x); y[2] += c0[2] * bflo(w0.y); y[3] += c0[3] * bfhi(w0.y);
            y[4] += c1[0] * bflo(w0.z); y[5] += c1[1] * bfhi(w0.z); y[6] += c1[2] * bflo(w0.w); y[7] += c1[3] * bfhi(w0.w);
            y[8] += c2[0] * bflo(w1.x); y[9] += c2[1] * bfhi(w1.x); y[10] += c2[2] * bflo(w1.y); y[11] += c2[3] * bfhi(w1.y);
            y[12] += c3[0] * bflo(w1.z); y[13] += c3[1] * bfhi(w1.z); y[14] += c3[2] * bflo(w1.w); y[15] += c3[3] * bfhi(w1.w);
        }
    }
#pragma unroll
    for (int e = 0; e < 16; ++e) y[e] = siluf_(y[e]);
}
__device__ __forceinline__ void gdn_pre_unit(Frame& F, int l, int unit) {
    const int tid = opq(F.tid), lane = tid & 63, w = __builtin_amdgcn_readfirstlane(tid >> 6);
    const int n = unit & 31, bh = unit >> 5, bl = bh >> 2, h = bh & 3;
    LAS bf16* Qs = (LAS bf16*)(F.lds + GP_QS); LAS bf16* Kn = (LAS bf16*)(F.lds + GP_KN); LAS float* Am = (LAS float*)(F.lds + GP_AM);
    LAS bf16* QKm = (LAS bf16*)(F.lds + GP_QK); LAS bf16* Tm = (LAS bf16*)(F.lds + GP_TM); LAS bf16* VbT = (LAS bf16*)(F.lds + GP_VBT);
    LAS bf16* KbT = (LAS bf16*)(F.lds + GP_KBT); LAS bf16* KdT = (LAS bf16*)(F.lds + GP_KDT); LAS bf16* UbT = (LAS bf16*)(F.lds + GP_UBT); LAS bf16* WkT = (LAS bf16*)(F.lds + GP_WKT);
    LAS float* gamA = (LAS float*)(F.lds + GP_SC); LAS float* betaA = gamA + 64; LAS float* gA = betaA + 64;
    const int row0 = bl * SEQ + n * 64;
    if (tid < 64) {
        const float db = F.PS[(size_t)(row0 + tid) * 32 + h], da = F.PS[(size_t)(row0 + tid) * 32 + 4 + h];
        betaA[tid] = sigmoidf_(db);
        gA[tid] = -expf(F.gdn_a_log[l * 4 + h]) * softplusf_(da + F.gdn_dt_bias[l * 4 + h]);
    }
    __syncthreads();
    const int i = tid >> 3, sub = tid & 7, c16 = sub * 16;
    float gam_i = 0.f, gl = 0.f;
    for (int j = 0; j < 64; ++j) { const float gj = gA[j]; gl += gj; if (j <= i) gam_i += gj; }
    const float beta_i = betaA[i];
    if (sub == 0) gamA[i] = gam_i;
    {
        const int pos = n * 64 + i;
        const bf16* prow = F.P + (size_t)(row0 + i) * NP + PC_DQ + h * 128 + c16;
        const float* cw = F.gdn_conv + (size_t)l * 4 * 1536 + h * 128 + c16;
        float y[16];
        conv16(F, prow, pos, cw, y);
        { float ss = 0.f;
#pragma unroll
          for (int e = 0; e < 16; ++e) ss += y[e] * y[e];
          ss += __shfl_xor(ss, 1); ss += __shfl_xor(ss, 2); ss += __shfl_xor(ss, 4);
          const float r = 0.08838834764831845f / sqrtf(ss + L2_EPS);
          v4u o0, o1; o0.x = pk2(y[0] * r, y[1] * r); o0.y = pk2(y[2] * r, y[3] * r); o0.z = pk2(y[4] * r, y[5] * r); o0.w = pk2(y[6] * r, y[7] * r);
          o1.x = pk2(y[8] * r, y[9] * r); o1.y = pk2(y[10] * r, y[11] * r); o1.z = pk2(y[12] * r, y[13] * r); o1.w = pk2(y[14] * r, y[15] * r);
          *(LAS v4u*)(Qs + i * 136 + c16) = o0; *(LAS v4u*)(Qs + i * 136 + c16 + 8) = o1; }
        conv16(F, prow + 512, pos, cw + 512, y);
        { float ss = 0.f;
#pragma unroll
          for (int e = 0; e < 16; ++e) ss += y[e] * y[e];
          ss += __shfl_xor(ss, 1); ss += __shfl_xor(ss, 2); ss += __shfl_xor(ss, 4);
          const float r = 1.f / sqrtf(ss + L2_EPS);
#pragma unroll
          for (int e = 0; e < 16; ++e) y[e] *= r;
          v4u o0, o1; o0.x = pk2(y[0], y[1]); o0.y = pk2(y[2], y[3]); o0.z = pk2(y[4], y[5]); o0.w = pk2(y[6], y[7]);
          o1.x = pk2(y[8], y[9]); o1.y = pk2(y[10], y[11]); o1.z = pk2(y[12], y[13]); o1.w = pk2(y[14], y[15]);
          *(LAS v4u*)(Kn + i * 136 + c16) = o0; *(LAS v4u*)(Kn + i * 136 + c16 + 8) = o1;
          const float fb = beta_i * __expf(gam_i), fd = __expf(gl - gam_i);
#pragma unroll
          for (int e = 0; e < 16; ++e) { KbT[(c16 + e) * 72 + i] = (bf16)f2bf(y[e] * fb); KdT[(c16 + e) * 72 + i] = (bf16)f2bf(y[e] * fd); } }
        conv16(F, prow + 1024, pos, cw + 1024, y);
#pragma unroll
        for (int e = 0; e < 16; ++e) VbT[(c16 + e) * 72 + i] = (bf16)f2bf(y[e] * beta_i);
    }
    __syncthreads();
#pragma unroll
    for (int t = 0; t < 2; ++t) {
        const int idx = 2 * w + t, mb = idx >> 2, nb = idx & 3;
        const f32x4 z4 = {0.f, 0.f, 0.f, 0.f};
        const f32x4 akk = mm16(Kn, 136, mb * 16, Kn, 136, nb * 16, 128, lane, z4);
        const f32x4 aqk = mm16(Qs, 136, mb * 16, Kn, 136, nb * 16, 128, lane, z4);
        const int j = nb * 16 + (lane & 15); const float gj = gamA[j];
#pragma unroll
        for (int e = 0; e < 4; ++e) { const int ii = mb * 16 + 4 * (lane >> 4) + e; const float dc = __expf(fminf(gamA[ii] - gj, 0.f));
            Am[ii * 68 + j] = (ii > j) ? betaA[ii] * akk[e] * dc : 0.f;
            QKm[ii * 72 + j] = (bf16)f2bf((ii >= j) ? aqk[e] * dc : 0.f); }
    }
    __syncthreads();
    if (w == 0) {
        float Tc[64];
#pragma clang loop unroll(full)
        for (int ii = 0; ii < 64; ++ii) {
            float s = (ii == lane) ? 1.f : 0.f;
#pragma clang loop unroll(full)
            for (int j = 0; j < ii; ++j) s -= Am[ii * 68 + j] * Tc[j];
            Tc[ii] = s;
            Tm[ii * 72 + lane] = (bf16)f2bf(s);
        }
    }
    __syncthreads();
#pragma unroll 1
    for (int b = 0; b < 8; ++b) {
        const int idx = w * 8 + b, which = idx >> 5, mb = (idx & 31) >> 3, nb = idx & 7;
        const f32x4 z4 = {0.f, 0.f, 0.f, 0.f};
        const f32x4 a = mm16(Tm, 72, mb * 16, which ? KbT : VbT, 72, nb * 16, 64, lane, z4);
        LAS bf16* dst = which ? WkT : UbT;
        *(LAS v2u*)(dst + (nb * 16 + (lane & 15)) * 72 + mb * 16 + 4 * (lane >> 4)) = pk4(a);
    }
    __syncthreads();
    bf16* gWN = (bf16*)(F.wsb + WS_GD_WN) + (size_t)unit * 16384; bf16* gBT = (bf16*)(F.wsb + WS_GD_BT) + (size_t)unit * 16384;
    bf16* gQE = (bf16*)(F.wsb + WS_GD_QE) + (size_t)unit * 8192; bf16* gOL = (bf16*)(F.wsb + WS_GD_OL) + (size_t)unit * 8192;
    if (tid == 0) ((float*)(F.wsb + WS_GD_CD))[unit] = __expf(gl);
#pragma unroll 1
    for (int b = 0; b < 24; ++b) {
        const int idx = w * 24 + b;
        const f32x4 z4 = {0.f, 0.f, 0.f, 0.f};
        const int q4 = 4 * (lane >> 4), c = lane & 15;
        if (idx < 64) {
            const int mb = idx >> 3, nb = idx & 7;
            f32x4 a = mm16(WkT, 72, mb * 16, KdT, 72, nb * 16, 64, lane, z4);
            a = -a;
            *(v2u*)(gWN + (nb * 16 + c) * 128 + mb * 16 + q4) = pk4(a);
        } else if (idx < 128) {
            const int x = idx - 64, mb = x >> 3, nb = x & 7;
            const f32x4 a = mm16(KdT, 72, mb * 16, UbT, 72, nb * 16, 64, lane, z4);
            *(v2u*)(gBT + (nb * 16 + c) * 128 + mb * 16 + q4) = pk4(a);
        } else if (idx < 160) {
            const int x = idx - 128, mb = x >> 2, nb = x & 3;
            const f32x4 a = mm16(WkT, 72, mb * 16, QKm, 72, nb * 16, 64, lane, z4);
            const int ii = nb * 16 + c, d0 = mb * 16 + q4; const float eg = __expf(gamA[ii]);
            const v2u qw = *(const LAS v2u*)(Qs + ii * 136 + d0);
            f32x4 r; r[0] = bflo(qw.x) * eg - a[0]; r[1] = bfhi(qw.x) * eg - a[1]; r[2] = bflo(qw.y) * eg - a[2]; r[3] = bfhi(qw.y) * eg - a[3];
            *(v2u*)(gQE + ii * 128 + d0) = pk4(r);
        } else {
            const int x = idx - 160, mb = x >> 3, nb = x & 7;
            const f32x4 a = mm16(QKm, 72, mb * 16, UbT, 72, nb * 16, 64, lane, z4);
            *(v2u*)(gOL + (nb * 16 + c) * 64 + mb * 16 + q4) = pk4(a);
        }
    }
    __syncthreads();
}
__device__ __forceinline__ void gdn_chain(Frame& F, int bh) {
    const int tid = opq(F.tid), lane = tid & 63, w = __builtin_amdgcn_readfirstlane(tid >> 6);
    LAS bf16* Wl = (LAS bf16*)F.lds;
    LAS bf16* Sw = (LAS bf16*)(F.lds + 34816) + w * (16 * 136);
    const bf16* gWN = (const bf16*)(F.wsb + WS_GD_WN) + (size_t)bh * 32 * 16384;
    const bf16* gBT = (const bf16*)(F.wsb + WS_GD_BT) + (size_t)bh * 32 * 16384;
    bf16* gST = (bf16*)(F.wsb + WS_GD_ST) + (size_t)bh * 32 * 16384;
    const float* gCD = (const float*)(F.wsb + WS_GD_CD) + bh * 32;
    f32x4 acc[8];
#pragma unroll
    for (int mb = 0; mb < 8; ++mb) acc[mb] = (f32x4){0.f, 0.f, 0.f, 0.f};
    v4u wreg[4];
#pragma unroll
    for (int k = 0; k < 4; ++k) { const int p = tid + 512 * k; wreg[k] = *(const v4u*)(gWN + (size_t)(p >> 4) * 128 + (p & 15) * 8); }
    const int c = lane & 15, q4 = 4 * (lane >> 4);
    for (int n = 0; n < 32; ++n) {
        __syncthreads();
#pragma unroll
        for (int k = 0; k < 4; ++k) { const int p = tid + 512 * k; *(LAS v4u*)(Wl + (p >> 4) * 136 + (p & 15) * 8) = wreg[k]; }
#pragma unroll
        for (int mb = 0; mb < 8; ++mb) { const v2u pk = pk4(acc[mb]);
            *(LAS v2u*)(Sw + c * 136 + mb * 16 + q4) = pk;
            *(v2u*)(gST + (size_t)n * 16384 + (16 * w + c) * 128 + mb * 16 + q4) = pk; }
        __syncthreads();
        if (n + 1 < 32) {
#pragma unroll
            for (int k = 0; k < 4; ++k) { const int p = tid + 512 * k; wreg[k] = *(const v4u*)(gWN + (size_t)(n + 1) * 16384 + (size_t)(p >> 4) * 128 + (p & 15) * 8); } }
        const float cd = gCD[n];
#pragma unroll
        for (int mb = 0; mb < 8; ++mb) {
            const v2u bw = *(const v2u*)(gBT + (size_t)n * 16384 + (16 * w + c) * 128 + mb * 16 + q4);
            f32x4 a = acc[mb] * cd; a[0] += bflo(bw.x); a[1] += bfhi(bw.x); a[2] += bflo(bw.y); a[3] += bfhi(bw.y);
            acc[mb] = mm16(Wl, 136, mb * 16, Sw, 136, 0, 128, lane, a);
        }
    }
    __syncthreads();
}
__device__ __forceinline__ void gdn_post_unit(Frame& F, int l, int unit) {
    const int tid = opq(F.tid), lane = tid & 63, w = __builtin_amdgcn_readfirstlane(tid >> 6);
    const int n = unit & 31, bh = unit >> 5, bl = bh >> 2, h = bh & 3;
    LAS bf16* QEl = (LAS bf16*)F.lds;
    LAS bf16* STl = (LAS bf16*)(F.lds + 17408);
    LAS float* Of = (LAS float*)(F.lds + 52224);
    const bf16* gQE = (const bf16*)(F.wsb + WS_GD_QE) + (size_t)unit * 8192; const bf16* gST = (const bf16*)(F.wsb + WS_GD_ST) + (size_t)unit * 16384;
    const bf16* gOL = (const bf16*)(F.wsb + WS_GD_OL) + (size_t)unit * 8192;
#pragma unroll
    for (int k = 0; k < 2; ++k) { const int p = tid + 512 * k; *(LAS v4u*)(QEl + (p >> 4) * 136 + (p & 15) * 8) = *(const v4u*)(gQE + (size_t)(p >> 4) * 128 + (p & 15) * 8); }
#pragma unroll
    for (int k = 0; k < 4; ++k) { const int p = tid + 512 * k; *(LAS v4u*)(STl + (p >> 4) * 136 + (p & 15) * 8) = *(const v4u*)(gST + (size_t)(p >> 4) * 128 + (p & 15) * 8); }
    __syncthreads();
    const int c = lane & 15, q4 = 4 * (lane >> 4);
#pragma unroll
    for (int t = 0; t < 4; ++t) {
        const int mb = w >> 1, nb = (w & 1) * 4 + t, dv = nb * 16 + c, i0 = mb * 16 + q4;
        const v2u ow = *(const v2u*)(gOL + dv * 64 + i0);
        f32x4 a; a[0] = bflo(ow.x); a[1] = bfhi(ow.x); a[2] = bflo(ow.y); a[3] = bfhi(ow.y);
        a = mm16(QEl, 136, mb * 16, STl, 136, nb * 16, 128, lane, a);
#pragma unroll
        for (int e = 0; e < 4; ++e) Of[(i0 + e) * 132 + dv] = a[e];
    }
    __syncthreads();
    {
        const int i = tid >> 3, sub = tid & 7, c16 = sub * 16; const size_t row = (size_t)bl * SEQ + n * 64 + i;
        float x[16]; float ss = 0.f;
#pragma unroll
        for (int e = 0; e < 16; ++e) { x[e] = Of[i * 132 + c16 + e]; ss += x[e] * x[e]; }
        ss += __shfl_xor(ss, 1); ss += __shfl_xor(ss, 2); ss += __shfl_xor(ss, 4);
        const float r = 1.f / sqrtf(ss * (1.f / 128.f) + RMS_EPS);
        const float* gn = F.gdn_onorm + l * 128 + c16;
        const v4u z0 = *(const v4u*)(F.P + row * NP + PC_DZ + h * 128 + c16), z1 = *(const v4u*)(F.P + row * NP + PC_DZ + h * 128 + c16 + 8);
        const float zg[16] = {bflo(z0.x), bfhi(z0.x), bflo(z0.y), bfhi(z0.y), bflo(z0.z), bfhi(z0.z), bflo(z0.w), bfhi(z0.w), bflo(z1.x), bfhi(z1.x), bflo(z1.y), bfhi(z1.y), bflo(z1.z), bfhi(z1.z), bflo(z1.w), bfhi(z1.w)};
#pragma unroll
        for (int e = 0; e < 16; ++e) x[e] = x[e] * r * gn[e] * zg[e];
        v4u o0, o1; o0.x = pk2(x[0], x[1]); o0.y = pk2(x[2], x[3]); o0.z = pk2(x[4], x[5]); o0.w = pk2(x[6], x[7]);
        o1.x = pk2(x[8], x[9]); o1.y = pk2(x[10], x[11]); o1.z = pk2(x[12], x[13]); o1.w = pk2(x[14], x[15]);
        bf16* yp = F.Y + row * YW + YC_GDN + h * 128 + c16;
        *(v4u*)yp = o0; *(v4u*)(yp + 8) = o1;
    }
    __syncthreads();
}
constexpr size_t WS_GL_BS = 40 * MiB;
constexpr size_t WS_GL_AN = 619 * MiB;
constexpr int GL_LA = 0, GL_QD = 33792, GL_KT = 51200, GL_ATT = 68608, GL_VT = 77824, GL_LR = 114688, GL_GL = 118784;
__device__ __forceinline__ void gla_gam(Frame& F, int l, int h, int row0, int tid) {
    LAS float* laL = (LAS float*)(F.lds + GL_LA); LAS float* lrL = (LAS float*)(F.lds + GL_LR); LAS float* glL = (LAS float*)(F.lds + GL_GL);
#pragma unroll
    for (int k = 0; k < 2; ++k) { const int p = tid + 512 * k; lrL[p] = F.PS[(size_t)(row0 + (p >> 4)) * 32 + 8 + (p & 15)]; }
    const int d = tid & 127, ig = tid >> 7;
    float w2r[16]; const float bb = F.gla_b[l * 512 + h * 128 + d];
#pragma unroll
    for (int r = 0; r < 16; ++r) w2r[r] = F.gla_w2[((size_t)l * 16 + r) * 512 + h * 128 + d];
    __syncthreads();
#pragma unroll 4
    for (int ii = 0; ii < 16; ++ii) { const int i = ig * 16 + ii; float x = bb;
#pragma unroll
        for (int r = 0; r < 16; ++r) x += lrL[i * 16 + r] * w2r[r];
        laL[i * 132 + d] = logsigf_(x) * (1.f / 16.f); }
    __syncthreads();
    if (tid < 128) { float run = 0.f;
        for (int i = 0; i < 64; ++i) { run += laL[i * 132 + tid]; laL[i * 132 + tid] = run; }
        glL[tid] = run; }
    __syncthreads();
}
__device__ __forceinline__ void gla_pre_unit(Frame& F, int l, int unit) {
    const int tid = opq(F.tid), lane = tid & 63, w = __builtin_amdgcn_readfirstlane(tid >> 6);
    const int n = unit & 31, bh = unit >> 5, bl = bh >> 2, h = bh & 3, row0 = bl * SEQ + n * 64;
    LAS float* laL = (LAS float*)(F.lds + GL_LA); LAS float* glL = (LAS float*)(F.lds + GL_GL);
    LAS bf16* KdT = (LAS bf16*)(F.lds + GL_QD);
    LAS bf16* VT = (LAS bf16*)(F.lds + GL_VT);
    gla_gam(F, l, h, row0, tid);
    {
        const int i = tid >> 3, sub = tid & 7;
        const bf16* kp = F.P + (size_t)(row0 + i) * NP + PC_LK + h * 128 + sub * 16;
        const v4u k0 = *(const v4u*)kp, k1 = *(const v4u*)(kp + 8);
        const float kk[16] = {bflo(k0.x), bfhi(k0.x), bflo(k0.y), bfhi(k0.y), bflo(k0.z), bfhi(k0.z), bflo(k0.w), bfhi(k0.w), bflo(k1.x), bfhi(k1.x), bflo(k1.y), bfhi(k1.y), bflo(k1.z), bfhi(k1.z), bflo(k1.w), bfhi(k1.w)};
#pragma unroll
        for (int e = 0; e < 16; ++e) { const int d = sub * 16 + e; KdT[d * 72 + i] = (bf16)f2bf(kk[e] * __expf(glL[d] - laL[i * 132 + d])); }
        const bf16* vp = F.P + (size_t)(row0 + i) * NP + PC_LV + h * 256 + sub * 32;
#pragma unroll
        for (int k = 0; k < 4; ++k) { const v4u vw = *(const v4u*)(vp + 8 * k); const int dv = sub * 32 + 8 * k;
            VT[(dv + 0) * 72 + i] = (bf16)(vw.x & 0xffff); VT[(dv + 1) * 72 + i] = (bf16)(vw.x >> 16); VT[(dv + 2) * 72 + i] = (bf16)(vw.y & 0xffff); VT[(dv + 3) * 72 + i] = (bf16)(vw.y >> 16);
            VT[(dv + 4) * 72 + i] = (bf16)(vw.z & 0xffff); VT[(dv + 5) * 72 + i] = (bf16)(vw.z >> 16); VT[(dv + 6) * 72 + i] = (bf16)(vw.w & 0xffff); VT[(dv + 7) * 72 + i] = (bf16)(vw.w >> 16); }
        if (tid < 128) ((float*)(F.wsb + WS_GL_AN))[(size_t)unit * 128 + tid] = __expf(glL[tid]);
    }
    __syncthreads();
    bf16* gBS = (bf16*)(F.wsb + WS_GL_BS) + (size_t)unit * 32768;
    const int c = lane & 15, q4 = 4 * (lane >> 4);
#pragma unroll 1
    for (int b = 0; b < 16; ++b) {
        const int idx = w * 16 + b, mb = idx >> 4, nb = idx & 15;
        const f32x4 z4 = {0.f, 0.f, 0.f, 0.f};
        const f32x4 a = mm16(KdT, 72, mb * 16, VT, 72, nb * 16, 64, lane, z4);
        *(v2u*)(gBS + (nb * 16 + c) * 128 + mb * 16 + q4) = pk4(a);
    }
    __syncthreads();
}
__device__ __forceinline__ void gla_scan(Frame& F, int bidx, int nblk) {
    const int tid = opq(F.tid);
    for (int item = bidx * NTHREADS + tid; item < BG * 4 * 4096; item += nblk * NTHREADS) {
        const int bh = item >> 12, rem = item & 4095, dv = rem >> 4, d8 = (rem & 15) * 8;
        bf16* base = (bf16*)(F.wsb + WS_GL_BS) + (size_t)bh * 32 * 32768 + dv * 128 + d8;
        const float* an = (const float*)(F.wsb + WS_GL_AN) + (size_t)bh * 32 * 128 + d8;
        float s[8];
#pragma unroll
        for (int e = 0; e < 8; ++e) s[e] = 0.f;
#pragma unroll 4
        for (int n = 0; n < 32; ++n) {
            const v4u bw = *(const v4u*)(base + (size_t)n * 32768);
            const f32x4 a0 = *(const f32x4*)(an + n * 128), a1 = *(const f32x4*)(an + n * 128 + 4);
            if (n >= 1) { v4u o; o.x = pk2(s[0], s[1]); o.y = pk2(s[2], s[3]); o.z = pk2(s[4], s[5]); o.w = pk2(s[6], s[7]); *(v4u*)(base + (size_t)(n - 1) * 32768) = o; }
            s[0] = a0[0] * s[0] + bflo(bw.x); s[1] = a0[1] * s[1] + bfhi(bw.x); s[2] = a0[2] * s[2] + bflo(bw.y); s[3] = a0[3] * s[3] + bfhi(bw.y);
            s[4] = a1[0] * s[4] + bflo(bw.z); s[5] = a1[1] * s[5] + bfhi(bw.z); s[6] = a1[2] * s[6] + bflo(bw.w); s[7] = a1[3] * s[7] + bfhi(bw.w);
        }
    }
}
__device__ __forceinline__ void gla_post_unit(Frame& F, int l, int unit) {
    const int tid = opq(F.tid), lane = tid & 63, w = __builtin_amdgcn_readfirstlane(tid >> 6);
    const int n = unit & 31, bh = unit >> 5, bl = bh >> 2, h = bh & 3, row0 = bl * SEQ + n * 64;
    LAS float* laL = (LAS float*)(F.lds + GL_LA);
    LAS bf16* QdL = (LAS bf16*)(F.lds + GL_QD); LAS bf16* KtL = (LAS bf16*)(F.lds + GL_KT); LAS bf16* AttL = (LAS bf16*)(F.lds + GL_ATT); LAS bf16* VT = (LAS bf16*)(F.lds + GL_VT);
    LAS float* Of = (LAS float*)F.lds;
    gla_gam(F, l, h, row0, tid);
    {
        const int i = tid >> 3, sub = tid & 7;
        const bf16* qp = F.P + (size_t)(row0 + i) * NP + PC_LQ + h * 128 + sub * 16;
        const v4u q0 = *(const v4u*)qp, q1 = *(const v4u*)(qp + 8), k0 = *(const v4u*)(qp + 512), k1 = *(const v4u*)(qp + 520);
        const float qq[16] = {bflo(q0.x), bfhi(q0.x), bflo(q0.y), bfhi(q0.y), bflo(q0.z), bfhi(q0.z), bflo(q0.w), bfhi(q0.w), bflo(q1.x), bfhi(q1.x), bflo(q1.y), bfhi(q1.y), bflo(q1.z), bfhi(q1.z), bflo(q1.w), bfhi(q1.w)};
        const float kk[16] = {bflo(k0.x), bfhi(k0.x), bflo(k0.y), bfhi(k0.y), bflo(k0.z), bfhi(k0.z), bflo(k0.w), bfhi(k0.w), bflo(k1.x), bfhi(k1.x), bflo(k1.y), bfhi(k1.y), bflo(k1.z), bfhi(k1.z), bflo(k1.w), bfhi(k1.w)};
        float qd[16], kt[16];
#pragma unroll
        for (int e = 0; e < 16; ++e) { const float gm = laL[i * 132 + sub * 16 + e]; qd[e] = qq[e] * 0.08838834764831845f * __expf(gm); kt[e] = kk[e] * __expf(-gm); }
        v4u o0, o1; o0.x = pk2(qd[0], qd[1]); o0.y = pk2(qd[2], qd[3]); o0.z = pk2(qd[4], qd[5]); o0.w = pk2(qd[6], qd[7]);
        o1.x = pk2(qd[8], qd[9]); o1.y = pk2(qd[10], qd[11]); o1.z = pk2(qd[12], qd[13]); o1.w = pk2(qd[14], qd[15]);
        *(LAS v4u*)(QdL + i * 136 + sub * 16) = o0; *(LAS v4u*)(QdL + i * 136 + sub * 16 + 8) = o1;
        o0.x = pk2(kt[0], kt[1]); o0.y = pk2(kt[2], kt[3]); o0.z = pk2(kt[4], kt[5]); o0.w = pk2(kt[6], kt[7]);
        o1.x = pk2(kt[8], kt[9]); o1.y = pk2(kt[10], kt[11]); o1.z = pk2(kt[12], kt[13]); o1.w = pk2(kt[14], kt[15]);
        *(LAS v4u*)(KtL + i * 136 + sub * 16) = o0; *(LAS v4u*)(KtL + i * 136 + sub * 16 + 8) = o1;
        const bf16* vp = F.P + (size_t)(row0 + i) * NP + PC_LV + h * 256 + sub * 32;
#pragma unroll
        for (int k = 0; k < 4; ++k) { const v4u vw = *(const v4u*)(vp + 8 * k); const int dv = sub * 32 + 8 * k;
            VT[(dv + 0) * 72 + i] = (bf16)(vw.x & 0xffff); VT[(dv + 1) * 72 + i] = (bf16)(vw.x >> 16); VT[(dv + 2) * 72 + i] = (bf16)(vw.y & 0xffff); VT[(dv + 3) * 72 + i] = (bf16)(vw.y >> 16);
            VT[(dv + 4) * 72 + i] = (bf16)(vw.z & 0xffff); VT[(dv + 5) * 72 + i] = (bf16)(vw.z >> 16); VT[(dv + 6) * 72 + i] = (bf16)(vw.w & 0xffff); VT[(dv + 7) * 72 + i] = (bf16)(vw.w >> 16); }
    }
    __syncthreads();
    const int c = lane & 15, q4 = 4 * (lane >> 4);
#pragma unroll
    for (int t = 0; t < 2; ++t) {
        const int idx = 2 * w + t, mb = idx >> 2, nb = idx & 3;
        const f32x4 z4 = {0.f, 0.f, 0.f, 0.f};
        const f32x4 a = mm16(QdL, 136, mb * 16, KtL, 136, nb * 16, 128, lane, z4);
        const int j = nb * 16 + c;
#pragma unroll
        for (int e = 0; e < 4; ++e) { const int ii = mb * 16 + q4 + e; AttL[ii * 72 + j] = (bf16)f2bf((ii >= j) ? a[e] : 0.f); }
    }
    __syncthreads();
    f32x4 acc[2][4];
    const bf16* gS = (const bf16*)(F.wsb + WS_GL_BS) + (size_t)(unit - 1) * 32768;
#pragma unroll
    for (int t = 0; t < 2; ++t) {
        const int nb = 2 * w + t;
        bf16x8 bfr[4];
#pragma unroll
        for (int ks = 0; ks < 4; ++ks) { if (n >= 1) bfr[ks] = *(const bf16x8*)(gS + (size_t)(nb * 16 + c) * 128 + ks * 32 + 8 * (lane >> 4)); else bfr[ks] = (bf16x8){0, 0, 0, 0, 0, 0, 0, 0}; }
#pragma unroll
        for (int mb = 0; mb < 4; ++mb) {
            f32x4 a = {0.f, 0.f, 0.f, 0.f};
#pragma unroll
            for (int ks = 0; ks < 4; ++ks) a = __builtin_amdgcn_mfma_f32_16x16x32_bf16(*(const LAS bf16x8*)(QdL + (mb * 16 + c) * 136 + ks * 32 + 8 * (lane >> 4)), bfr[ks], a, 0, 0, 0);
            acc[t][mb] = mm16(AttL, 72, mb * 16, VT, 72, nb * 16, 64, lane, a);
        }
    }
    __syncthreads();
#pragma unroll
    for (int t = 0; t < 2; ++t)
#pragma unroll
        for (int mb = 0; mb < 4; ++mb)
#pragma unroll
            for (int e = 0; e < 4; ++e) Of[(mb * 16 + q4 + e) * 260 + (2 * w + t) * 16 + c] = acc[t][mb][e];
    __syncthreads();
    {
        const int i = tid >> 3, sub = tid & 7, c32 = sub * 32; const size_t row = (size_t)row0 + i;
        float x[32]; float ss = 0.f;
#pragma unroll
        for (int e = 0; e < 32; ++e) { x[e] = Of[i * 260 + c32 + e]; ss += x[e] * x[e]; }
        ss += __shfl_xor(ss, 1); ss += __shfl_xor(ss, 2); ss += __shfl_xor(ss, 4);
        const float r = 1.f / sqrtf(ss * (1.f / 256.f) + RMS_EPS);
        const float* gn = F.gla_onorm + l * 256 + c32;
        const bf16* zp = F.P + row * NP + PC_LZ + h * 256 + c32; bf16* yp = F.Y + row * YW + YC_GLA + h * 256 + c32;
#pragma unroll
        for (int k = 0; k < 4; ++k) { const v4u zw = *(const v4u*)(zp + 8 * k);
            const float zg[8] = {bflo(zw.x), bfhi(zw.x), bflo(zw.y), bfhi(zw.y), bflo(zw.z), bfhi(zw.z), bflo(zw.w), bfhi(zw.w)};
            float y[8];
#pragma unroll
            for (int e = 0; e < 8; ++e) y[e] = x[8 * k + e] * r * gn[8 * k + e] * zg[e];
            v4u o; o.x = pk2(y[0], y[1]); o.y = pk2(y[2], y[3]); o.z = pk2(y[4], y[5]); o.w = pk2(y[6], y[7]);
            *(v4u*)(yp + 8 * k) = o; }
    }
    __syncthreads();
}
constexpr int SB_QS = 0, SB_KS = 34816, SB_VT = 52224, SB_FL = 70656;
__device__ __forceinline__ void sb_unit(Frame& F, int unit) {
    const int tid = opq(F.tid), lane = tid & 63, w = __builtin_amdgcn_readfirstlane(tid >> 6);
    const int qt = ((unit >> 8) & 1) ? (unit & 15) : 15 - (unit & 15), bh = unit >> 4, bl = bh >> 2, h = bh & 3;
    LAS bf16* Qs = (LAS bf16*)(F.lds + SB_QS); LAS bf16* Ks = (LAS bf16*)(F.lds + SB_KS); LAS bf16* Vt = (LAS bf16*)(F.lds + SB_VT);
    volatile LAS unsigned* flags = (volatile LAS unsigned*)(F.lds + SB_FL);
    const size_t rowb = (size_t)bl * SEQ;
    const int c = lane & 15, q = lane >> 4, q4 = 4 * q;
#pragma unroll
    for (int k = 0; k < 4; ++k) { const int p = tid + 512 * k; *(LAS v4u*)(Qs + (p >> 4) * 136 + (p & 15) * 8) = *(const v4u*)(F.P + (rowb + qt * 128 + (p >> 4)) * NP + PC_SQ + h * 128 + (p & 15) * 8); }
    f32x4 o[8];
#pragma unroll
    for (int mb = 0; mb < 8; ++mb) o[mb] = (f32x4){0.f, 0.f, 0.f, 0.f};
    float R = 0.f;
    const int t = qt * 128 + 16 * w + c;
    for (int kb = 2 * qt + 1; kb >= 0; --kb) {
        {
            const int key = tid >> 3, sub = tid & 7;
            const bf16* kp = F.P + (rowb + kb * 64 + key) * NP + PC_SK + h * 128 + sub * 16;
            const v4u k0 = *(const v4u*)kp, k1 = *(const v4u*)(kp + 8), v0 = *(const v4u*)(kp + 512), v1 = *(const v4u*)(kp + 520);
            *(LAS v4u*)(Ks + key * 136 + sub * 16) = k0; *(LAS v4u*)(Ks + key * 136 + sub * 16 + 8) = k1;
            const int d0 = sub * 16;
            Vt[(d0 + 0) * 72 + key] = (bf16)(v0.x & 0xffff); Vt[(d0 + 1) * 72 + key] = (bf16)(v0.x >> 16); Vt[(d0 + 2) * 72 + key] = (bf16)(v0.y & 0xffff); Vt[(d0 + 3) * 72 + key] = (bf16)(v0.y >> 16);
            Vt[(d0 + 4) * 72 + key] = (bf16)(v0.z & 0xffff); Vt[(d0 + 5) * 72 + key] = (bf16)(v0.z >> 16); Vt[(d0 + 6) * 72 + key] = (bf16)(v0.w & 0xffff); Vt[(d0 + 7) * 72 + key] = (bf16)(v0.w >> 16);
            Vt[(d0 + 8) * 72 + key] = (bf16)(v1.x & 0xffff); Vt[(d0 + 9) * 72 + key] = (bf16)(v1.x >> 16); Vt[(d0 + 10) * 72 + key] = (bf16)(v1.y & 0xffff); Vt[(d0 + 11) * 72 + key] = (bf16)(v1.y >> 16);
            Vt[(d0 + 12) * 72 + key] = (bf16)(v1.z & 0xffff); Vt[(d0 + 13) * 72 + key] = (bf16)(v1.z >> 16); Vt[(d0 + 14) * 72 + key] = (bf16)(v1.w & 0xffff); Vt[(d0 + 15) * 72 + key] = (bf16)(v1.w >> 16);
        }
        __syncthreads();
        const bool active = (kb * 64 < qt * 128 + 16 * w + 15);
        if (active) {
            float wgt[4][4], l1m[4][4], tot[4], hi[4];
#pragma unroll
            for (int kk = 0; kk < 4; ++kk) {
                const f32x4 z4 = {0.f, 0.f, 0.f, 0.f};
                const f32x4 a = mm16(Ks, 136, kk * 16, Qs, 136, 16 * w, 128, lane, z4);
                float g = 0.f;
#pragma unroll
                for (int e = 0; e < 4; ++e) {
                    const int s = kb * 64 + kk * 16 + q4 + e; const bool valid = s < t;
                    const float z = a[e] * 0.08838834764831845f;
                    const float sp = fmaxf(z, 0.f) + __logf(1.f + __expf(-fabsf(z)));
                    l1m[kk][e] = valid ? -sp : 0.f;
                    wgt[kk][e] = valid ? (z - sp) : -1e30f;
                    g += l1m[kk][e];
                }
                const float b = __shfl_xor(g, 16), pr = g + b, d = __shfl_xor(pr, 32);
                hi[kk] = ((q & 1) == 0 ? b : 0.f) + ((q & 2) == 0 ? d : 0.f);
                tot[kk] = pr + d;
            }
            float after = R;
#pragma unroll
            for (int kk = 3; kk >= 0; --kk) {
                float tail = after + hi[kk];
#pragma unroll
                for (int e = 3; e >= 0; --e) { const float lw = wgt[kk][e] + tail; wgt[kk][e] = __expf(lw); tail += l1m[kk][e]; }
                after += tot[kk];
            }
            R = after;
#pragma unroll
            for (int ks = 0; ks < 2; ++ks) {
                v4u pb; pb.x = pk2(wgt[2 * ks][0], wgt[2 * ks][1]); pb.y = pk2(wgt[2 * ks][2], wgt[2 * ks][3]); pb.z = pk2(wgt[2 * ks + 1][0], wgt[2 * ks + 1][1]); pb.w = pk2(wgt[2 * ks + 1][2], wgt[2 * ks + 1][3]);
                const bf16x8 bfrag = __builtin_bit_cast(bf16x8, pb);
#pragma unroll
                for (int mb = 0; mb < 8; ++mb) {
                    const LAS bf16* vp = Vt + (mb * 16 + c) * 72 + 32 * ks + q4;
                    const v2u lo = *(const LAS v2u*)vp, hi2 = *(const LAS v2u*)(vp + 16);
                    v4u av; av.x = lo.x; av.y = lo.y; av.z = hi2.x; av.w = hi2.y;
                    o[mb] = __builtin_amdgcn_mfma_f32_16x16x32_bf16(__builtin_bit_cast(bf16x8, av), bfrag, o[mb], 0, 0, 0);
                }
            }
        }
        const bool done = __all(R < -104.f || !active) && active;
        if (lane == 0) flags[w] = done ? 1u : 0u;
        __syncthreads();
        unsigned alldone = 1u;
#pragma unroll
        for (int k = 0; k < 8; ++k) alldone &= flags[k];
        if (alldone) break;
    }
    {
        const size_t row = rowb + qt * 128 + 16 * w + c;
#pragma unroll
        for (int mb = 0; mb < 8; ++mb) {
            const int d = mb * 16 + q4;
            const v2u zw = *(const v2u*)(F.P + row * NP + PC_SZ + h * 128 + d);
            v2u ow; ow.x = pk2(o[mb][0] * bflo(zw.x), o[mb][1] * bfhi(zw.x)); ow.y = pk2(o[mb][2] * bflo(zw.y), o[mb][3] * bfhi(zw.y));
            *(v2u*)(F.Y + row * YW + YC_SB + h * 128 + d) = ow;
        }
    }
    __syncthreads();
}
__device__ __forceinline__ void phase_mix_naive(Frame& F, int l) {
    const int bx = blockIdx.x;
    if (bx < 32) gdn_chain(F, bx);
    else if (bx < 64) gla_scan(F, bx - 32, 32);
    else for (int u = bx - 64; u < BG * 4 * 16; u += F.G - 64) sb_unit(F, u);
}
__device__ __forceinline__ void phase_post(Frame& F, int l) {
    const int gw = blockIdx.x * NWAVES + F.wave, NGW = F.G * NWAVES, lane = opq(F.lane);
    for (int m = gw; m < TG; m += NGW) {
#pragma unroll
        for (int ps = 1; ps < 3; ++ps) {
            const int e = (ps == 0) ? lane * 8 : (ps - 1) * 512 + lane * 8;
            bf16* yp = F.Y + (size_t)m * YW + (ps == 0 ? YC_GDN : YC_GLA) + e;
            const bf16* zp = F.P + (size_t)m * NP + (ps == 0 ? PC_DZ : PC_LZ) + e;
            const v4u w = *(const v4u*)yp, zw = *(const v4u*)zp;
            float x[8] = {bflo(w.x), bfhi(w.x), bflo(w.y), bfhi(w.y), bflo(w.z), bfhi(w.z), bflo(w.w), bfhi(w.w)};
            const float zg[8] = {bflo(zw.x), bfhi(zw.x), bflo(zw.y), bfhi(zw.y), bflo(zw.z), bfhi(zw.z), bflo(zw.w), bfhi(zw.w)};
            float ss = 0.f;
#pragma unroll
            for (int i = 0; i < 8; ++i) ss += x[i] * x[i];
            ss += __shfl_xor(ss, 1); ss += __shfl_xor(ss, 2); ss += __shfl_xor(ss, 4); ss += __shfl_xor(ss, 8);
            float r; const float* gn;
            if (ps == 0) { r = 1.f / sqrtf(ss * (1.f / 128.f) + RMS_EPS); gn = F.gdn_onorm + l * 128 + (lane & 15) * 8; }
            else { ss += __shfl_xor(ss, 16); r = 1.f / sqrtf(ss * (1.f / 256.f) + RMS_EPS); gn = F.gla_onorm + l * 256 + (lane & 31) * 8; }
#pragma unroll
            for (int i = 0; i < 8; ++i) x[i] = x[i] * r * gn[i] * zg[i];
            v4u o; o.x = pk2(x[0], x[1]); o.y = pk2(x[2], x[3]); o.z = pk2(x[4], x[5]); o.w = pk2(x[6], x[7]);
            *(v4u*)yp = o;
        }
    }
}

__global__ void __launch_bounds__(NTHREADS, 2) fwd_kernel(Args args) {
    extern __shared__ __attribute__((aligned(16))) unsigned char lds_raw[];
    Frame F;
    F.lds = (LAS unsigned char*)lds_raw;
    volatile LAS unsigned* MISC = (volatile LAS unsigned*)(F.lds + MISC_OFF);
    F.tid = threadIdx.x; F.lane = F.tid & 63; F.wave = __builtin_amdgcn_readfirstlane(F.tid >> 6); F.G = gridDim.x;
    unsigned char* ws = args.ws;
    F.x = args.in[0]; F.c = args.in[1]; F.ada_w = args.in[2]; F.ada_b = args.in[3]; F.norm_g = args.in[4]; F.w_in = args.in[5]; F.sb_qnorm = args.in[6]; F.sb_knorm = args.in[7];
    F.gdn_conv = args.in[8]; F.gdn_a_log = args.in[9]; F.gdn_dt_bias = args.in[10]; F.gdn_onorm = args.in[11]; F.gla_w2 = args.in[12]; F.gla_b = args.in[13]; F.gla_onorm = args.in[14];
    F.merge_b = args.in[15]; F.proj_sb = args.in[16]; F.proj_gdn = args.in[17]; F.proj_gla = args.in[18]; F.w_out = args.in[19];
    F.out = args.out; F.wsb = ws;
    F.MODP = (float*)(ws + WS_MODP); F.MODA = (float*)(ws + WS_MOD); F.MODB = F.MODA + DEPTH * BATCH * D; F.MODG = F.MODB + DEPTH * BATCH * D;
    F.PS = (float*)(ws + WS_PS); F.MGF = (float*)(ws + WS_MGF);
    F.WIN = (bf16*)(ws + WS_WIN); F.WP = (bf16*)(ws + WS_WP); F.WO = (bf16*)(ws + WS_WO); F.H = (bf16*)(ws + WS_H); F.MGB = (bf16*)(ws + WS_MGB);
    F.P = (bf16*)(ws + WS_P); F.Y = (bf16*)(ws + WS_Y); F.GQKV = (bf16*)(ws + WS_H);
    for (int u = F.tid; u < 32; u += NTHREADS) MISC[u] = 0u;
    __syncthreads();
    XcdBarrier bar = xcd_barrier_post((unsigned*)(ws + WS_CTL) + CW_BAR, MISC + 8);
#define GRID_BAR() xcd_barrier(bar)

    p0_ada(F);
    GRID_BAR();
    p1_mod(F);
    GRID_BAR();
    for (int l = 0; l < DEPTH; ++l) {
        const float* xin = (l == 0) ? F.x : F.out;
        for (int g = 0; g < NGRP; ++g) {
            if (g == 0) wconv_layer(F, l);
            phase_norm(F, xin, l, g);
            GRID_BAR();
#ifndef NO_G1
            {   pg8::Gemm gm{F.H, F.WIN, D, D, D}; pg8::StaticOrder S; S.init(TG, NWT, F.G, (int)blockIdx.x);
                EpiG1 E{F.P, F.PS, F.merge_b + l * 3072};
                pg8::gemm_phase<EpiG1, pg8::StaticOrder, true>(F.lds, gm, S, E); }
#endif
            GRID_BAR();
            phase_prep(F, l);
            for (int u = blockIdx.x; u < BG * 4 * 32; u += F.G) gdn_pre_unit(F, l, u);
            for (int u = blockIdx.x; u < BG * 4 * 32; u += F.G) gla_pre_unit(F, l, u);
            GRID_BAR();
#ifndef NO_MIX
            phase_mix_naive(F, l);
#endif
            GRID_BAR();
            for (int u = blockIdx.x; u < BG * 4 * 32; u += F.G) gdn_post_unit(F, l, u);
            for (int u = blockIdx.x; u < BG * 4 * 32; u += F.G) gla_post_unit(F, l, u);
            GRID_BAR();
#ifndef NO_G2
            {   pg8::StaticOrder S; S.init(TG, D, F.G, (int)blockIdx.x);
                const bf16* wp = F.WP;
                {   pg8::Gemm gm{F.Y + YC_SB, wp, YW, 2048, 512}; EpiG2<0> E{F.P, PC_MG, F.MGF, F.MGB};
                    pg8::gemm_phase<EpiG2<0>, pg8::StaticOrder, false>(F.lds, gm, S, E); }
                {   pg8::Gemm gm{F.Y + YC_GDN, wp + 512, YW, 2048, 512}; EpiG2<1> E{F.P, PC_MG + D, F.MGF, F.MGB};
                    pg8::gemm_phase<EpiG2<1>, pg8::StaticOrder, false>(F.lds, gm, S, E); }
                {   pg8::Gemm gm{F.Y + YC_GLA, wp + 1024, YW, 2048, 1024}; EpiG2<2> E{F.P, PC_MG + 2 * D, F.MGF, F.MGB};
                    pg8::gemm_phase<EpiG2<2>, pg8::StaticOrder, false>(F.lds, gm, S, E); } }
#endif
            GRID_BAR();
#ifndef NO_G3
            {   pg8::Gemm gm{F.MGB, F.WO, D, D, D}; pg8::StaticOrder S; S.init(TG, D, F.G, (int)blockIdx.x);
                EpiG3 E{xin, F.out, F.MODG + (size_t)l * BATCH * D, g * TG};
                pg8::gemm_phase<EpiG3, pg8::StaticOrder, false>(F.lds, gm, S, E); }
#endif
            GRID_BAR();
        }
    }
}

extern "C" void kernel_launch(void* const* d_in, const int* in_sizes, int n_in, void* d_out, int out_size, void* d_ws, size_t ws_size, hipStream_t stream) {
    static int grid = 0;
    if (grid == 0) {
        if (n_in != 20 || out_size != T * D || ws_size < WS_END) { fprintf(stderr, "kernel_launch: unexpected shapes / workspace (%d inputs, out %d, ws %zu)\n", n_in, out_size, ws_size); grid = -1; return; }
        int dev = 0, cus = 0, per_cu = 0;
        if (hipGetDevice(&dev) != hipSuccess || hipDeviceGetAttribute(&cus, hipDeviceAttributeMultiprocessorCount, dev) != hipSuccess) { grid = -1; return; }
        if (hipFuncSetAttribute((const void*)fwd_kernel, hipFuncAttributeMaxDynamicSharedMemorySize, LDS_BYTES) != hipSuccess) { grid = -1; return; }
        if (hipOccupancyMaxActiveBlocksPerMultiprocessor(&per_cu, (const void*)fwd_kernel, NTHREADS, LDS_BYTES) != hipSuccess || per_cu < 1) fprintf(stderr, "kernel_launch: occupancy query reports %d\n", per_cu);
        (void)hipGetLastError();
        grid = cus;
    }
    if (grid < 0) return;
    if (hipMemsetAsync((char*)d_ws + WS_CTL, 0, CTL_ZERO_BYTES, stream) != hipSuccess) return;
    Args a{};
    for (int i = 0; i < 20; ++i) a.in[i] = (const float*)d_in[i];
    a.out = (float*)d_out; a.ws = (unsigned char*)d_ws; a.ph_lo = 0; a.ph_hi = 0;
    hipLaunchKernelGGL(fwd_kernel, dim3(grid), dim3(NTHREADS), LDS_BYTES, stream, a);
}
```

```cpp
#include <hip/hip_runtime.h>
#include <cstdio>
#include <cstdint>

#define GAS __attribute__((address_space(1)))
#define LAS __attribute__((address_space(3)))

#define XB_TMO      128
#define XB_XCNT(j)  (256  + 64 * (j))
#define XB_XSUB(j)  (1280 + 64 * (j))
#define XB_XGEN(j)  (2304 + 64 * (j))
#define XB_TOP      3328
#define XB_TOPGEN   3392
#define XCD_BAR_WORDS 3456
#define XB_SPIN_CAP (1u << 24)

__device__ __forceinline__ unsigned xb_ld(unsigned* p)              { return __hip_atomic_load(p, __ATOMIC_RELAXED, __HIP_MEMORY_SCOPE_AGENT); }
__device__ __forceinline__ unsigned xb_add(unsigned* p, unsigned v) { return __hip_atomic_fetch_add(p, v, __ATOMIC_RELAXED, __HIP_MEMORY_SCOPE_AGENT); }
__device__ __forceinline__ unsigned xb_xcc_id() { return (unsigned)__builtin_amdgcn_s_getreg((3 << 11) | 20) & 0xFu; }
#define XB_SPIN(cond, bar) do { unsigned _sp = 0; while (cond) { __builtin_amdgcn_s_sleep(1); \
    if ((++_sp & 255u) == 0u) { if (xb_ld(&(bar)[XB_TMO])) break; if (_sp > XB_SPIN_CAP) { atomicAdd(&(bar)[XB_TMO], 1u); break; } } } } while (0)

struct XcdBarrier { unsigned* bar; unsigned x; volatile LAS unsigned* st; };

__device__ __forceinline__ XcdBarrier xcd_barrier_post(unsigned* bar, volatile LAS unsigned* st) {
    XcdBarrier b; b.bar = bar; b.x = xb_xcc_id(); b.st = st;
    if (threadIdx.x == 0) (void)xb_add(&bar[XB_XCNT(b.x)], 1u);
    return b;
}
__device__ __forceinline__ void xcd_barrier_complete(unsigned* bar, unsigned x, unsigned& nloc, unsigned& nx) {
    const unsigned G = gridDim.x * gridDim.y * gridDim.z;
    unsigned sum, cnt, mine, sp = 0u;
    for (;;) {
        sum = 0u; cnt = 0u; mine = 0u;
#pragma unroll
        for (unsigned j = 0; j < 16; ++j) { const unsigned c = xb_ld(&bar[XB_XCNT(j)]); sum += c; cnt += (c > 0u) ? 1u : 0u; mine = (j == x) ? c : mine; }
        if (sum == G) break;
        __builtin_amdgcn_s_sleep(1);
        if ((++sp & 255u) == 0u) { if (xb_ld(&bar[XB_TMO])) break; if (sp > XB_SPIN_CAP) { atomicAdd(&bar[XB_TMO], 1u); break; } }
    }
    nloc = mine > 0u ? mine : 1u; nx = cnt > 0u ? cnt : 1u;
}
__device__ __forceinline__ void xcd_barrier(const XcdBarrier& b) {
    asm volatile("s_waitcnt vmcnt(0)" ::: "memory");
    __syncthreads();
    if (threadIdx.x == 0) {
        unsigned* bar = b.bar;
        __builtin_amdgcn_s_waitcnt(0);
        unsigned nloc = b.st[0], nx = b.st[1];
        if (nloc == 0u) { xcd_barrier_complete(bar, b.x, nloc, nx); b.st[0] = nloc; b.st[1] = nx; }
        const unsigned old = xb_add(&bar[XB_XSUB(b.x)], 1u);
        const unsigned gen = old / nloc;
        if (old + 1u == (gen + 1u) * nloc) {
            __builtin_amdgcn_fence(__ATOMIC_RELEASE, "agent");
            asm volatile("s_waitcnt vmcnt(0)" ::: "memory");
            const unsigned og = xb_add(&bar[XB_TOP], 1u);
            const unsigned tg = og / nx;
            if (og + 1u == (tg + 1u) * nx) xb_add(&bar[XB_TOPGEN], 1u);
            else XB_SPIN(xb_ld(&bar[XB_TOPGEN]) == tg, bar);
            __builtin_amdgcn_fence(__ATOMIC_ACQUIRE, "agent");
            xb_add(&bar[XB_XGEN(b.x)], 1u);
            asm volatile("s_waitcnt vmcnt(0)" ::: "memory");
        } else {
            XB_SPIN(xb_ld(&bar[XB_XGEN(b.x)]) == gen, bar);
            __builtin_amdgcn_fence(__ATOMIC_ACQUIRE, "agent");
            asm volatile("s_waitcnt vmcnt(0)" ::: "memory");
        }
    }
    __syncthreads();
}
namespace pg8 {
#define PG8_LAS __attribute__((address_space(3)))
typedef unsigned short bf16_t;
typedef short bf16x8 __attribute__((ext_vector_type(8)));
typedef float f32x4 __attribute__((ext_vector_type(4)));
typedef unsigned u32x4 __attribute__((ext_vector_type(4)));
typedef unsigned u32x2 __attribute__((ext_vector_type(2)));
constexpr int BM = 256, BK = 64, HALF = 128, HTB = HALF * BK * 2, STAGE_BYTES = 8 * HTB, NXCD = 8, WGM = 8;

__host__ __device__ __forceinline__ int lds_byte(int r, int c) { const int st = (r >> 4) * 2 + (c >> 5), rr = r & 15, cc = c & 31, ob = rr * 64 + cc * 2; return st * 1024 + (ob ^ (((ob >> 9) & 1) << 5)); }
__host__ __device__ __forceinline__ void stage_rc(int b, int& R, int& C) { const int st = b / 1024, sb = b % 1024, swz = sb ^ (((sb >> 9) & 1) << 5); R = (st >> 1) * 16 + swz / 64; C = (st & 1) * 32 + (swz % 64) / 2; }
__host__ __device__ __forceinline__ int perm32(int rho) { const int n = rho >> 4, i = rho & 15; return 8 * (i >> 2) + 4 * n + (i & 3); }

struct Unit { int pm, pn, seg; };
struct Gemm { const bf16_t* A; const bf16_t* Bt; int lda, ldb, K; };

struct StaticOrder {
    int nM, nN, nwg, G, c;
    __host__ __device__ void init(int M, int N, int G_, int c_) { nM = M / BM; nN = N / BM; nwg = nM * nN; G = G_; c = c_; }
    __host__ __device__ bool next(int i, Unit& u) const {
        const long L = (long)i * G + c; if (L >= nwg) return false;
        int wgid = (int)L; { const int q = nwg / NXCD, r = nwg % NXCD, xcd = wgid % NXCD, off = wgid / NXCD; wgid = (xcd < r ? xcd * (q + 1) : r * (q + 1) + (xcd - r) * q) + off; }
        const int nig = WGM * nN, gid = wgid / nig, fm = gid * WGM, gsz = (nM - fm) < WGM ? (nM - fm) : WGM;
        u.pm = fm + ((wgid % nig) % gsz); u.pn = (wgid % nig) / gsz; u.seg = 0; return true;
    }
    __device__ __forceinline__ size_t k_off(const Unit&) const { return 0; }
    __device__ __forceinline__ void a_ready(const Unit&) const {}
    __device__ __forceinline__ void done(const Unit&) const {}
};

template <int NSEG> struct SegOrder : StaticOrder {
    int segk;
    __host__ __device__ bool next(int i, Unit& u) const { if (!StaticOrder::next(i / NSEG, u)) return false; u.seg = i % NSEG; return true; }
    __device__ __forceinline__ size_t k_off(const Unit& u) const { return (size_t)u.seg * segk * 2; }
};
__device__ __forceinline__ unsigned cvt_pk_bf16(float lo, float hi) { unsigned r; asm volatile("v_cvt_pk_bf16_f32 %0, %1, %2" : "=v"(r) : "v"(lo), "v"(hi)); return r; }

template <class Epi, class Sched, bool ALIGN_EPI>
__device__ __forceinline__ void gemm_phase(PG8_LAS unsigned char* lds, const Gemm g, const Sched& S, const Epi& E) {
    int tid = threadIdx.x; asm volatile("" : "+v"(tid));
    const int wid = __builtin_amdgcn_readfirstlane(tid >> 6), lane = tid & 63, wr = wid >> 2, wc = wid & 3, fr = lane & 15, fq = lane >> 4;
    const int K = g.K, nt = K / BK;
    unsigned voffA[2], voffB[2];
#pragma unroll
    for (int i = 0; i < 2; ++i) { int R, C; stage_rc(tid * 16 + i * 8192, R, C); const int Rb = Epi::PERM ? ((R & ~31) + perm32(R & 31)) : R;
        voffA[i] = (unsigned)(R * g.lda + C) * 2u; voffB[i] = (unsigned)(Rb * g.ldb + C) * 2u; }
    const size_t kstep = (size_t)(BK * 2);
    const size_t hstepA = (size_t)HALF * g.lda * 2, hstepB = (size_t)HALF * g.ldb * 2;
    const size_t tstepA = 2 * hstepA, tstepB = 2 * hstepB;
    const unsigned ldsw = (unsigned)wid * 1024u;
    const int aoff = lds_byte(wr * 64 + fr, fq * 8), boff = lds_byte(wc * 32 + fr, fq * 8);
#define PG8_SA(b, h) (((b) * 2 + (h)) * HTB)
#define PG8_SB(b, h) ((4 + (b) * 2 + (h)) * HTB)
#define PG8_STAGE(bufoff, gbase, voff) do { _Pragma("unroll") for (int _i = 0; _i < 2; ++_i) \
        __builtin_amdgcn_global_load_lds((const unsigned*)((const char*)(gbase) + (voff)[_i]), (PG8_LAS unsigned*)(lds + (bufoff) + ldsw + _i * 8192), 16, 0, 0); } while (0)
#define PG8_LDA(dst, b, h) do { _Pragma("unroll") for (int m = 0; m < 4; ++m) _Pragma("unroll") for (int k = 0; k < 2; ++k) dst[m][k] = *(const PG8_LAS bf16x8*)(lds + PG8_SA(b, h) + aoff + m * 2048 + k * 1024); } while (0)
#define PG8_LDB(dst, b, h) do { _Pragma("unroll") for (int n = 0; n < 2; ++n) _Pragma("unroll") for (int k = 0; k < 2; ++k) dst[n][k] = *(const PG8_LAS bf16x8*)(lds + PG8_SB(b, h) + boff + n * 2048 + k * 1024); } while (0)
#define PG8_MMA(ai, bj, At, Bt) do { __builtin_amdgcn_s_setprio(1); _Pragma("unroll") for (int m = 0; m < 4; ++m) _Pragma("unroll") for (int n = 0; n < 2; ++n) _Pragma("unroll") for (int k = 0; k < 2; ++k) \
        acc[ai][bj][m][n] = __builtin_amdgcn_mfma_f32_16x16x32_bf16(Bt[n][k], At[m][k], acc[ai][bj][m][n], 0, 0, 0); __builtin_amdgcn_s_setprio(0); } while (0)
#define PG8_WAIT_V(n) asm volatile("s_waitcnt vmcnt(" #n ")" ::: "memory")
#define PG8_WAIT_L(n) asm volatile("s_waitcnt lgkmcnt(" #n ")" ::: "memory")
#define PG8_BAR __builtin_amdgcn_s_barrier()
#define PG8_SCHED __builtin_amdgcn_sched_barrier(0)
    Unit cur, nxt; int ui = 0;
    if (!S.next(0, cur)) return;
    f32x4 acc[2][2][4][2];
#pragma unroll
    for (int a = 0; a < 2; ++a)
#pragma unroll
        for (int b = 0; b < 2; ++b)
#pragma unroll
            for (int m = 0; m < 4; ++m)
#pragma unroll
                for (int n = 0; n < 2; ++n) acc[a][b][m][n] = (f32x4){0.f, 0.f, 0.f, 0.f};
    bf16x8 At[4][2], B0[2][2], B1[2][2];
    const char* cA = (const char*)g.A + (size_t)cur.pm * tstepA + S.k_off(cur); const char* cB = (const char*)g.Bt + (size_t)cur.pn * tstepB + S.k_off(cur);
    S.a_ready(cur);
    PG8_STAGE(PG8_SB(0, 0), cB, voffB); PG8_STAGE(PG8_SB(0, 1), cB + hstepB, voffB); PG8_STAGE(PG8_SA(0, 0), cA, voffA); PG8_STAGE(PG8_SA(0, 1), cA + hstepA, voffA);
    if (wr == 1) PG8_BAR;
    PG8_WAIT_V(2); PG8_BAR;
    PG8_STAGE(PG8_SB(1, 0), cB + kstep, voffB); PG8_STAGE(PG8_SA(1, 0), cA + kstep, voffA); PG8_STAGE(PG8_SB(1, 1), cB + hstepB + kstep, voffB);
    PG8_WAIT_V(6); PG8_BAR;
    for (;;) {
        const bool has_next = S.next(ui + 1, nxt);
        const char* nA = has_next ? (const char*)g.A + (size_t)nxt.pm * tstepA + S.k_off(nxt) : cA; const char* nB = has_next ? (const char*)g.Bt + (size_t)nxt.pn * tstepB + S.k_off(nxt) : cB;
        for (int t = 0; t < nt; t += 2) {
            const bool last = (t == nt - 2);
            const char* a1 = cA + (size_t)(t + 1) * kstep;
            const char* a2 = last ? nA : cA + (size_t)(t + 2) * kstep; const char* b2 = last ? nB : cB + (size_t)(t + 2) * kstep;
            const char* a3 = a2 + kstep; const char* b3 = b2 + kstep;
            if (last && has_next) S.a_ready(nxt);
            if constexpr (Epi::MID) { if (t == Epi::MID_T0 || t == Epi::MID_T1) E.mid(acc, cur, t, wr, wc, fr, fq); }
            PG8_LDB(B0, 0, 0); PG8_LDB(B1, 0, 1); PG8_SCHED; PG8_LDA(At, 0, 0); PG8_STAGE(PG8_SA(1, 1), a1 + hstepA, voffA);
            PG8_WAIT_V(8); PG8_WAIT_L(0); PG8_BAR; PG8_MMA(0, 0, At, B0); PG8_MMA(0, 1, At, B1); PG8_BAR; PG8_SCHED;
            PG8_LDA(At, 0, 1); PG8_STAGE(PG8_SB(0, 0), b2, voffB); PG8_STAGE(PG8_SB(0, 1), b2 + hstepB, voffB); PG8_STAGE(PG8_SA(0, 0), a2, voffA);
            PG8_WAIT_V(8); PG8_WAIT_L(0); PG8_BAR; PG8_MMA(1, 0, At, B0); PG8_MMA(1, 1, At, B1); PG8_BAR; PG8_SCHED;
            PG8_LDB(B0, 1, 0); PG8_LDB(B1, 1, 1); PG8_SCHED; PG8_LDA(At, 1, 0); PG8_STAGE(PG8_SA(0, 1), a2 + hstepA, voffA);
            PG8_WAIT_V(8); PG8_WAIT_L(0); PG8_BAR; PG8_MMA(0, 0, At, B0); PG8_MMA(0, 1, At, B1); PG8_BAR; PG8_SCHED;
            PG8_LDA(At, 1, 1); PG8_STAGE(PG8_SB(1, 0), b3, voffB); PG8_STAGE(PG8_SB(1, 1), b3 + hstepB, voffB); PG8_STAGE(PG8_SA(1, 0), a3, voffA);
            PG8_WAIT_V(8); PG8_WAIT_L(0); PG8_BAR; PG8_MMA(1, 0, At, B0); PG8_MMA(1, 1, At, B1); PG8_BAR; PG8_SCHED;
        }
        if constexpr (ALIGN_EPI) { if (wr == 0) PG8_BAR; }
        E(acc, cur, wr, wc, fr, fq);
        if (!has_next) break;
        {
#pragma unroll
        for (int a = 0; a < 2; ++a)
#pragma unroll
            for (int b = 0; b < 2; ++b)
#pragma unroll
                for (int m = 0; m < 4; ++m)
#pragma unroll
                    for (int n = 0; n < 2; ++n) acc[a][b][m][n] = (f32x4){0.f, 0.f, 0.f, 0.f};
        }
        cur = nxt; cA = nA; cB = nB; ++ui;
        if constexpr (ALIGN_EPI) { if (wr == 1) PG8_BAR; }
    }
    PG8_WAIT_V(0);
    if constexpr (!ALIGN_EPI) { if (wr == 0) PG8_BAR; }
    PG8_BAR;
#undef PG8_SA
#undef PG8_SB
#undef PG8_STAGE
#undef PG8_LDA
#undef PG8_LDB
#undef PG8_MMA
#undef PG8_WAIT_V
#undef PG8_WAIT_L
#undef PG8_BAR
#undef PG8_SCHED
}
}
constexpr int D = 1024, BATCH = 16, SEQ = 2048, DEPTH = 4, T = BATCH * SEQ;
constexpr int NGRP = 2, TG = T / NGRP, BG = BATCH / NGRP;
constexpr int N_IN = 10264, NP = 10240, NWT = 10496;
constexpr int PC_SQ = 0, PC_SK = 512, PC_SV = 1024, PC_SZ = 1536, PC_DQ = 2048, PC_DZ = 3584, PC_LQ = 4096, PC_LK = 4608, PC_LV = 5120, PC_LZ = 6144, PC_MG = 7168;
constexpr int YC_SB = 0, YC_GDN = 512, YC_GLA = 1024, YW = 2048;
constexpr int NTHREADS = 512, NWAVES = 8;
constexpr float RMS_EPS = 1e-6f, L2_EPS = 1e-6f;

constexpr size_t MiB = 1u << 20;
constexpr size_t WS_CTL = 0, CTL_ZERO_BYTES = 1 * MiB;
constexpr size_t WS_MODP = 2 * MiB;
constexpr size_t WS_MOD = 8 * MiB;
constexpr size_t WS_WIN = 10 * MiB;
constexpr size_t WS_WP = 31 * MiB;
constexpr size_t WS_WO = 35 * MiB;
constexpr size_t WS_H = 40 * MiB;
constexpr size_t WS_MGB = 72 * MiB;
constexpr size_t WS_P = 104 * MiB;
constexpr size_t WS_PS = 424 * MiB;
constexpr size_t WS_Y = 426 * MiB;
constexpr size_t WS_MGF = 490 * MiB;
constexpr size_t WS_END = 640 * MiB;
constexpr size_t WS_GD_WN = 490 * MiB;
constexpr size_t WS_GD_BT = 522 * MiB;
constexpr size_t WS_GD_ST = 554 * MiB;
constexpr size_t WS_GD_QE = 586 * MiB;
constexpr size_t WS_GD_OL = 602 * MiB;
constexpr size_t WS_GD_CD = 618 * MiB;
constexpr int CW_BAR = 4096;

constexpr int RING_BYTES = 131072;
constexpr int MISC_OFF = RING_BYTES + 320;
constexpr int LDS_BYTES = 147456;

typedef unsigned short bf16;
typedef unsigned v4u __attribute__((ext_vector_type(4)));
typedef unsigned v2u __attribute__((ext_vector_type(2)));
typedef float f32x4 __attribute__((ext_vector_type(4)));
#define LDS_WAIT() asm volatile("s_waitcnt lgkmcnt(0)" ::: "memory")

__device__ __forceinline__ float bf2f(unsigned v) { return __uint_as_float(v << 16); }
__device__ __forceinline__ float bflo(unsigned w) { return __uint_as_float(w << 16); }
__device__ __forceinline__ float bfhi(unsigned w) { return __uint_as_float(w & 0xffff0000u); }
__device__ __forceinline__ unsigned f2bf(float f) { unsigned u = __float_as_uint(f); return (u + 0x7fffu + ((u >> 16) & 1u)) >> 16; }
__device__ __forceinline__ unsigned pk2(float lo, float hi) { return f2bf(lo) | (f2bf(hi) << 16); }
__device__ __forceinline__ float sigmoidf_(float x) { return 1.f / (1.f + __expf(-x)); }
__device__ __forceinline__ float siluf_(float x) { return x / (1.f + __expf(-x)); }
__device__ __forceinline__ float softplusf_(float x) { return fmaxf(x, 0.f) + log1pf(expf(-fabsf(x))); }
__device__ __forceinline__ float logsigf_(float x) { return fminf(x, 0.f) - log1pf(expf(-fabsf(x))); }

__device__ __forceinline__ int opq(int v) { asm volatile("" : "+v"(v)); return v; }
struct Args {
    const float* in[20];
    float* out; unsigned char* ws;
    int ph_lo, ph_hi;
};
struct Frame {
    LAS unsigned char* lds;
    int tid, lane, wave, G;
    const float *x, *c, *ada_w, *ada_b, *norm_g, *w_in, *sb_qnorm, *sb_knorm, *gdn_conv, *gdn_a_log, *gdn_dt_bias, *gdn_onorm, *gla_w2, *gla_b, *gla_onorm, *merge_b, *proj_sb, *proj_gdn, *proj_gla, *w_out;
    float* out; unsigned char* wsb;
    float *MODP, *MODA, *MODB, *MODG, *PS, *MGF;
    bf16 *WIN, *WP, *WO, *H, *MGB, *P, *Y, *GQKV;
};

struct EpiG1 {
    static constexpr bool PERM = true, MID = false;
    bf16* P; float* PS; const float* mb;
    __device__ __forceinline__ bool operator()(pg8::f32x4 (&acc)[2][2][4][2], const pg8::Unit& u, int wr, int wc, int fr, int fq) const {
        const int row0 = u.pm * 256 + wr * 64 + fr, pn = u.pn;
        if (pn < 40) {
            const int mode = (pn == 6 || pn == 7 || pn == 14 || pn == 15 || (pn >= 24 && pn < 28)) ? 1 : (pn >= 28 ? 2 : 0);
            const int col0 = pn * 256 + wc * 32 + 8 * fq;
            pg8::f32x4 bv[2][2];
#pragma unroll
            for (int bj = 0; bj < 2; ++bj)
#pragma unroll
                for (int n = 0; n < 2; ++n) bv[bj][n] = (mode == 2) ? *(const pg8::f32x4*)(mb + (col0 - PC_MG) + bj * 128 + 4 * n) : (pg8::f32x4){0.f, 0.f, 0.f, 0.f};
#pragma unroll
            for (int ai = 0; ai < 2; ++ai)
#pragma unroll
                for (int m = 0; m < 4; ++m) { bf16* rowp = P + (size_t)(row0 + ai * 128 + m * 16) * NP + col0;
#pragma unroll
                    for (int bj = 0; bj < 2; ++bj) { pg8::f32x4 v0 = acc[ai][bj][m][0], v1 = acc[ai][bj][m][1];
                        if (mode == 1) {
#pragma unroll
                            for (int j = 0; j < 4; ++j) { v0[j] = siluf_(v0[j]); v1[j] = siluf_(v1[j]); } }
                        else if (mode == 2) { v0 = v0 + bv[bj][0]; v1 = v1 + bv[bj][1];
#pragma unroll
                            for (int j = 0; j < 4; ++j) { v0[j] = sigmoidf_(v0[j]); v1[j] = sigmoidf_(v1[j]); } }
                        pg8::u32x4 w; w.x = pg8::cvt_pk_bf16(v0[0], v0[1]); w.y = pg8::cvt_pk_bf16(v0[2], v0[3]); w.z = pg8::cvt_pk_bf16(v1[0], v1[1]); w.w = pg8::cvt_pk_bf16(v1[2], v1[3]);
                        *(pg8::u32x4*)(rowp + bj * 128) = w; } }
        } else if (wc == 0 && fq < 3) {
#pragma unroll
            for (int ai = 0; ai < 2; ++ai)
#pragma unroll
                for (int m = 0; m < 4; ++m) { float* rowp = PS + (size_t)(row0 + ai * 128 + m * 16) * 32 + 8 * fq;
                    *(pg8::f32x4*)(rowp) = acc[ai][0][m][0]; *(pg8::f32x4*)(rowp + 4) = acc[ai][0][m][1]; }
        }
        return false;
    }
};
struct EpiG2R {
    static constexpr bool PERM = false, MID = true;
    static constexpr int MID_T0 = 8, MID_T1 = 16;
    const bf16* P; bf16* MGB;
    __device__ __forceinline__ void apply(pg8::f32x4 (&acc)[2][2][4][2], const pg8::Unit& u, int which, int wr, int wc, int fr, int fq) const {
        const unsigned row0 = u.pm * 256 + wr * 64 + fr, col0 = u.pn * 256 + wc * 32 + 4 * fq;
        const unsigned gn = (PC_MG + which * D) * 2, gd = (PC_MG + (which + 1) * D) * 2;
        const char* Pb = (const char*)P; char* Mb = (char*)MGB;
#pragma unroll
        for (int ai = 0; ai < 2; ++ai)
#pragma unroll
            for (int m = 0; m < 4; ++m) { const unsigned r = row0 + ai * 128 + m * 16; const unsigned po = (r * NP + col0) * 2u, mo = (r * D + col0) * 2u;
#pragma unroll
                for (int bj = 0; bj < 2; ++bj)
#pragma unroll
                    for (int n = 0; n < 2; ++n) { const unsigned co = (bj * 128 + n * 16) * 2;
                        const pg8::u32x2 gw = *(const pg8::u32x2*)(Pb + (po + gn + co));
                        pg8::f32x4 f; f[0] = bflo(gw.x); f[1] = bfhi(gw.x); f[2] = bflo(gw.y); f[3] = bfhi(gw.y);
                        if (which < 2) { const pg8::u32x2 dw = *(const pg8::u32x2*)(Pb + (po + gd + co));
                            f[0] *= __builtin_amdgcn_rcpf(fmaxf(bflo(dw.x), 1e-30f)); f[1] *= __builtin_amdgcn_rcpf(fmaxf(bfhi(dw.x), 1e-30f));
                            f[2] *= __builtin_amdgcn_rcpf(fmaxf(bflo(dw.y), 1e-30f)); f[3] *= __builtin_amdgcn_rcpf(fmaxf(bfhi(dw.y), 1e-30f)); }
                        const pg8::f32x4 v = acc[ai][bj][m][n] * f;
                        if (which < 2) acc[ai][bj][m][n] = v;
                        else { pg8::u32x2 w; w.x = pg8::cvt_pk_bf16(v[0], v[1]); w.y = pg8::cvt_pk_bf16(v[2], v[3]); *(pg8::u32x2*)(Mb + (mo + co)) = w; }
                        if (n == 1) asm volatile("" ::: "memory"); } }
    }
    __device__ __forceinline__ void mid(pg8::f32x4 (&acc)[2][2][4][2], const pg8::Unit& u, int t, int wr, int wc, int fr, int fq) const { apply(acc, u, t == MID_T0 ? 0 : 1, wr, wc, fr, fq); }
    __device__ __forceinline__ bool operator()(pg8::f32x4 (&acc)[2][2][4][2], const pg8::Unit& u, int wr, int wc, int fr, int fq) const { apply(acc, u, 2, wr, wc, fr, fq); return false; }
};
struct EpiG3 {
    static constexpr bool PERM = false, MID = false;
    const float* xin; float* out; const float* gate; int grow0;
    __device__ __forceinline__ bool operator()(pg8::f32x4 (&acc)[2][2][4][2], const pg8::Unit& u, int wr, int wc, int fr, int fq) const {
        const int row0 = grow0 + u.pm * 256 + wr * 64 + fr, col0 = u.pn * 256 + wc * 32 + 4 * fq;
        const float* gp = gate + (size_t)((grow0 + u.pm * 256) / SEQ) * D;
        pg8::f32x4 gv[2][2];
#pragma unroll
        for (int bj = 0; bj < 2; ++bj)
#pragma unroll
            for (int n = 0; n < 2; ++n) gv[bj][n] = *(const pg8::f32x4*)(gp + col0 + bj * 128 + n * 16);
#pragma unroll
        for (int ai = 0; ai < 2; ++ai)
#pragma unroll
            for (int m = 0; m < 4; ++m) { const size_t off = (size_t)(row0 + ai * 128 + m * 16) * D + col0;
#pragma unroll
                for (int bj = 0; bj < 2; ++bj)
#pragma unroll
                    for (int n = 0; n < 2; ++n) { const pg8::f32x4 xv = *(const pg8::f32x4*)(xin + off + bj * 128 + n * 16);
                        *(pg8::f32x4*)(out + off + bj * 128 + n * 16) = xv + gv[bj][n] * acc[ai][bj][m][n]; } }
        return false;
    }
};

__device__ __forceinline__ void transpose_item(const float* W, int ldw, int col0, bf16* WT, int ldd, int drow0, int dk0, int nblk, LAS float* scr, int item, int lane) {
    const int kb = item / nblk, nb = item % nblk, k0 = 64 * kb, n0 = 32 * nb;
#pragma unroll 8
    for (int i = 0; i < 32; ++i) { const int kk = 2 * i + (lane >> 5); scr[kk * 33 + (lane & 31)] = W[(size_t)(k0 + kk) * ldw + col0 + n0 + (lane & 31)]; }
    LDS_WAIT(); asm volatile("" ::: "memory");
    const int c = lane & 7;
#pragma unroll
    for (int j = 0; j < 4; ++j) { const int n = (lane >> 3) + 8 * j; const LAS float* s = scr + (8 * c) * 33 + n;
        v4u o; o.x = pk2(s[0 * 33], s[1 * 33]); o.y = pk2(s[2 * 33], s[3 * 33]); o.z = pk2(s[4 * 33], s[5 * 33]); o.w = pk2(s[6 * 33], s[7 * 33]);
        *(v4u*)(WT + (size_t)(drow0 + n0 + n) * ldd + dk0 + k0 + 8 * c) = o; }
    LDS_WAIT(); asm volatile("" ::: "memory");
}
__device__ __forceinline__ void p0_ada(Frame& F) {
    LAS float* cact = (LAS float*)F.lds;
    for (int i = F.tid; i < BATCH * D; i += NTHREADS) cact[i] = siluf_(F.c[i]);
    __syncthreads();
    for (int it = blockIdx.x; it < 4 * 8 * 6; it += F.G) {
        const int l = it / 48, ks = (it % 48) / 6, jc = it % 6, j = jc * 512 + F.tid;
        float a[16];
#pragma unroll
        for (int b = 0; b < 16; ++b) a[b] = 0.f;
        const float* wp = F.ada_w + ((size_t)l * D + ks * 128) * 3072 + j;
#pragma unroll 4
        for (int k = 0; k < 128; ++k) { const float w = wp[(size_t)k * 3072];
#pragma unroll
            for (int b = 0; b < 16; ++b) a[b] += cact[b * D + ks * 128 + k] * w; }
#pragma unroll
        for (int b = 0; b < 16; ++b) F.MODP[((size_t)(ks * 4 + l) * 16 + b) * 3072 + j] = a[b];
    }
}
__device__ __forceinline__ void wconv_layer(Frame& F, int l) {
    const int lane = opq(F.lane);
    LAS float* scr = (LAS float*)(F.lds + F.wave * 16384);
    const int gw = blockIdx.x * NWAVES + F.wave, NGW = F.G * NWAVES;
    constexpr int I_A = 16 * 128, I_B = 16 * 96, I_C = 16 * 96, I_SB = 8 * 32, I_GDN = 8 * 32, I_GLA = 16 * 32, I_WO = 16 * 32;
    constexpr int I_L = I_A + I_B + I_C + I_SB + I_GDN + I_GLA + I_WO;
    const float* win = F.w_in + (size_t)l * D * N_IN;
    for (int it = gw; it < I_L; it += NGW) {
        int r = it;
        if (r < I_A) { transpose_item(win, N_IN, 0, F.WIN, D, 0, 0, 128, scr, r, lane); continue; } r -= I_A;
        if (r < I_B) { transpose_item(win, N_IN, 4104, F.WIN, D, 4096, 0, 96, scr, r, lane); continue; } r -= I_B;
        if (r < I_C) { transpose_item(win, N_IN, 7192, F.WIN, D, 7168, 0, 96, scr, r, lane); continue; } r -= I_C;
        if (r < I_SB) { transpose_item(F.proj_sb + (size_t)l * 512 * D, D, 0, F.WP, 2048, 0, 0, 32, scr, r, lane); continue; } r -= I_SB;
        if (r < I_GDN) { transpose_item(F.proj_gdn + (size_t)l * 512 * D, D, 0, F.WP, 2048, 0, 512, 32, scr, r, lane); continue; } r -= I_GDN;
        if (r < I_GLA) { transpose_item(F.proj_gla + (size_t)l * D * D, D, 0, F.WP, 2048, 0, 1024, 32, scr, r, lane); continue; } r -= I_GLA;
        transpose_item(F.w_out + (size_t)l * D * D, D, 0, F.WO, D, 0, 0, 32, scr, r, lane);
    }
    for (int i = blockIdx.x * NTHREADS + opq(F.tid); i < 256 * D; i += F.G * NTHREADS) {
        const int r = i / D, k = i % D;
        float v = 0.f;
        if (r < 8) v = win[(size_t)k * N_IN + 4096 + r];
        else if (r < 24) v = win[(size_t)k * N_IN + 7176 + (r - 8)];
        F.WIN[(size_t)(10240 + r) * D + k] = (bf16)f2bf(v);
    }
    __syncthreads();
}
__device__ __forceinline__ void p1_mod(Frame& F) {
    for (int i = blockIdx.x * NTHREADS + F.tid; i < DEPTH * BATCH * D; i += F.G * NTHREADS) {
        const int l = i / (BATCH * D), b = (i / D) % BATCH, c = i % D;
        float sh = F.ada_b[l * 3072 + c], sc = F.ada_b[l * 3072 + D + c], gt = F.ada_b[l * 3072 + 2 * D + c];
#pragma unroll
        for (int ks = 0; ks < 8; ++ks) { const float* p = F.MODP + ((size_t)(ks * 4 + l) * 16 + b) * 3072; sh += p[c]; sc += p[D + c]; gt += p[2 * D + c]; }
        F.MODA[i] = F.norm_g[l * D + c] * (1.f + sc); F.MODB[i] = sh; F.MODG[i] = gt;
    }
}
__device__ __forceinline__ float wave_sum(float v) {
#pragma unroll
    for (int o = 1; o < 64; o <<= 1) v += __shfl_xor(v, o);
    return v;
}
__device__ __forceinline__ void phase_norm(Frame& F, const float* xin, int l, int g) {
    const int gw = blockIdx.x * NWAVES + F.wave, NGW = F.G * NWAVES, lane = opq(F.lane);
    for (int m = gw; m < TG; m += NGW) {
        const int grow = g * TG + m, b = grow / SEQ;
        const f32x4* xr = (const f32x4*)(xin + (size_t)grow * D) + lane;
        const f32x4* ma = (const f32x4*)(F.MODA + (size_t)(l * BATCH + b) * D) + lane;
        const f32x4* mb = (const f32x4*)(F.MODB + (size_t)(l * BATCH + b) * D) + lane;
        f32x4 v[4]; float s = 0.f;
#pragma unroll
        for (int j = 0; j < 4; ++j) { v[j] = xr[64 * j]; s += (v[j].x * v[j].x + v[j].y * v[j].y) + (v[j].z * v[j].z + v[j].w * v[j].w); }
        const float rstd = 1.f / sqrtf(wave_sum(s) * (1.f / D) + RMS_EPS);
        unsigned long long* o8 = (unsigned long long*)(F.H + (size_t)m * D) + lane;
#pragma unroll
        for (int j = 0; j < 4; ++j) { const f32x4 a = ma[64 * j], sh = mb[64 * j]; const f32x4 y = v[j] * rstd * a + sh;
            o8[64 * j] = (unsigned long long)pk2(y.x, y.y) | ((unsigned long long)pk2(y.z, y.w) << 32); }
    }
}
__device__ __forceinline__ void phase_prep(Frame& F, int l) {
    const int gw = blockIdx.x * NWAVES + F.wave, NGW = F.G * NWAVES, lane = opq(F.lane);
    for (int m = gw; m < TG; m += NGW) {
        {
            bf16* p = F.P + (size_t)m * NP + lane * 16;
            const v4u w0 = *(const v4u*)p, w1 = *(const v4u*)(p + 8);
            float x[16];
            x[0] = bflo(w0.x); x[1] = bfhi(w0.x); x[2] = bflo(w0.y); x[3] = bfhi(w0.y); x[4] = bflo(w0.z); x[5] = bfhi(w0.z); x[6] = bflo(w0.w); x[7] = bfhi(w0.w);
            x[8] = bflo(w1.x); x[9] = bfhi(w1.x); x[10] = bflo(w1.y); x[11] = bfhi(w1.y); x[12] = bflo(w1.z); x[13] = bfhi(w1.z); x[14] = bflo(w1.w); x[15] = bfhi(w1.w);
            float ss = 0.f;
#pragma unroll
            for (int i = 0; i < 16; ++i) ss += x[i] * x[i];
            ss += __shfl_xor(ss, 1); ss += __shfl_xor(ss, 2); ss += __shfl_xor(ss, 4);
            const float r = 1.f / sqrtf(ss * (1.f / 128.f) + RMS_EPS);
            const float* gn = (lane < 32 ? F.sb_qnorm : F.sb_knorm) + l * 128 + (lane & 7) * 16;
#pragma unroll
            for (int i = 0; i < 16; ++i) x[i] = x[i] * r * gn[i];
            v4u o0, o1;
            o0.x = pk2(x[0], x[1]); o0.y = pk2(x[2], x[3]); o0.z = pk2(x[4], x[5]); o0.w = pk2(x[6], x[7]);
            o1.x = pk2(x[8], x[9]); o1.y = pk2(x[10], x[11]); o1.z = pk2(x[12], x[13]); o1.w = pk2(x[14], x[15]);
            *(v4u*)p = o0; *(v4u*)(p + 8) = o1;
        }
    }
}
__device__ __forceinline__ void gdn_chain_naive(Frame& F, int l, int bh) {
    const int bl = bh >> 2, h = bh & 3, tid = opq(F.tid), v = tid & 127, kq = tid >> 7;
    LAS float* qv = (LAS float*)F.lds; LAS float* kv = qv + 128; LAS float* vv = kv + 128; LAS float* sc = vv + 128; LAS float* red = sc + 128; LAS float* red2 = red + 512;
    float s[32];
#pragma unroll
    for (int i = 0; i < 32; ++i) s[i] = 0.f;
    const float Aexp = expf(F.gdn_a_log[l * 4 + h]), dtb = F.gdn_dt_bias[l * 4 + h];
    for (int t = 0; t < SEQ; ++t) {
        const size_t row = (size_t)bl * SEQ + t;
        if (tid < 128) { const bf16* gp = F.GQKV + row * 1536 + h * 128 + tid; qv[tid] = bf2f(gp[0]); kv[tid] = bf2f(gp[512]); vv[tid] = bf2f(gp[1024]); }
        if (tid == 128) { const float db = F.PS[row * 32 + h], da = F.PS[row * 32 + 4 + h]; sc[0] = sigmoidf_(db); sc[1] = expf(-Aexp * softplusf_(da + dtb)); }
        __syncthreads();
        const float eg = sc[1]; float part = 0.f;
#pragma unroll
        for (int i = 0; i < 32; ++i) { s[i] *= eg; part += kv[kq * 32 + i] * s[i]; }
        red[kq * 128 + v] = part;
        __syncthreads();
        const float kS = (red[v] + red[128 + v]) + (red[256 + v] + red[384 + v]);
        const float delta = sc[0] * (vv[v] - kS); float part2 = 0.f;
#pragma unroll
        for (int i = 0; i < 32; ++i) { s[i] += kv[kq * 32 + i] * delta; part2 += qv[kq * 32 + i] * s[i]; }
        red2[kq * 128 + v] = part2;
        __syncthreads();
        if (tid < 128) { const float o = (red2[tid] + red2[128 + tid]) + (red2[256 + tid] + red2[384 + tid]); F.Y[row * YW + YC_GDN + h * 128 + tid] = (bf16)f2bf(o); }
    }
}
__device__ __forceinline__ void gla_chain_naive(Frame& F, int l, int bh) {
    const int bl = bh >> 2, h = bh & 3, tid = opq(F.tid), v = tid & 255, kh = tid >> 8;
    LAS float* qv = (LAS float*)F.lds; LAS float* kv = qv + 128; LAS float* ea = kv + 128; LAS float* vv = ea + 128; LAS float* red = vv + 256;
    float s[64];
#pragma unroll
    for (int i = 0; i < 64; ++i) s[i] = 0.f;
    float w2r[16]; float bb = 0.f;
    if (tid < 128) { bb = F.gla_b[l * 512 + h * 128 + tid];
#pragma unroll
        for (int r = 0; r < 16; ++r) w2r[r] = F.gla_w2[((size_t)l * 16 + r) * 512 + h * 128 + tid]; }
    else {
#pragma unroll
        for (int r = 0; r < 16; ++r) w2r[r] = 0.f; }
    for (int t = 0; t < SEQ; ++t) {
        const size_t row = (size_t)bl * SEQ + t;
        if (tid < 128) {
            const bf16* pp = F.P + row * NP + h * 128 + tid;
            qv[tid] = bf2f(pp[PC_LQ]) * 0.08838834764831845f; kv[tid] = bf2f(pp[PC_LK]);
            float xg = bb;
#pragma unroll
            for (int r = 0; r < 16; ++r) xg += F.PS[row * 32 + 8 + r] * w2r[r];
            ea[tid] = expf(logsigf_(xg) * (1.f / 16.f));
        } else if (tid >= 256) { vv[tid - 256] = bf2f(F.P[row * NP + PC_LV + h * 256 + (tid - 256)]); }
        __syncthreads();
        const float vvv = vv[v]; float part = 0.f;
#pragma unroll
        for (int i = 0; i < 64; ++i) { const int k = kh * 64 + i; s[i] = ea[k] * s[i] + kv[k] * vvv; part += qv[k] * s[i]; }
        red[kh * 256 + v] = part;
        __syncthreads();
        if (tid < 256) F.Y[row * YW + YC_GLA + h * 256 + tid] = (bf16)f2bf(red[tid] + red[256 + tid]);
    }
}
__device__ __forceinline__ void sb_naive(Frame& F, int w, int NW) {
    const int lane = opq(F.lane);
    for (int qi = w; qi < BG * 4 * SEQ; qi += NW) {
        const int bh = __builtin_amdgcn_readfirstlane(qi >> 11), t = __builtin_amdgcn_readfirstlane(qi & 2047), bl = bh >> 2, h = bh & 3;
        const size_t row = (size_t)bl * SEQ + t;
        const v4u* qp = (const v4u*)(F.P + row * NP + PC_SQ + h * 128);
        v4u qr[16];
#pragma unroll
        for (int i = 0; i < 16; ++i) qr[i] = qp[i];
        float acc0 = 0.f, acc1 = 0.f, R = 0.f;
        for (int kb = (t - 1) >> 6; kb >= 0; --kb) {
            const int s = kb * 64 + lane; const bool valid = s < t; const int sc = valid ? s : (t - 1);
            const v4u* kp = (const v4u*)(F.P + ((size_t)bl * SEQ + sc) * NP + PC_SK + h * 128);
            float dot = 0.f;
#pragma unroll
            for (int i = 0; i < 16; ++i) { const v4u kw = kp[i]; const v4u qw = qr[i];
                dot += bflo(kw.x) * bflo(qw.x) + bfhi(kw.x) * bfhi(qw.x) + bflo(kw.y) * bflo(qw.y) + bfhi(kw.y) * bfhi(qw.y)
                     + bflo(kw.z) * bflo(qw.z) + bfhi(kw.z) * bfhi(qw.z) + bflo(kw.w) * bflo(qw.w) + bfhi(kw.w) * bfhi(qw.w); }
            const float z = dot * 0.08838834764831845f;
            const float l1m = valid ? logsigf_(-z) : 0.f;
            float incl = l1m;
#pragma unroll
            for (int off = 1; off < 64; off <<= 1) { const float tmp = __shfl_down(incl, off); incl += (lane + off < 64) ? tmp : 0.f; }
            const float tail = R + incl - l1m;
            const float wgt = valid ? expf(logsigf_(z) + tail) : 0.f;
            R += __shfl(incl, 0);
            const bf16* vbase = F.P + ((size_t)bl * SEQ + kb * 64) * NP + PC_SV + h * 128 + 2 * lane;
            for (int j = 0; j < 64; ++j) { const float wj = __shfl(wgt, j);
                if (wj != 0.f) { const unsigned vw = *(const unsigned*)(vbase + (size_t)j * NP); acc0 += wj * bflo(vw); acc1 += wj * bfhi(vw); } }
            if (R < -104.f) break;
        }
        const unsigned zw = *(const unsigned*)(F.P + row * NP + PC_SZ + h * 128 + 2 * lane);
        *(unsigned*)(F.Y + row * YW + YC_SB + h * 128 + 2 * lane) = pk2(acc0 * bflo(zw), acc1 * bfhi(zw));
    }
}
typedef short bf16x8 __attribute__((ext_vector_type(8)));
__device__ __forceinline__ f32x4 mm16(const LAS bf16* A, int lda, int m0, const LAS bf16* Bt, int ldb, int n0, int K, int lane, f32x4 acc) {
    const LAS bf16* ap = A + (m0 + (lane & 15)) * lda + (lane >> 4) * 8;
    const LAS bf16* bp = Bt + (n0 + (lane & 15)) * ldb + (lane >> 4) * 8;
#pragma unroll
    for (int k0 = 0; k0 < K; k0 += 32) acc = __builtin_amdgcn_mfma_f32_16x16x32_bf16(*(const LAS bf16x8*)(ap + k0), *(const LAS bf16x8*)(bp + k0), acc, 0, 0, 0);
    return acc;
}
__device__ __forceinline__ v2u pk4(const f32x4 a) { v2u r; r.x = pk2(a[0], a[1]); r.y = pk2(a[2], a[3]); return r; }

constexpr int GP_QS = 0, GP_KN = 17408, GP_AM = 34816, GP_QK = 54272, GP_TM = 63488, GP_VBT = 72704, GP_KBT = 91136, GP_KDT = 109568, GP_SC = 128000;
constexpr int GP_UBT = 17408, GP_WKT = 35840;
__device__ __forceinline__ void conv16(const Frame& F, const bf16* prow, int pos, const float* cw, float (&y)[16]) {
#pragma unroll
    for (int e = 0; e < 16; ++e) y[e] = 0.f;
#pragma unroll
    for (int tap = 0; tap < 4; ++tap) {
        const int dt = tap - 3;
        if (pos + dt >= 0) {
            const v4u w0 = *(const v4u*)(prow + (long)dt * NP), w1 = *(const v4u*)(prow + (long)dt * NP + 8);
            const f32x4 c0 = *(const f32x4*)(cw + tap * 1536), c1 = *(const f32x4*)(cw + tap * 1536 + 4), c2 = *(const f32x4*)(cw + tap * 1536 + 8), c3 = *(const f32x4*)(cw + tap * 1536 + 12);
            y[0] += c0[0] * bflo(w0.x); y[1] += c0[1] * bfhi(w0.x); y[2] += c0[2] * bflo(w0.y); y[3] += c0[3] * bfhi(w0.y);
            y[4] += c1[0] * bflo(w0.z); y[5] += c1[1] * bfhi(w0.z); y[6] += c1[2] * bflo(w0.w); y[7] += c1[3] * bfhi(w0.w);
            y[8] += c2[0] * bflo(w1.x); y[9] += c2[1] * bfhi(w1.x); y[10] += c2[2] * bflo(w1.y); y[11] += c2[3] * bfhi(w1.y);
            y[12] += c3[0] * bflo(w1.z); y[13] += c3[1] * bfhi(w1.z); y[14] += c3[2] * bflo(w1.w); y[15] += c3[3] * bfhi(w1.w);
        }
    }
#pragma unroll
    for (int e = 0; e < 16; ++e) y[e] = siluf_(y[e]);
}
__device__ __forceinline__ void gdn_pre_unit(Frame& F, int l, int unit) {
    const int tid = opq(F.tid), lane = tid & 63, w = __builtin_amdgcn_readfirstlane(tid >> 6);
    const int n = unit & 31, bh = unit >> 5, bl = bh >> 2, h = bh & 3;
    LAS bf16* Qs = (LAS bf16*)(F.lds + GP_QS); LAS bf16* Kn = (LAS bf16*)(F.lds + GP_KN); LAS float* Am = (LAS float*)(F.lds + GP_AM);
    LAS bf16* QKm = (LAS bf16*)(F.lds + GP_QK); LAS bf16* Tm = (LAS bf16*)(F.lds + GP_TM); LAS bf16* VbT = (LAS bf16*)(F.lds + GP_VBT);
    LAS bf16* KbT = (LAS bf16*)(F.lds + GP_KBT); LAS bf16* KdT = (LAS bf16*)(F.lds + GP_KDT); LAS bf16* UbT = (LAS bf16*)(F.lds + GP_UBT); LAS bf16* WkT = (LAS bf16*)(F.lds + GP_WKT);
    LAS float* gamA = (LAS float*)(F.lds + GP_SC); LAS float* betaA = gamA + 64; LAS float* gA = betaA + 64;
    const int row0 = bl * SEQ + n * 64;
    if (tid < 64) {
        const float db = F.PS[(size_t)(row0 + tid) * 32 + h], da = F.PS[(size_t)(row0 + tid) * 32 + 4 + h];
        betaA[tid] = sigmoidf_(db);
        gA[tid] = -expf(F.gdn_a_log[l * 4 + h]) * softplusf_(da + F.gdn_dt_bias[l * 4 + h]);
    }
    __syncthreads();
    const int i = tid >> 3, sub = tid & 7, c16 = sub * 16;
    float gam_i = 0.f, gl = 0.f;
    for (int j = 0; j < 64; ++j) { const float gj = gA[j]; gl += gj; if (j <= i) gam_i += gj; }
    const float beta_i = betaA[i];
    if (sub == 0) gamA[i] = gam_i;
    {
        const int pos = n * 64 + i;
        const bf16* prow = F.P + (size_t)(row0 + i) * NP + PC_DQ + h * 128 + c16;
        const float* cw = F.gdn_conv + (size_t)l * 4 * 1536 + h * 128 + c16;
        float y[16];
        conv16(F, prow, pos, cw, y);
        { float ss = 0.f;
#pragma unroll
          for (int e = 0; e < 16; ++e) ss += y[e] * y[e];
          ss += __shfl_xor(ss, 1); ss += __shfl_xor(ss, 2); ss += __shfl_xor(ss, 4);
          const float r = 0.08838834764831845f / sqrtf(ss + L2_EPS);
          v4u o0, o1; o0.x = pk2(y[0] * r, y[1] * r); o0.y = pk2(y[2] * r, y[3] * r); o0.z = pk2(y[4] * r, y[5] * r); o0.w = pk2(y[6] * r, y[7] * r);
          o1.x = pk2(y[8] * r, y[9] * r); o1.y = pk2(y[10] * r, y[11] * r); o1.z = pk2(y[12] * r, y[13] * r); o1.w = pk2(y[14] * r, y[15] * r);
          *(LAS v4u*)(Qs + i * 136 + c16) = o0; *(LAS v4u*)(Qs + i * 136 + c16 + 8) = o1; }
        conv16(F, prow + 512, pos, cw + 512, y);
        { float ss = 0.f;
#pragma unroll
          for (int e = 0; e < 16; ++e) ss += y[e] * y[e];
          ss += __shfl_xor(ss, 1); ss += __shfl_xor(ss, 2); ss += __shfl_xor(ss, 4);
          const float r = 1.f / sqrtf(ss + L2_EPS);
#pragma unroll
          for (int e = 0; e < 16; ++e) y[e] *= r;
          v4u o0, o1; o0.x = pk2(y[0], y[1]); o0.y = pk2(y[2], y[3]); o0.z = pk2(y[4], y[5]); o0.w = pk2(y[6], y[7]);
          o1.x = pk2(y[8], y[9]); o1.y = pk2(y[10], y[11]); o1.z = pk2(y[12], y[13]); o1.w = pk2(y[14], y[15]);
          *(LAS v4u*)(Kn + i * 136 + c16) = o0; *(LAS v4u*)(Kn + i * 136 + c16 + 8) = o1;
          const float fb = beta_i * __expf(gam_i), fd = __expf(gl - gam_i);
#pragma unroll
          for (int e = 0; e < 16; ++e) { KbT[(c16 + e) * 72 + i] = (bf16)f2bf(y[e] * fb); KdT[(c16 + e) * 72 + i] = (bf16)f2bf(y[e] * fd); } }
        conv16(F, prow + 1024, pos, cw + 1024, y);
#pragma unroll
        for (int e = 0; e < 16; ++e) VbT[(c16 + e) * 72 + i] = (bf16)f2bf(y[e] * beta_i);
    }
    __syncthreads();
#pragma unroll
    for (int t = 0; t < 2; ++t) {
        const int idx = 2 * w + t, mb = idx >> 2, nb = idx & 3;
        const f32x4 z4 = {0.f, 0.f, 0.f, 0.f};
        const f32x4 akk = mm16(Kn, 136, mb * 16, Kn, 136, nb * 16, 128, lane, z4);
        const f32x4 aqk = mm16(Qs, 136, mb * 16, Kn, 136, nb * 16, 128, lane, z4);
        const int j = nb * 16 + (lane & 15); const float gj = gamA[j];
#pragma unroll
        for (int e = 0; e < 4; ++e) { const int ii = mb * 16 + 4 * (lane >> 4) + e; const float dc = __expf(fminf(gamA[ii] - gj, 0.f));
            Am[ii * 68 + j] = (ii > j) ? betaA[ii] * akk[e] * dc : 0.f;
            QKm[ii * 72 + j] = (bf16)f2bf((ii >= j) ? aqk[e] * dc : 0.f); }
    }
    __syncthreads();
    if (w == 0) {
        float Tc[64];
#pragma clang loop unroll(full)
        for (int ii = 0; ii < 64; ++ii) {
            float s = (ii == lane) ? 1.f : 0.f;
#pragma clang loop unroll(full)
            for (int j = 0; j < ii; ++j) s -= Am[ii * 68 + j] * Tc[j];
            Tc[ii] = s;
            Tm[ii * 72 + lane] = (bf16)f2bf(s);
        }
    }
    __syncthreads();
#pragma unroll 1
    for (int b = 0; b < 8; ++b) {
        const int idx = w * 8 + b, which = idx >> 5, mb = (idx & 31) >> 3, nb = idx & 7;
        const f32x4 z4 = {0.f, 0.f, 0.f, 0.f};
        const f32x4 a = mm16(Tm, 72, mb * 16, which ? KbT : VbT, 72, nb * 16, 64, lane, z4);
        LAS bf16* dst = which ? WkT : UbT;
        *(LAS v2u*)(dst + (nb * 16 + (lane & 15)) * 72 + mb * 16 + 4 * (lane >> 4)) = pk4(a);
    }
    __syncthreads();
    bf16* gWN = (bf16*)(F.wsb + WS_GD_WN) + (size_t)unit * 16384; bf16* gBT = (bf16*)(F.wsb + WS_GD_BT) + (size_t)unit * 16384;
    bf16* gQE = (bf16*)(F.wsb + WS_GD_QE) + (size_t)unit * 8192; bf16* gOL = (bf16*)(F.wsb + WS_GD_OL) + (size_t)unit * 8192;
    if (tid == 0) ((float*)(F.wsb + WS_GD_CD))[unit] = __expf(gl);
#pragma unroll 1
    for (int b = 0; b < 24; ++b) {
        const int idx = w * 24 + b;
        const f32x4 z4 = {0.f, 0.f, 0.f, 0.f};
        const int q4 = 4 * (lane >> 4), c = lane & 15;
        if (idx < 64) {
            const int mb = idx >> 3, nb = idx & 7;
            f32x4 a = mm16(WkT, 72, mb * 16, KdT, 72, nb * 16, 64, lane, z4);
            a = -a;
            *(v2u*)(gWN + (nb * 16 + c) * 128 + mb * 16 + q4) = pk4(a);
        } else if (idx < 128) {
            const int x = idx - 64, mb = x >> 3, nb = x & 7;
            const f32x4 a = mm16(KdT, 72, mb * 16, UbT, 72, nb * 16, 64, lane, z4);
            *(v2u*)(gBT + (nb * 16 + c) * 128 + mb * 16 + q4) = pk4(a);
        } else if (idx < 160) {
            const int x = idx - 128, mb = x >> 2, nb = x & 3;
            const f32x4 a = mm16(WkT, 72, mb * 16, QKm, 72, nb * 16, 64, lane, z4);
            const int ii = nb * 16 + c, d0 = mb * 16 + q4; const float eg = __expf(gamA[ii]);
            const v2u qw = *(const LAS v2u*)(Qs + ii * 136 + d0);
            f32x4 r; r[0] = bflo(qw.x) * eg - a[0]; r[1] = bfhi(qw.x) * eg - a[1]; r[2] = bflo(qw.y) * eg - a[2]; r[3] = bfhi(qw.y) * eg - a[3];
            *(v2u*)(gQE + ii * 128 + d0) = pk4(r);
        } else {
            const int x = idx - 160, mb = x >> 3, nb = x & 7;
            const f32x4 a = mm16(QKm, 72, mb * 16, UbT, 72, nb * 16, 64, lane, z4);
            *(v2u*)(gOL + (nb * 16 + c) * 64 + mb * 16 + q4) = pk4(a);
        }
    }
    __syncthreads();
}
__device__ __forceinline__ void gdn_chain(Frame& F, int bh) {
    const int tid = opq(F.tid), lane = tid & 63, w = __builtin_amdgcn_readfirstlane(tid >> 6);
    LAS bf16* Wl = (LAS bf16*)F.lds;
    LAS bf16* Sw = (LAS bf16*)(F.lds + 34816) + w * (16 * 136);
    const bf16* gWN = (const bf16*)(F.wsb + WS_GD_WN) + (size_t)bh * 32 * 16384;
    const bf16* gBT = (const bf16*)(F.wsb + WS_GD_BT) + (size_t)bh * 32 * 16384;
    bf16* gST = (bf16*)(F.wsb + WS_GD_ST) + (size_t)bh * 32 * 16384;
    const float* gCD = (const float*)(F.wsb + WS_GD_CD) + bh * 32;
    f32x4 acc[8];
#pragma unroll
    for (int mb = 0; mb < 8; ++mb) acc[mb] = (f32x4){0.f, 0.f, 0.f, 0.f};
    v4u wreg[4];
#pragma unroll
    for (int k = 0; k < 4; ++k) { const int p = tid + 512 * k; wreg[k] = *(const v4u*)(gWN + (size_t)(p >> 4) * 128 + (p & 15) * 8); }
    const int c = lane & 15, q4 = 4 * (lane >> 4);
    for (int n = 0; n < 32; ++n) {
        __syncthreads();
#pragma unroll
        for (int k = 0; k < 4; ++k) { const int p = tid + 512 * k; *(LAS v4u*)(Wl + (p >> 4) * 136 + (p & 15) * 8) = wreg[k]; }
#pragma unroll
        for (int mb = 0; mb < 8; ++mb) { const v2u pk = pk4(acc[mb]);
            *(LAS v2u*)(Sw + c * 136 + mb * 16 + q4) = pk;
            *(v2u*)(gST + (size_t)n * 16384 + (16 * w + c) * 128 + mb * 16 + q4) = pk; }
        __syncthreads();
        if (n + 1 < 32) {
#pragma unroll
            for (int k = 0; k < 4; ++k) { const int p = tid + 512 * k; wreg[k] = *(const v4u*)(gWN + (size_t)(n + 1) * 16384 + (size_t)(p >> 4) * 128 + (p & 15) * 8); } }
        const float cd = gCD[n];
#pragma unroll
        for (int mb = 0; mb < 8; ++mb) {
            const v2u bw = *(const v2u*)(gBT + (size_t)n * 16384 + (16 * w + c) * 128 + mb * 16 + q4);
            f32x4 a = acc[mb] * cd; a[0] += bflo(bw.x); a[1] += bfhi(bw.x); a[2] += bflo(bw.y); a[3] += bfhi(bw.y);
            acc[mb] = mm16(Wl, 136, mb * 16, Sw, 136, 0, 128, lane, a);
        }
    }
    __syncthreads();
}
__device__ __forceinline__ void gdn_post_unit(Frame& F, int l, int unit) {
    const int tid = opq(F.tid), lane = tid & 63, w = __builtin_amdgcn_readfirstlane(tid >> 6);
    const int n = unit & 31, bh = unit >> 5, bl = bh >> 2, h = bh & 3;
    LAS bf16* QEl = (LAS bf16*)F.lds;
    LAS bf16* STl = (LAS bf16*)(F.lds + 17408);
    LAS float* Of = (LAS float*)(F.lds + 52224);
    const bf16* gQE = (const bf16*)(F.wsb + WS_GD_QE) + (size_t)unit * 8192; const bf16* gST = (const bf16*)(F.wsb + WS_GD_ST) + (size_t)unit * 16384;
    const bf16* gOL = (const bf16*)(F.wsb + WS_GD_OL) + (size_t)unit * 8192;
#pragma unroll
    for (int k = 0; k < 2; ++k) { const int p = tid + 512 * k; *(LAS v4u*)(QEl + (p >> 4) * 136 + (p & 15) * 8) = *(const v4u*)(gQE + (size_t)(p >> 4) * 128 + (p & 15) * 8); }
#pragma unroll
    for (int k = 0; k < 4; ++k) { const int p = tid + 512 * k; *(LAS v4u*)(STl + (p >> 4) * 136 + (p & 15) * 8) = *(const v4u*)(gST + (size_t)(p >> 4) * 128 + (p & 15) * 8); }
    __syncthreads();
    const int c = lane & 15, q4 = 4 * (lane >> 4);
#pragma unroll
    for (int t = 0; t < 4; ++t) {
        const int mb = w >> 1, nb = (w & 1) * 4 + t, dv = nb * 16 + c, i0 = mb * 16 + q4;
        const v2u ow = *(const v2u*)(gOL + dv * 64 + i0);
        f32x4 a; a[0] = bflo(ow.x); a[1] = bfhi(ow.x); a[2] = bflo(ow.y); a[3] = bfhi(ow.y);
        a = mm16(QEl, 136, mb * 16, STl, 136, nb * 16, 128, lane, a);
#pragma unroll
        for (int e = 0; e < 4; ++e) Of[(i0 + e) * 132 + dv] = a[e];
    }
    __syncthreads();
    {
        const int i = tid >> 3, sub = tid & 7, c16 = sub * 16; const size_t row = (size_t)bl * SEQ + n * 64 + i;
        float x[16]; float ss = 0.f;
#pragma unroll
        for (int e = 0; e < 16; ++e) { x[e] = Of[i * 132 + c16 + e]; ss += x[e] * x[e]; }
        ss += __shfl_xor(ss, 1); ss += __shfl_xor(ss, 2); ss += __shfl_xor(ss, 4);
        const float r = 1.f / sqrtf(ss * (1.f / 128.f) + RMS_EPS);
        const float* gn = F.gdn_onorm + l * 128 + c16;
        const v4u z0 = *(const v4u*)(F.P + row * NP + PC_DZ + h * 128 + c16), z1 = *(const v4u*)(F.P + row * NP + PC_DZ + h * 128 + c16 + 8);
        const float zg[16] = {bflo(z0.x), bfhi(z0.x), bflo(z0.y), bfhi(z0.y), bflo(z0.z), bfhi(z0.z), bflo(z0.w), bfhi(z0.w), bflo(z1.x), bfhi(z1.x), bflo(z1.y), bfhi(z1.y), bflo(z1.z), bfhi(z1.z), bflo(z1.w), bfhi(z1.w)};
#pragma unroll
        for (int e = 0; e < 16; ++e) x[e] = x[e] * r * gn[e] * zg[e];
        v4u o0, o1; o0.x = pk2(x[0], x[1]); o0.y = pk2(x[2], x[3]); o0.z = pk2(x[4], x[5]); o0.w = pk2(x[6], x[7]);
        o1.x = pk2(x[8], x[9]); o1.y = pk2(x[10], x[11]); o1.z = pk2(x[12], x[13]); o1.w = pk2(x[14], x[15]);
        bf16* yp = F.Y + row * YW + YC_GDN + h * 128 + c16;
        *(v4u*)yp = o0; *(v4u*)(yp + 8) = o1;
    }
    __syncthreads();
}
constexpr size_t WS_GL_BS = 40 * MiB;
constexpr size_t WS_GL_AN = 619 * MiB;
constexpr int GL_LA = 0, GL_QD = 33792, GL_KT = 51200, GL_ATT = 68608, GL_VT = 77824, GL_LR = 114688, GL_GL = 118784;
__device__ __forceinline__ void gla_gam(Frame& F, int l, int h, int row0, int tid) {
    LAS float* laL = (LAS float*)(F.lds + GL_LA); LAS float* lrL = (LAS float*)(F.lds + GL_LR); LAS float* glL = (LAS float*)(F.lds + GL_GL);
#pragma unroll
    for (int k = 0; k < 2; ++k) { const int p = tid + 512 * k; lrL[p] = F.PS[(size_t)(row0 + (p >> 4)) * 32 + 8 + (p & 15)]; }
    const int d = tid & 127, ig = tid >> 7;
    float w2r[16]; const float bb = F.gla_b[l * 512 + h * 128 + d];
#pragma unroll
    for (int r = 0; r < 16; ++r) w2r[r] = F.gla_w2[((size_t)l * 16 + r) * 512 + h * 128 + d];
    __syncthreads();
#pragma unroll 4
    for (int ii = 0; ii < 16; ++ii) { const int i = ig * 16 + ii; float x = bb;
#pragma unroll
        for (int r = 0; r < 16; ++r) x += lrL[i * 16 + r] * w2r[r];
        laL[i * 132 + d] = logsigf_(x) * (1.f / 16.f); }
    __syncthreads();
    if (tid < 128) { float run = 0.f;
        for (int i = 0; i < 64; ++i) { run += laL[i * 132 + tid]; laL[i * 132 + tid] = run; }
        glL[tid] = run; }
    __syncthreads();
}
__device__ __forceinline__ void gla_pre_unit(Frame& F, int l, int unit) {
    const int tid = opq(F.tid), lane = tid & 63, w = __builtin_amdgcn_readfirstlane(tid >> 6);
    const int n = unit & 31, bh = unit >> 5, bl = bh >> 2, h = bh & 3, row0 = bl * SEQ + n * 64;
    LAS float* laL = (LAS float*)(F.lds + GL_LA); LAS float* glL = (LAS float*)(F.lds + GL_GL);
    LAS bf16* KdT = (LAS bf16*)(F.lds + GL_QD);
    LAS bf16* VT = (LAS bf16*)(F.lds + GL_VT);
    gla_gam(F, l, h, row0, tid);
    {
        const int i = tid >> 3, sub = tid & 7;
        const bf16* kp = F.P + (size_t)(row0 + i) * NP + PC_LK + h * 128 + sub * 16;
        const v4u k0 = *(const v4u*)kp, k1 = *(const v4u*)(kp + 8);
        const float kk[16] = {bflo(k0.x), bfhi(k0.x), bflo(k0.y), bfhi(k0.y), bflo(k0.z), bfhi(k0.z), bflo(k0.w), bfhi(k0.w), bflo(k1.x), bfhi(k1.x), bflo(k1.y), bfhi(k1.y), bflo(k1.z), bfhi(k1.z), bflo(k1.w), bfhi(k1.w)};
#pragma unroll
        for (int e = 0; e < 16; ++e) { const int d = sub * 16 + e; KdT[d * 72 + i] = (bf16)f2bf(kk[e] * __expf(glL[d] - laL[i * 132 + d])); }
        const bf16* vp = F.P + (size_t)(row0 + i) * NP + PC_LV + h * 256 + sub * 32;
#pragma unroll
        for (int k = 0; k < 4; ++k) { const v4u vw = *(const v4u*)(vp + 8 * k); const int dv = sub * 32 + 8 * k;
            VT[(dv + 0) * 72 + i] = (bf16)(vw.x & 0xffff); VT[(dv + 1) * 72 + i] = (bf16)(vw.x >> 16); VT[(dv + 2) * 72 + i] = (bf16)(vw.y & 0xffff); VT[(dv + 3) * 72 + i] = (bf16)(vw.y >> 16);
            VT[(dv + 4) * 72 + i] = (bf16)(vw.z & 0xffff); VT[(dv + 5) * 72 + i] = (bf16)(vw.z >> 16); VT[(dv + 6) * 72 + i] = (bf16)(vw.w & 0xffff); VT[(dv + 7) * 72 + i] = (bf16)(vw.w >> 16); }
        if (tid < 128) ((float*)(F.wsb + WS_GL_AN))[(size_t)unit * 128 + tid] = __expf(glL[tid]);
    }
    __syncthreads();
    bf16* gBS = (bf16*)(F.wsb + WS_GL_BS) + (size_t)unit * 32768;
    const int c = lane & 15, q4 = 4 * (lane >> 4);
#pragma unroll 1
    for (int b = 0; b < 16; ++b) {
        const int idx = w * 16 + b, mb = idx >> 4, nb = idx & 15;
        const f32x4 z4 = {0.f, 0.f, 0.f, 0.f};
        const f32x4 a = mm16(KdT, 72, mb * 16, VT, 72, nb * 16, 64, lane, z4);
        *(v2u*)(gBS + (nb * 16 + c) * 128 + mb * 16 + q4) = pk4(a);
    }
    __syncthreads();
}
__device__ __forceinline__ void gla_scan(Frame& F, int bidx, int nblk) {
    const int tid = opq(F.tid);
    for (int item = bidx * NTHREADS + tid; item < BG * 4 * 4096; item += nblk * NTHREADS) {
        const int bh = item >> 12, rem = item & 4095, dv = rem >> 4, d8 = (rem & 15) * 8;
        bf16* base = (bf16*)(F.wsb + WS_GL_BS) + (size_t)bh * 32 * 32768 + dv * 128 + d8;
        const float* an = (const float*)(F.wsb + WS_GL_AN) + (size_t)bh * 32 * 128 + d8;
        float s[8];
#pragma unroll
        for (int e = 0; e < 8; ++e) s[e] = 0.f;
#pragma unroll 4
        for (int n = 0; n < 32; ++n) {
            const v4u bw = *(const v4u*)(base + (size_t)n * 32768);
            const f32x4 a0 = *(const f32x4*)(an + n * 128), a1 = *(const f32x4*)(an + n * 128 + 4);
            if (n >= 1) { v4u o; o.x = pk2(s[0], s[1]); o.y = pk2(s[2], s[3]); o.z = pk2(s[4], s[5]); o.w = pk2(s[6], s[7]); *(v4u*)(base + (size_t)(n - 1) * 32768) = o; }
            s[0] = a0[0] * s[0] + bflo(bw.x); s[1] = a0[1] * s[1] + bfhi(bw.x); s[2] = a0[2] * s[2] + bflo(bw.y); s[3] = a0[3] * s[3] + bfhi(bw.y);
            s[4] = a1[0] * s[4] + bflo(bw.z); s[5] = a1[1] * s[5] + bfhi(bw.z); s[6] = a1[2] * s[6] + bflo(bw.w); s[7] = a1[3] * s[7] + bfhi(bw.w);
        }
    }
}
__device__ __forceinline__ void gla_post_unit(Frame& F, int l, int unit) {
    const int tid = opq(F.tid), lane = tid & 63, w = __builtin_amdgcn_readfirstlane(tid >> 6);
    const int n = unit & 31, bh = unit >> 5, bl = bh >> 2, h = bh & 3, row0 = bl * SEQ + n * 64;
    LAS float* laL = (LAS float*)(F.lds + GL_LA);
    LAS bf16* QdL = (LAS bf16*)(F.lds + GL_QD); LAS bf16* KtL = (LAS bf16*)(F.lds + GL_KT); LAS bf16* AttL = (LAS bf16*)(F.lds + GL_ATT); LAS bf16* VT = (LAS bf16*)(F.lds + GL_VT);
    LAS float* Of = (LAS float*)F.lds;
    gla_gam(F, l, h, row0, tid);
    {
        const int i = tid >> 3, sub = tid & 7;
        const bf16* qp = F.P + (size_t)(row0 + i) * NP + PC_LQ + h * 128 + sub * 16;
        const v4u q0 = *(const v4u*)qp, q1 = *(const v4u*)(qp + 8), k0 = *(const v4u*)(qp + 512), k1 = *(const v4u*)(qp + 520);
        const float qq[16] = {bflo(q0.x), bfhi(q0.x), bflo(q0.y), bfhi(q0.y), bflo(q0.z), bfhi(q0.z), bflo(q0.w), bfhi(q0.w), bflo(q1.x), bfhi(q1.x), bflo(q1.y), bfhi(q1.y), bflo(q1.z), bfhi(q1.z), bflo(q1.w), bfhi(q1.w)};
        const float kk[16] = {bflo(k0.x), bfhi(k0.x), bflo(k0.y), bfhi(k0.y), bflo(k0.z), bfhi(k0.z), bflo(k0.w), bfhi(k0.w), bflo(k1.x), bfhi(k1.x), bflo(k1.y), bfhi(k1.y), bflo(k1.z), bfhi(k1.z), bflo(k1.w), bfhi(k1.w)};
        float qd[16], kt[16];
#pragma unroll
        for (int e = 0; e < 16; ++e) { const float gm = laL[i * 132 + sub * 16 + e]; qd[e] = qq[e] * 0.08838834764831845f * __expf(gm); kt[e] = kk[e] * __expf(-gm); }
        v4u o0, o1; o0.x = pk2(qd[0], qd[1]); o0.y = pk2(qd[2], qd[3]); o0.z = pk2(qd[4], qd[5]); o0.w = pk2(qd[6], qd[7]);
        o1.x = pk2(qd[8], qd[9]); o1.y = pk2(qd[10], qd[11]); o1.z = pk2(qd[12], qd[13]); o1.w = pk2(qd[14], qd[15]);
        *(LAS v4u*)(QdL + i * 136 + sub * 16) = o0; *(LAS v4u*)(QdL + i * 136 + sub * 16 + 8) = o1;
        o0.x = pk2(kt[0], kt[1]); o0.y = pk2(kt[2], kt[3]); o0.z = pk2(kt[4], kt[5]); o0.w = pk2(kt[6], kt[7]);
        o1.x = pk2(kt[8], kt[9]); o1.y = pk2(kt[10], kt[11]); o1.z = pk2(kt[12], kt[13]); o1.w = pk2(kt[14], kt[15]);
        *(LAS v4u*)(KtL + i * 136 + sub * 16) = o0; *(LAS v4u*)(KtL + i * 136 + sub * 16 + 8) = o1;
        const bf16* vp = F.P + (size_t)(row0 + i) * NP + PC_LV + h * 256 + sub * 32;
#pragma unroll
        for (int k = 0; k < 4; ++k) { const v4u vw = *(const v4u*)(vp + 8 * k); const int dv = sub * 32 + 8 * k;
            VT[(dv + 0) * 72 + i] = (bf16)(vw.x & 0xffff); VT[(dv + 1) * 72 + i] = (bf16)(vw.x >> 16); VT[(dv + 2) * 72 + i] = (bf16)(vw.y & 0xffff); VT[(dv + 3) * 72 + i] = (bf16)(vw.y >> 16);
            VT[(dv + 4) * 72 + i] = (bf16)(vw.z & 0xffff); VT[(dv + 5) * 72 + i] = (bf16)(vw.z >> 16); VT[(dv + 6) * 72 + i] = (bf16)(vw.w & 0xffff); VT[(dv + 7) * 72 + i] = (bf16)(vw.w >> 16); }
    }
    __syncthreads();
    const int c = lane & 15, q4 = 4 * (lane >> 4);
#pragma unroll
    for (int t = 0; t < 2; ++t) {
        const int idx = 2 * w + t, mb = idx >> 2, nb = idx & 3;
        const f32x4 z4 = {0.f, 0.f, 0.f, 0.f};
        const f32x4 a = mm16(QdL, 136, mb * 16, KtL, 136, nb * 16, 128, lane, z4);
        const int j = nb * 16 + c;
#pragma unroll
        for (int e = 0; e < 4; ++e) { const int ii = mb * 16 + q4 + e; AttL[ii * 72 + j] = (bf16)f2bf((ii >= j) ? a[e] : 0.f); }
    }
    __syncthreads();
    f32x4 acc[2][4];
    const bf16* gS = (const bf16*)(F.wsb + WS_GL_BS) + (size_t)(unit - 1) * 32768;
#pragma unroll
    for (int t = 0; t < 2; ++t) {
        const int nb = 2 * w + t;
        bf16x8 bfr[4];
#pragma unroll
        for (int ks = 0; ks < 4; ++ks) { if (n >= 1) bfr[ks] = *(const bf16x8*)(gS + (size_t)(nb * 16 + c) * 128 + ks * 32 + 8 * (lane >> 4)); else bfr[ks] = (bf16x8){0, 0, 0, 0, 0, 0, 0, 0}; }
#pragma unroll
        for (int mb = 0; mb < 4; ++mb) {
            f32x4 a = {0.f, 0.f, 0.f, 0.f};
#pragma unroll
            for (int ks = 0; ks < 4; ++ks) a = __builtin_amdgcn_mfma_f32_16x16x32_bf16(*(const LAS bf16x8*)(QdL + (mb * 16 + c) * 136 + ks * 32 + 8 * (lane >> 4)), bfr[ks], a, 0, 0, 0);
            acc[t][mb] = mm16(AttL, 72, mb * 16, VT, 72, nb * 16, 64, lane, a);
        }
    }
    __syncthreads();
#pragma unroll
    for (int t = 0; t < 2; ++t)
#pragma unroll
        for (int mb = 0; mb < 4; ++mb)
#pragma unroll
            for (int e = 0; e < 4; ++e) Of[(mb * 16 + q4 + e) * 260 + (2 * w + t) * 16 + c] = acc[t][mb][e];
    __syncthreads();
    {
        const int i = tid >> 3, sub = tid & 7, c32 = sub * 32; const size_t row = (size_t)row0 + i;
        float x[32]; float ss = 0.f;
#pragma unroll
        for (int e = 0; e < 32; ++e) { x[e] = Of[i * 260 + c32 + e]; ss += x[e] * x[e]; }
        ss += __shfl_xor(ss, 1); ss += __shfl_xor(ss, 2); ss += __shfl_xor(ss, 4);
        const float r = 1.f / sqrtf(ss * (1.f / 256.f) + RMS_EPS);
        const float* gn = F.gla_onorm + l * 256 + c32;
        const bf16* zp = F.P + row * NP + PC_LZ + h * 256 + c32; bf16* yp = F.Y + row * YW + YC_GLA + h * 256 + c32;
#pragma unroll
        for (int k = 0; k < 4; ++k) { const v4u zw = *(const v4u*)(zp + 8 * k);
            const float zg[8] = {bflo(zw.x), bfhi(zw.x), bflo(zw.y), bfhi(zw.y), bflo(zw.z), bfhi(zw.z), bflo(zw.w), bfhi(zw.w)};
            float y[8];
#pragma unroll
            for (int e = 0; e < 8; ++e) y[e] = x[8 * k + e] * r * gn[8 * k + e] * zg[e];
            v4u o; o.x = pk2(y[0], y[1]); o.y = pk2(y[2], y[3]); o.z = pk2(y[4], y[5]); o.w = pk2(y[6], y[7]);
            *(v4u*)(yp + 8 * k) = o; }
    }
    __syncthreads();
}
constexpr int SB_QS = 0, SB_KS = 34816, SB_VT = 52224, SB_FL = 70656;
__device__ __forceinline__ void sb_unit(Frame& F, int unit) {
    const int tid = opq(F.tid), lane = tid & 63, w = __builtin_amdgcn_readfirstlane(tid >> 6);
    const int qt = ((unit >> 8) & 1) ? (unit & 15) : 15 - (unit & 15), bh = unit >> 4, bl = bh >> 2, h = bh & 3;
    LAS bf16* Qs = (LAS bf16*)(F.lds + SB_QS); LAS bf16* Ks = (LAS bf16*)(F.lds + SB_KS); LAS bf16* Vt = (LAS bf16*)(F.lds + SB_VT);
    volatile LAS unsigned* flags = (volatile LAS unsigned*)(F.lds + SB_FL);
    const size_t rowb = (size_t)bl * SEQ;
    const int c = lane & 15, q = lane >> 4, q4 = 4 * q;
#pragma unroll
    for (int k = 0; k < 4; ++k) { const int p = tid + 512 * k; *(LAS v4u*)(Qs + (p >> 4) * 136 + (p & 15) * 8) = *(const v4u*)(F.P + (rowb + qt * 128 + (p >> 4)) * NP + PC_SQ + h * 128 + (p & 15) * 8); }
    f32x4 o[8];
#pragma unroll
    for (int mb = 0; mb < 8; ++mb) o[mb] = (f32x4){0.f, 0.f, 0.f, 0.f};
    float R = 0.f;
    const int t = qt * 128 + 16 * w + c;
    for (int kb = 2 * qt + 1; kb >= 0; --kb) {
        {
            const int key = tid >> 3, sub = tid & 7;
            const bf16* kp = F.P + (rowb + kb * 64 + key) * NP + PC_SK + h * 128 + sub * 16;
            const v4u k0 = *(const v4u*)kp, k1 = *(const v4u*)(kp + 8), v0 = *(const v4u*)(kp + 512), v1 = *(const v4u*)(kp + 520);
            *(LAS v4u*)(Ks + key * 136 + sub * 16) = k0; *(LAS v4u*)(Ks + key * 136 + sub * 16 + 8) = k1;
            const int d0 = sub * 16;
            Vt[(d0 + 0) * 72 + key] = (bf16)(v0.x & 0xffff); Vt[(d0 + 1) * 72 + key] = (bf16)(v0.x >> 16); Vt[(d0 + 2) * 72 + key] = (bf16)(v0.y & 0xffff); Vt[(d0 + 3) * 72 + key] = (bf16)(v0.y >> 16);
            Vt[(d0 + 4) * 72 + key] = (bf16)(v0.z & 0xffff); Vt[(d0 + 5) * 72 + key] = (bf16)(v0.z >> 16); Vt[(d0 + 6) * 72 + key] = (bf16)(v0.w & 0xffff); Vt[(d0 + 7) * 72 + key] = (bf16)(v0.w >> 16);
            Vt[(d0 + 8) * 72 + key] = (bf16)(v1.x & 0xffff); Vt[(d0 + 9) * 72 + key] = (bf16)(v1.x >> 16); Vt[(d0 + 10) * 72 + key] = (bf16)(v1.y & 0xffff); Vt[(d0 + 11) * 72 + key] = (bf16)(v1.y >> 16);
            Vt[(d0 + 12) * 72 + key] = (bf16)(v1.z & 0xffff); Vt[(d0 + 13) * 72 + key] = (bf16)(v1.z >> 16); Vt[(d0 + 14) * 72 + key] = (bf16)(v1.w & 0xffff); Vt[(d0 + 15) * 72 + key] = (bf16)(v1.w >> 16);
        }
        __syncthreads();
        const bool active = (kb * 64 < qt * 128 + 16 * w + 15);
        if (active) {
            float wgt[4][4], l1m[4][4], tot[4], hi[4];
#pragma unroll
            for (int kk = 0; kk < 4; ++kk) {
                const f32x4 z4 = {0.f, 0.f, 0.f, 0.f};
                const f32x4 a = mm16(Ks, 136, kk * 16, Qs, 136, 16 * w, 128, lane, z4);
                float g = 0.f;
#pragma unroll
                for (int e = 0; e < 4; ++e) {
                    const int s = kb * 64 + kk * 16 + q4 + e; const bool valid = s < t;
                    const float z = a[e] * 0.08838834764831845f;
                    const float sp = fmaxf(z, 0.f) + __logf(1.f + __expf(-fabsf(z)));
                    l1m[kk][e] = valid ? -sp : 0.f;
                    wgt[kk][e] = valid ? (z - sp) : -1e30f;
                    g += l1m[kk][e];
                }
                const float b = __shfl_xor(g, 16), pr = g + b, d = __shfl_xor(pr, 32);
                hi[kk] = ((q & 1) == 0 ? b : 0.f) + ((q & 2) == 0 ? d : 0.f);
                tot[kk] = pr + d;
            }
            float after = R;
#pragma unroll
            for (int kk = 3; kk >= 0; --kk) {
                float tail = after + hi[kk];
#pragma unroll
                for (int e = 3; e >= 0; --e) { const float lw = wgt[kk][e] + tail; wgt[kk][e] = __expf(lw); tail += l1m[kk][e]; }
                after += tot[kk];
            }
            R = after;
#pragma unroll
            for (int ks = 0; ks < 2; ++ks) {
                v4u pb; pb.x = pk2(wgt[2 * ks][0], wgt[2 * ks][1]); pb.y = pk2(wgt[2 * ks][2], wgt[2 * ks][3]); pb.z = pk2(wgt[2 * ks + 1][0], wgt[2 * ks + 1][1]); pb.w = pk2(wgt[2 * ks + 1][2], wgt[2 * ks + 1][3]);
                const bf16x8 bfrag = __builtin_bit_cast(bf16x8, pb);
#pragma unroll
                for (int mb = 0; mb < 8; ++mb) {
                    const LAS bf16* vp = Vt + (mb * 16 + c) * 72 + 32 * ks + q4;
                    const v2u lo = *(const LAS v2u*)vp, hi2 = *(const LAS v2u*)(vp + 16);
                    v4u av; av.x = lo.x; av.y = lo.y; av.z = hi2.x; av.w = hi2.y;
                    o[mb] = __builtin_amdgcn_mfma_f32_16x16x32_bf16(__builtin_bit_cast(bf16x8, av), bfrag, o[mb], 0, 0, 0);
                }
            }
        }
        const bool done = __all(R < -104.f || !active) && active;
        if (lane == 0) flags[w] = done ? 1u : 0u;
        __syncthreads();
        unsigned alldone = 1u;
#pragma unroll
        for (int k = 0; k < 8; ++k) alldone &= flags[k];
        if (alldone) break;
    }
    {
        const size_t row = rowb + qt * 128 + 16 * w + c;
#pragma unroll
        for (int mb = 0; mb < 8; ++mb) {
            const int d = mb * 16 + q4;
            const v2u zw = *(const v2u*)(F.P + row * NP + PC_SZ + h * 128 + d);
            v2u ow; ow.x = pk2(o[mb][0] * bflo(zw.x), o[mb][1] * bfhi(zw.x)); ow.y = pk2(o[mb][2] * bflo(zw.y), o[mb][3] * bfhi(zw.y));
            *(v2u*)(F.Y + row * YW + YC_SB + h * 128 + d) = ow;
        }
    }
    __syncthreads();
}
__device__ __forceinline__ void phase_mix_naive(Frame& F, int l) {
    const int bx = blockIdx.x;
    if (bx < 32) gdn_chain(F, bx);
    else if (bx < 64) gla_scan(F, bx - 32, 32);
    else for (int u = bx - 64; u < BG * 4 * 16; u += F.G - 64) sb_unit(F, u);
}
__device__ __forceinline__ void phase_post(Frame& F, int l) {
    const int gw = blockIdx.x * NWAVES + F.wave, NGW = F.G * NWAVES, lane = opq(F.lane);
    for (int m = gw; m < TG; m += NGW) {
#pragma unroll
        for (int ps = 1; ps < 3; ++ps) {
            const int e = (ps == 0) ? lane * 8 : (ps - 1) * 512 + lane * 8;
            bf16* yp = F.Y + (size_t)m * YW + (ps == 0 ? YC_GDN : YC_GLA) + e;
            const bf16* zp = F.P + (size_t)m * NP + (ps == 0 ? PC_DZ : PC_LZ) + e;
            const v4u w = *(const v4u*)yp, zw = *(const v4u*)zp;
            float x[8] = {bflo(w.x), bfhi(w.x), bflo(w.y), bfhi(w.y), bflo(w.z), bfhi(w.z), bflo(w.w), bfhi(w.w)};
            const float zg[8] = {bflo(zw.x), bfhi(zw.x), bflo(zw.y), bfhi(zw.y), bflo(zw.z), bfhi(zw.z), bflo(zw.w), bfhi(zw.w)};
            float ss = 0.f;
#pragma unroll
            for (int i = 0; i < 8; ++i) ss += x[i] * x[i];
            ss += __shfl_xor(ss, 1); ss += __shfl_xor(ss, 2); ss += __shfl_xor(ss, 4); ss += __shfl_xor(ss, 8);
            float r; const float* gn;
            if (ps == 0) { r = 1.f / sqrtf(ss * (1.f / 128.f) + RMS_EPS); gn = F.gdn_onorm + l * 128 + (lane & 15) * 8; }
            else { ss += __shfl_xor(ss, 16); r = 1.f / sqrtf(ss * (1.f / 256.f) + RMS_EPS); gn = F.gla_onorm + l * 256 + (lane & 31) * 8; }
#pragma unroll
            for (int i = 0; i < 8; ++i) x[i] = x[i] * r * gn[i] * zg[i];
            v4u o; o.x = pk2(x[0], x[1]); o.y = pk2(x[2], x[3]); o.z = pk2(x[4], x[5]); o.w = pk2(x[6], x[7]);
            *(v4u*)yp = o;
        }
    }
}

__global__ void __launch_bounds__(NTHREADS, 2) fwd_kernel(Args args) {
    extern __shared__ __attribute__((aligned(16))) unsigned char lds_raw[];
    Frame F;
    F.lds = (LAS unsigned char*)lds_raw;
    volatile LAS unsigned* MISC = (volatile LAS unsigned*)(F.lds + MISC_OFF);
    F.tid = threadIdx.x; F.lane = F.tid & 63; F.wave = __builtin_amdgcn_readfirstlane(F.tid >> 6); F.G = gridDim.x;
    unsigned char* ws = args.ws;
    F.x = args.in[0]; F.c = args.in[1]; F.ada_w = args.in[2]; F.ada_b = args.in[3]; F.norm_g = args.in[4]; F.w_in = args.in[5]; F.sb_qnorm = args.in[6]; F.sb_knorm = args.in[7];
    F.gdn_conv = args.in[8]; F.gdn_a_log = args.in[9]; F.gdn_dt_bias = args.in[10]; F.gdn_onorm = args.in[11]; F.gla_w2 = args.in[12]; F.gla_b = args.in[13]; F.gla_onorm = args.in[14];
    F.merge_b = args.in[15]; F.proj_sb = args.in[16]; F.proj_gdn = args.in[17]; F.proj_gla = args.in[18]; F.w_out = args.in[19];
    F.out = args.out; F.wsb = ws;
    F.MODP = (float*)(ws + WS_MODP); F.MODA = (float*)(ws + WS_MOD); F.MODB = F.MODA + DEPTH * BATCH * D; F.MODG = F.MODB + DEPTH * BATCH * D;
    F.PS = (float*)(ws + WS_PS); F.MGF = (float*)(ws + WS_MGF);
    F.WIN = (bf16*)(ws + WS_WIN); F.WP = (bf16*)(ws + WS_WP); F.WO = (bf16*)(ws + WS_WO); F.H = (bf16*)(ws + WS_H); F.MGB = (bf16*)(ws + WS_MGB);
    F.P = (bf16*)(ws + WS_P); F.Y = (bf16*)(ws + WS_Y); F.GQKV = (bf16*)(ws + WS_H);
    for (int u = F.tid; u < 32; u += NTHREADS) MISC[u] = 0u;
    __syncthreads();
    XcdBarrier bar = xcd_barrier_post((unsigned*)(ws + WS_CTL) + CW_BAR, MISC + 8);
#define GRID_BAR() do { XcdBarrier b2_ = bar; asm volatile("" : "+s"(b2_.x)); xcd_barrier(b2_); } while (0)

    p0_ada(F);
    GRID_BAR();
    p1_mod(F);
    GRID_BAR();
    for (int l = 0; l < DEPTH; ++l) {
        const float* xin = (l == 0) ? F.x : F.out;
        for (int g = 0; g < NGRP; ++g) {
            if (g == 0) wconv_layer(F, l);
            phase_norm(F, xin, l, g);
            GRID_BAR();
#define PH_G1() do { pg8::Gemm gm{F.H, F.WIN, D, D, D}; pg8::StaticOrder S; S.init(TG, NWT, F.G, (int)blockIdx.x); \
                EpiG1 E{F.P, F.PS, F.merge_b + l * 3072}; \
                pg8::gemm_phase<EpiG1, pg8::StaticOrder, true>(F.lds, gm, S, E); GRID_BAR(); } while (0)
            PH_G1();
#ifdef PROBE_G1
            PH_G1();
#endif
            phase_prep(F, l);
#define PH_PRE() do { for (int u = blockIdx.x; u < BG * 4 * 32; u += F.G) gdn_pre_unit(F, l, u); \
                for (int u = blockIdx.x; u < BG * 4 * 32; u += F.G) gla_pre_unit(F, l, u); GRID_BAR(); } while (0)
            PH_PRE();
#ifdef PROBE_PRE
            PH_PRE();
#endif
#define PH_MIX() do { const int bx = blockIdx.x; if (bx < 32) gdn_chain(F, bx); else { for (int u = bx - 32; u < BG * 4 * 16; u += F.G - 32) sb_unit(F, u); gla_scan(F, bx - 32, F.G - 32); } GRID_BAR(); } while (0)
            PH_MIX();
#ifdef PROBE_MIX
            PH_MIX();
#endif
#define PH_POST() do { for (int u = blockIdx.x; u < BG * 4 * 32; u += F.G) gdn_post_unit(F, l, u); \
                for (int u = blockIdx.x; u < BG * 4 * 32; u += F.G) gla_post_unit(F, l, u); GRID_BAR(); } while (0)
            PH_POST();
#ifdef PROBE_POST
            PH_POST();
#endif
#define PH_G2() do { pg8::StaticOrder S; S.init(TG, D, F.G, (int)blockIdx.x); \
                pg8::Gemm gm{F.Y, F.WP, YW, 2048, 2048}; EpiG2R E{F.P, F.MGB}; \
                pg8::gemm_phase<EpiG2R, pg8::StaticOrder, false>(F.lds, gm, S, E); GRID_BAR(); } while (0)
            PH_G2();
#ifdef PROBE_G2
            PH_G2();
#endif
#ifndef NO_G3
            {   pg8::Gemm gm{F.MGB, F.WO, D, D, D}; pg8::StaticOrder S; S.init(TG, D, F.G, (int)blockIdx.x);
                EpiG3 E{xin, F.out, F.MODG + (size_t)l * BATCH * D, g * TG};
                pg8::gemm_phase<EpiG3, pg8::StaticOrder, false>(F.lds, gm, S, E); }
#endif
            GRID_BAR();
        }
    }
}

extern "C" void kernel_launch(void* const* d_in, const int* in_sizes, int n_in, void* d_out, int out_size, void* d_ws, size_t ws_size, hipStream_t stream) {
    static int grid = 0;
    if (grid == 0) {
        if (n_in != 20 || out_size != T * D || ws_size < WS_END) { fprintf(stderr, "kernel_launch: unexpected shapes / workspace (%d inputs, out %d, ws %zu)\n", n_in, out_size, ws_size); grid = -1; return; }
        int dev = 0, cus = 0, per_cu = 0;
        if (hipGetDevice(&dev) != hipSuccess || hipDeviceGetAttribute(&cus, hipDeviceAttributeMultiprocessorCount, dev) != hipSuccess) { grid = -1; return; }
        if (hipFuncSetAttribute((const void*)fwd_kernel, hipFuncAttributeMaxDynamicSharedMemorySize, LDS_BYTES) != hipSuccess) { grid = -1; return; }
        if (hipOccupancyMaxActiveBlocksPerMultiprocessor(&per_cu, (const void*)fwd_kernel, NTHREADS, LDS_BYTES) != hipSuccess || per_cu < 1) fprintf(stderr, "kernel_launch: occupancy query reports %d\n", per_cu);
        (void)hipGetLastError();
        grid = cus;
    }
    if (grid < 0) return;
    if (hipMemsetAsync((char*)d_ws + WS_CTL, 0, CTL_ZERO_BYTES, stream) != hipSuccess) return;
    Args a{};
    for (int i = 0; i < 20; ++i) a.in[i] = (const float*)d_in[i];
    a.out = (float*)d_out; a.ws = (unsigned char*)d_ws; a.ph_lo = 0; a.ph_hi = 0;
    hipLaunchKernelGGL(fwd_kernel, dim3(grid), dim3(NTHREADS), LDS_BYTES, stream, a);
}
```

```cpp
#include <hip/hip_runtime.h>
#include <cstdio>
#include <cstdint>

#define GAS __attribute__((address_space(1)))
#define LAS __attribute__((address_space(3)))

#define XB_TMO      128
#define XB_XCNT(j)  (256  + 64 * (j))
#define XB_XSUB(j)  (1280 + 64 * (j))
#define XB_XGEN(j)  (2304 + 64 * (j))
#define XB_TOP      3328
#define XB_TOPGEN   3392
#define XCD_BAR_WORDS 3456
#define XB_SPIN_CAP (1u << 24)

__device__ __forceinline__ unsigned xb_ld(unsigned* p)              { return __hip_atomic_load(p, __ATOMIC_RELAXED, __HIP_MEMORY_SCOPE_AGENT); }
__device__ __forceinline__ unsigned xb_add(unsigned* p, unsigned v) { return __hip_atomic_fetch_add(p, v, __ATOMIC_RELAXED, __HIP_MEMORY_SCOPE_AGENT); }
__device__ __forceinline__ unsigned xb_xcc_id() { return (unsigned)__builtin_amdgcn_s_getreg((3 << 11) | 20) & 0xFu; }
#define XB_SPIN(cond, bar) do { unsigned _sp = 0; while (cond) { __builtin_amdgcn_s_sleep(1); \
    if ((++_sp & 255u) == 0u) { if (xb_ld(&(bar)[XB_TMO])) break; if (_sp > XB_SPIN_CAP) { atomicAdd(&(bar)[XB_TMO], 1u); break; } } } } while (0)

struct XcdBarrier { unsigned* bar; unsigned x; volatile LAS unsigned* st; };

__device__ __forceinline__ XcdBarrier xcd_barrier_post(unsigned* bar, volatile LAS unsigned* st) {
    XcdBarrier b; b.bar = bar; b.x = xb_xcc_id(); b.st = st;
    if (threadIdx.x == 0) (void)xb_add(&bar[XB_XCNT(b.x)], 1u);
    return b;
}
__device__ __forceinline__ void xcd_barrier_complete(unsigned* bar, unsigned x, unsigned& nloc, unsigned& nx) {
    const unsigned G = gridDim.x * gridDim.y * gridDim.z;
    unsigned sum, cnt, mine, sp = 0u;
    for (;;) {
        sum = 0u; cnt = 0u; mine = 0u;
#pragma unroll
        for (unsigned j = 0; j < 16; ++j) { const unsigned c = xb_ld(&bar[XB_XCNT(j)]); sum += c; cnt += (c > 0u) ? 1u : 0u; mine = (j == x) ? c : mine; }
        if (sum == G) break;
        __builtin_amdgcn_s_sleep(1);
        if ((++sp & 255u) == 0u) { if (xb_ld(&bar[XB_TMO])) break; if (sp > XB_SPIN_CAP) { atomicAdd(&bar[XB_TMO], 1u); break; } }
    }
    nloc = mine > 0u ? mine : 1u; nx = cnt > 0u ? cnt : 1u;
}
__device__ __forceinline__ void xcd_barrier(const XcdBarrier& b) {
    asm volatile("s_waitcnt vmcnt(0)" ::: "memory");
    __syncthreads();
    if (threadIdx.x == 0) {
        unsigned* bar = b.bar;
        __builtin_amdgcn_s_waitcnt(0);
        unsigned nloc = b.st[0], nx = b.st[1];
        if (nloc == 0u) { xcd_barrier_complete(bar, b.x, nloc, nx); b.st[0] = nloc; b.st[1] = nx; }
        const unsigned old = xb_add(&bar[XB_XSUB(b.x)], 1u);
        const unsigned gen = old / nloc;
        if (old + 1u == (gen + 1u) * nloc) {
            __builtin_amdgcn_fence(__ATOMIC_RELEASE, "agent");
            asm volatile("s_waitcnt vmcnt(0)" ::: "memory");
            const unsigned og = xb_add(&bar[XB_TOP], 1u);
            const unsigned tg = og / nx;
            if (og + 1u == (tg + 1u) * nx) xb_add(&bar[XB_TOPGEN], 1u);
            else XB_SPIN(xb_ld(&bar[XB_TOPGEN]) == tg, bar);
            __builtin_amdgcn_fence(__ATOMIC_ACQUIRE, "agent");
            xb_add(&bar[XB_XGEN(b.x)], 1u);
            asm volatile("s_waitcnt vmcnt(0)" ::: "memory");
        } else {
            XB_SPIN(xb_ld(&bar[XB_XGEN(b.x)]) == gen, bar);
            __builtin_amdgcn_fence(__ATOMIC_ACQUIRE, "agent");
            asm volatile("s_waitcnt vmcnt(0)" ::: "memory");
        }
    }
    __syncthreads();
}
namespace pg8 {
#define PG8_LAS __attribute__((address_space(3)))
typedef unsigned short bf16_t;
typedef short bf16x8 __attribute__((ext_vector_type(8)));
typedef float f32x4 __attribute__((ext_vector_type(4)));
typedef unsigned u32x4 __attribute__((ext_vector_type(4)));
typedef unsigned u32x2 __attribute__((ext_vector_type(2)));
constexpr int BM = 256, BK = 64, HALF = 128, HTB = HALF * BK * 2, STAGE_BYTES = 8 * HTB, NXCD = 8, WGM = 8;

__host__ __device__ __forceinline__ int lds_byte(int r, int c) { const int st = (r >> 4) * 2 + (c >> 5), rr = r & 15, cc = c & 31, ob = rr * 64 + cc * 2; return st * 1024 + (ob ^ (((ob >> 9) & 1) << 5)); }
__host__ __device__ __forceinline__ void stage_rc(int b, int& R, int& C) { const int st = b / 1024, sb = b % 1024, swz = sb ^ (((sb >> 9) & 1) << 5); R = (st >> 1) * 16 + swz / 64; C = (st & 1) * 32 + (swz % 64) / 2; }
__host__ __device__ __forceinline__ int perm32(int rho) { const int n = rho >> 4, i = rho & 15; return 8 * (i >> 2) + 4 * n + (i & 3); }

struct Unit { int pm, pn, seg; };
struct Gemm { const bf16_t* A; const bf16_t* Bt; int lda, ldb, K; };

struct StaticOrder {
    int nM, nN, nwg, G, c;
    __host__ __device__ void init(int M, int N, int G_, int c_) { nM = M / BM; nN = N / BM; nwg = nM * nN; G = G_; c = c_; }
    __host__ __device__ bool next(int i, Unit& u) const {
        const long L = (long)i * G + c; if (L >= nwg) return false;
        int wgid = (int)L; { const int q = nwg / NXCD, r = nwg % NXCD, xcd = wgid % NXCD, off = wgid / NXCD; wgid = (xcd < r ? xcd * (q + 1) : r * (q + 1) + (xcd - r) * q) + off; }
        const int nig = WGM * nN, gid = wgid / nig, fm = gid * WGM, gsz = (nM - fm) < WGM ? (nM - fm) : WGM;
        u.pm = fm + ((wgid % nig) % gsz); u.pn = (wgid % nig) / gsz; u.seg = 0; return true;
    }
    __device__ __forceinline__ size_t k_off(const Unit&) const { return 0; }
    __device__ __forceinline__ void a_ready(const Unit&) const {}
    __device__ __forceinline__ void done(const Unit&) const {}
};

template <int NSEG> struct SegOrder : StaticOrder {
    int segk;
    __host__ __device__ bool next(int i, Unit& u) const { if (!StaticOrder::next(i / NSEG, u)) return false; u.seg = i % NSEG; return true; }
    __device__ __forceinline__ size_t k_off(const Unit& u) const { return (size_t)u.seg * segk * 2; }
};
__device__ __forceinline__ unsigned cvt_pk_bf16(float lo, float hi) { unsigned r; asm volatile("v_cvt_pk_bf16_f32 %0, %1, %2" : "=v"(r) : "v"(lo), "v"(hi)); return r; }

template <class Epi, class Sched, bool ALIGN_EPI>
__device__ __forceinline__ void gemm_phase(PG8_LAS unsigned char* lds, const Gemm g, const Sched& S, const Epi& E) {
    int tid = threadIdx.x; asm volatile("" : "+v"(tid));
    const int wid = __builtin_amdgcn_readfirstlane(tid >> 6), lane = tid & 63, wr = wid >> 2, wc = wid & 3, fr = lane & 15, fq = lane >> 4;
    const int K = g.K, nt = K / BK;
    unsigned voffA[2], voffB[2];
#pragma unroll
    for (int i = 0; i < 2; ++i) { int R, C; stage_rc(tid * 16 + i * 8192, R, C); const int Rb = Epi::PERM ? ((R & ~31) + perm32(R & 31)) : R;
        voffA[i] = (unsigned)(R * g.lda + C) * 2u; voffB[i] = (unsigned)(Rb * g.ldb + C) * 2u; }
    const size_t kstep = (size_t)(BK * 2);
    const size_t hstepA = (size_t)HALF * g.lda * 2, hstepB = (size_t)HALF * g.ldb * 2;
    const size_t tstepA = 2 * hstepA, tstepB = 2 * hstepB;
    const unsigned ldsw = (unsigned)wid * 1024u;
    const int aoff = lds_byte(wr * 64 + fr, fq * 8), boff = lds_byte(wc * 32 + fr, fq * 8);
#define PG8_SA(b, h) (((b) * 2 + (h)) * HTB)
#define PG8_SB(b, h) ((4 + (b) * 2 + (h)) * HTB)
#define PG8_STAGE(bufoff, gbase, voff) do { _Pragma("unroll") for (int _i = 0; _i < 2; ++_i) \
        __builtin_amdgcn_global_load_lds((const unsigned*)((const char*)(gbase) + (voff)[_i]), (PG8_LAS unsigned*)(lds + (bufoff) + ldsw + _i * 8192), 16, 0, 0); } while (0)
#define PG8_LDA(dst, b, h) do { _Pragma("unroll") for (int m = 0; m < 4; ++m) _Pragma("unroll") for (int k = 0; k < 2; ++k) dst[m][k] = *(const PG8_LAS bf16x8*)(lds + PG8_SA(b, h) + aoff + m * 2048 + k * 1024); } while (0)
#define PG8_LDB(dst, b, h) do { _Pragma("unroll") for (int n = 0; n < 2; ++n) _Pragma("unroll") for (int k = 0; k < 2; ++k) dst[n][k] = *(const PG8_LAS bf16x8*)(lds + PG8_SB(b, h) + boff + n * 2048 + k * 1024); } while (0)
#define PG8_MMA(ai, bj, At, Bt) do { __builtin_amdgcn_s_setprio(1); _Pragma("unroll") for (int m = 0; m < 4; ++m) _Pragma("unroll") for (int n = 0; n < 2; ++n) _Pragma("unroll") for (int k = 0; k < 2; ++k) \
        acc[ai][bj][m][n] = __builtin_amdgcn_mfma_f32_16x16x32_bf16(Bt[n][k], At[m][k], acc[ai][bj][m][n], 0, 0, 0); __builtin_amdgcn_s_setprio(0); } while (0)
#define PG8_WAIT_V(n) asm volatile("s_waitcnt vmcnt(" #n ")" ::: "memory")
#define PG8_WAIT_L(n) asm volatile("s_waitcnt lgkmcnt(" #n ")" ::: "memory")
#define PG8_BAR __builtin_amdgcn_s_barrier()
#define PG8_SCHED __builtin_amdgcn_sched_barrier(0)
    Unit cur, nxt; int ui = 0;
    if (!S.next(0, cur)) return;
    f32x4 acc[2][2][4][2];
#pragma unroll
    for (int a = 0; a < 2; ++a)
#pragma unroll
        for (int b = 0; b < 2; ++b)
#pragma unroll
            for (int m = 0; m < 4; ++m)
#pragma unroll
                for (int n = 0; n < 2; ++n) acc[a][b][m][n] = (f32x4){0.f, 0.f, 0.f, 0.f};
    bf16x8 At[4][2], B0[2][2], B1[2][2];
    const char* cA = (const char*)g.A + (size_t)cur.pm * tstepA + S.k_off(cur); const char* cB = (const char*)g.Bt + (size_t)cur.pn * tstepB + S.k_off(cur);
    S.a_ready(cur);
    PG8_STAGE(PG8_SB(0, 0), cB, voffB); PG8_STAGE(PG8_SB(0, 1), cB + hstepB, voffB); PG8_STAGE(PG8_SA(0, 0), cA, voffA); PG8_STAGE(PG8_SA(0, 1), cA + hstepA, voffA);
    if (wr == 1) PG8_BAR;
    PG8_WAIT_V(2); PG8_BAR;
    PG8_STAGE(PG8_SB(1, 0), cB + kstep, voffB); PG8_STAGE(PG8_SA(1, 0), cA + kstep, voffA); PG8_STAGE(PG8_SB(1, 1), cB + hstepB + kstep, voffB);
    PG8_WAIT_V(6); PG8_BAR;
    for (;;) {
        const bool has_next = S.next(ui + 1, nxt);
        const char* nA = has_next ? (const char*)g.A + (size_t)nxt.pm * tstepA + S.k_off(nxt) : cA; const char* nB = has_next ? (const char*)g.Bt + (size_t)nxt.pn * tstepB + S.k_off(nxt) : cB;
        for (int t = 0; t < nt; t += 2) {
            const bool last = (t == nt - 2);
            const char* a1 = cA + (size_t)(t + 1) * kstep;
            const char* a2 = last ? nA : cA + (size_t)(t + 2) * kstep; const char* b2 = last ? nB : cB + (size_t)(t + 2) * kstep;
            const char* a3 = a2 + kstep; const char* b3 = b2 + kstep;
            if (last && has_next) S.a_ready(nxt);
            if constexpr (Epi::MID) { if (t == Epi::MID_T0 || t == Epi::MID_T1) E.mid(acc, cur, t, wr, wc, fr, fq); }
            PG8_LDB(B0, 0, 0); PG8_LDB(B1, 0, 1); PG8_SCHED; PG8_LDA(At, 0, 0); PG8_STAGE(PG8_SA(1, 1), a1 + hstepA, voffA);
            PG8_WAIT_V(8); PG8_WAIT_L(0); PG8_BAR; PG8_MMA(0, 0, At, B0); PG8_MMA(0, 1, At, B1); PG8_BAR; PG8_SCHED;
            PG8_LDA(At, 0, 1); PG8_STAGE(PG8_SB(0, 0), b2, voffB); PG8_STAGE(PG8_SB(0, 1), b2 + hstepB, voffB); PG8_STAGE(PG8_SA(0, 0), a2, voffA);
            PG8_WAIT_V(8); PG8_WAIT_L(0); PG8_BAR; PG8_MMA(1, 0, At, B0); PG8_MMA(1, 1, At, B1); PG8_BAR; PG8_SCHED;
            PG8_LDB(B0, 1, 0); PG8_LDB(B1, 1, 1); PG8_SCHED; PG8_LDA(At, 1, 0); PG8_STAGE(PG8_SA(0, 1), a2 + hstepA, voffA);
            PG8_WAIT_V(8); PG8_WAIT_L(0); PG8_BAR; PG8_MMA(0, 0, At, B0); PG8_MMA(0, 1, At, B1); PG8_BAR; PG8_SCHED;
            PG8_LDA(At, 1, 1); PG8_STAGE(PG8_SB(1, 0), b3, voffB); PG8_STAGE(PG8_SB(1, 1), b3 + hstepB, voffB); PG8_STAGE(PG8_SA(1, 0), a3, voffA);
            PG8_WAIT_V(8); PG8_WAIT_L(0); PG8_BAR; PG8_MMA(1, 0, At, B0); PG8_MMA(1, 1, At, B1); PG8_BAR; PG8_SCHED;
        }
        if constexpr (ALIGN_EPI) { if (wr == 0) PG8_BAR; }
        E(acc, cur, wr, wc, fr, fq);
        if (!has_next) break;
        {
#pragma unroll
        for (int a = 0; a < 2; ++a)
#pragma unroll
            for (int b = 0; b < 2; ++b)
#pragma unroll
                for (int m = 0; m < 4; ++m)
#pragma unroll
                    for (int n = 0; n < 2; ++n) acc[a][b][m][n] = (f32x4){0.f, 0.f, 0.f, 0.f};
        }
        cur = nxt; cA = nA; cB = nB; ++ui;
        if constexpr (ALIGN_EPI) { if (wr == 1) PG8_BAR; }
    }
    PG8_WAIT_V(0);
    if constexpr (!ALIGN_EPI) { if (wr == 0) PG8_BAR; }
    PG8_BAR;
#undef PG8_SA
#undef PG8_SB
#undef PG8_STAGE
#undef PG8_LDA
#undef PG8_LDB
#undef PG8_MMA
#undef PG8_WAIT_V
#undef PG8_WAIT_L
#undef PG8_BAR
#undef PG8_SCHED
}
}
constexpr int D = 1024, BATCH = 16, SEQ = 2048, DEPTH = 4, T = BATCH * SEQ;
constexpr int NGRP = 2, TG = T / NGRP, BG = BATCH / NGRP;
constexpr int N_IN = 10264, NP = 10240, NWT = 10496;
constexpr int PC_SQ = 0, PC_SK = 512, PC_SV = 1024, PC_SZ = 1536, PC_DQ = 2048, PC_DZ = 3584, PC_LQ = 4096, PC_LK = 4608, PC_LV = 5120, PC_LZ = 6144, PC_MG = 7168;
constexpr int YC_SB = 0, YC_GDN = 512, YC_GLA = 1024, YW = 2048;
constexpr int NTHREADS = 512, NWAVES = 8;
constexpr float RMS_EPS = 1e-6f, L2_EPS = 1e-6f;

constexpr size_t MiB = 1u << 20;
constexpr size_t WS_CTL = 0, CTL_ZERO_BYTES = 1 * MiB;
constexpr size_t WS_MODP = 2 * MiB;
constexpr size_t WS_MOD = 8 * MiB;
constexpr size_t WS_WIN = 10 * MiB;
constexpr size_t WS_WP = 31 * MiB;
constexpr size_t WS_WO = 35 * MiB;
constexpr size_t WS_H = 40 * MiB;
constexpr size_t WS_MGB = 72 * MiB;
constexpr size_t WS_P = 104 * MiB;
constexpr size_t WS_PS = 424 * MiB;
constexpr size_t WS_Y = 426 * MiB;
constexpr size_t WS_MGF = 490 * MiB;
constexpr size_t WS_END = 640 * MiB;
constexpr size_t WS_GD_WN = 490 * MiB;
constexpr size_t WS_GD_BT = 522 * MiB;
constexpr size_t WS_GD_ST = 554 * MiB;
constexpr size_t WS_GD_QE = 586 * MiB;
constexpr size_t WS_GD_OL = 602 * MiB;
constexpr size_t WS_GD_CD = 618 * MiB;
constexpr int CW_BAR = 4096;

constexpr int RING_BYTES = 131072;
constexpr int MISC_OFF = RING_BYTES + 320;
constexpr int LDS_BYTES = 147456;

typedef unsigned short bf16;
typedef unsigned v4u __attribute__((ext_vector_type(4)));
typedef unsigned v2u __attribute__((ext_vector_type(2)));
typedef float f32x4 __attribute__((ext_vector_type(4)));
#define LDS_WAIT() asm volatile("s_waitcnt lgkmcnt(0)" ::: "memory")

__device__ __forceinline__ float bf2f(unsigned v) { return __uint_as_float(v << 16); }
__device__ __forceinline__ float bflo(unsigned w) { return __uint_as_float(w << 16); }
__device__ __forceinline__ float bfhi(unsigned w) { return __uint_as_float(w & 0xffff0000u); }
__device__ __forceinline__ unsigned f2bf(float f) { unsigned u = __float_as_uint(f); return (u + 0x7fffu + ((u >> 16) & 1u)) >> 16; }
__device__ __forceinline__ unsigned pk2(float lo, float hi) { return f2bf(lo) | (f2bf(hi) << 16); }
__device__ __forceinline__ float sigmoidf_(float x) { return 1.f / (1.f + __expf(-x)); }
__device__ __forceinline__ float siluf_(float x) { return x / (1.f + __expf(-x)); }
__device__ __forceinline__ float softplusf_(float x) { return fmaxf(x, 0.f) + log1pf(expf(-fabsf(x))); }
__device__ __forceinline__ float logsigf_(float x) { return fminf(x, 0.f) - log1pf(expf(-fabsf(x))); }

__device__ __forceinline__ int opq(int v) { asm volatile("" : "+v"(v)); return v; }
struct Args {
    const float* in[20];
    float* out; unsigned char* ws;
    int ph_lo, ph_hi;
};
struct Frame {
    LAS unsigned char* lds;
    int tid, lane, wave, G;
    const float *x, *c, *ada_w, *ada_b, *norm_g, *w_in, *sb_qnorm, *sb_knorm, *gdn_conv, *gdn_a_log, *gdn_dt_bias, *gdn_onorm, *gla_w2, *gla_b, *gla_onorm, *merge_b, *proj_sb, *proj_gdn, *proj_gla, *w_out;
    float* out; unsigned char* wsb;
    float *MODP, *MODA, *MODB, *MODG, *PS, *MGF;
    bf16 *WIN, *WP, *WO, *H, *MGB, *P, *Y, *GQKV;
};

struct EpiG1 {
    static constexpr bool PERM = true, MID = false;
    bf16* P; float* PS; const float* mb;
    __device__ __forceinline__ bool operator()(pg8::f32x4 (&acc)[2][2][4][2], const pg8::Unit& u, int wr, int wc, int fr, int fq) const {
        const int row0 = u.pm * 256 + wr * 64 + fr, pn = u.pn;
        if (pn < 40) {
            const int mode = (pn == 6 || pn == 7 || pn == 14 || pn == 15 || (pn >= 24 && pn < 28)) ? 1 : (pn >= 28 ? 2 : 0);
            const int col0 = pn * 256 + wc * 32 + 8 * fq;
            pg8::f32x4 bv[2][2];
#pragma unroll
            for (int bj = 0; bj < 2; ++bj)
#pragma unroll
                for (int n = 0; n < 2; ++n) bv[bj][n] = (mode == 2) ? *(const pg8::f32x4*)(mb + (col0 - PC_MG) + bj * 128 + 4 * n) : (pg8::f32x4){0.f, 0.f, 0.f, 0.f};
#pragma unroll
            for (int ai = 0; ai < 2; ++ai)
#pragma unroll
                for (int m = 0; m < 4; ++m) { bf16* rowp = P + (size_t)(row0 + ai * 128 + m * 16) * NP + col0;
#pragma unroll
                    for (int bj = 0; bj < 2; ++bj) { pg8::f32x4 v0 = acc[ai][bj][m][0], v1 = acc[ai][bj][m][1];
                        if (mode == 1) {
#pragma unroll
                            for (int j = 0; j < 4; ++j) { v0[j] = siluf_(v0[j]); v1[j] = siluf_(v1[j]); } }
                        else if (mode == 2) { v0 = v0 + bv[bj][0]; v1 = v1 + bv[bj][1];
#pragma unroll
                            for (int j = 0; j < 4; ++j) { v0[j] = sigmoidf_(v0[j]); v1[j] = sigmoidf_(v1[j]); } }
                        pg8::u32x4 w; w.x = pg8::cvt_pk_bf16(v0[0], v0[1]); w.y = pg8::cvt_pk_bf16(v0[2], v0[3]); w.z = pg8::cvt_pk_bf16(v1[0], v1[1]); w.w = pg8::cvt_pk_bf16(v1[2], v1[3]);
                        *(pg8::u32x4*)(rowp + bj * 128) = w; } }
        } else if (wc == 0 && fq < 3) {
#pragma unroll
            for (int ai = 0; ai < 2; ++ai)
#pragma unroll
                for (int m = 0; m < 4; ++m) { float* rowp = PS + (size_t)(row0 + ai * 128 + m * 16) * 32 + 8 * fq;
                    *(pg8::f32x4*)(rowp) = acc[ai][0][m][0]; *(pg8::f32x4*)(rowp + 4) = acc[ai][0][m][1]; }
        }
        return false;
    }
};
struct EpiG2R {
    static constexpr bool PERM = false, MID = true;
    static constexpr int MID_T0 = 8, MID_T1 = 16;
    const bf16* P; bf16* MGB;
    __device__ __forceinline__ void apply(pg8::f32x4 (&acc)[2][2][4][2], const pg8::Unit& u, int which, int wr, int wc, int fr, int fq) const {
        const unsigned row0 = u.pm * 256 + wr * 64 + fr, col0 = u.pn * 256 + wc * 32 + 4 * fq;
        const unsigned gn = (PC_MG + which * D) * 2, gd = (PC_MG + (which + 1) * D) * 2;
        const char* Pb = (const char*)P; char* Mb = (char*)MGB;
#pragma unroll
        for (int ai = 0; ai < 2; ++ai)
#pragma unroll
            for (int m = 0; m < 4; ++m) { const unsigned r = row0 + ai * 128 + m * 16; const unsigned po = (r * NP + col0) * 2u, mo = (r * D + col0) * 2u;
#pragma unroll
                for (int bj = 0; bj < 2; ++bj)
#pragma unroll
                    for (int n = 0; n < 2; ++n) { const unsigned co = (bj * 128 + n * 16) * 2;
                        const pg8::u32x2 gw = *(const pg8::u32x2*)(Pb + (po + gn + co));
                        pg8::f32x4 f; f[0] = bflo(gw.x); f[1] = bfhi(gw.x); f[2] = bflo(gw.y); f[3] = bfhi(gw.y);
                        if (which < 2) { const pg8::u32x2 dw = *(const pg8::u32x2*)(Pb + (po + gd + co));
                            f[0] *= __builtin_amdgcn_rcpf(fmaxf(bflo(dw.x), 1e-30f)); f[1] *= __builtin_amdgcn_rcpf(fmaxf(bfhi(dw.x), 1e-30f));
                            f[2] *= __builtin_amdgcn_rcpf(fmaxf(bflo(dw.y), 1e-30f)); f[3] *= __builtin_amdgcn_rcpf(fmaxf(bfhi(dw.y), 1e-30f)); }
                        const pg8::f32x4 v = acc[ai][bj][m][n] * f;
                        if (which < 2) acc[ai][bj][m][n] = v;
                        else { pg8::u32x2 w; w.x = pg8::cvt_pk_bf16(v[0], v[1]); w.y = pg8::cvt_pk_bf16(v[2], v[3]); *(pg8::u32x2*)(Mb + (mo + co)) = w; }
                        if (n == 1) asm volatile("" ::: "memory"); } }
    }
    __device__ __forceinline__ void mid(pg8::f32x4 (&acc)[2][2][4][2], const pg8::Unit& u, int t, int wr, int wc, int fr, int fq) const { apply(acc, u, t == MID_T0 ? 0 : 1, wr, wc, fr, fq); }
    __device__ __forceinline__ bool operator()(pg8::f32x4 (&acc)[2][2][4][2], const pg8::Unit& u, int wr, int wc, int fr, int fq) const { apply(acc, u, 2, wr, wc, fr, fq); return false; }
};
struct EpiG3 {
    static constexpr bool PERM = false, MID = false;
    const float* xin; float* out; const float* gate; int grow0;
    __device__ __forceinline__ bool operator()(pg8::f32x4 (&acc)[2][2][4][2], const pg8::Unit& u, int wr, int wc, int fr, int fq) const {
        const int row0 = grow0 + u.pm * 256 + wr * 64 + fr, col0 = u.pn * 256 + wc * 32 + 4 * fq;
        const float* gp = gate + (size_t)((grow0 + u.pm * 256) / SEQ) * D;
        pg8::f32x4 gv[2][2];
#pragma unroll
        for (int bj = 0; bj < 2; ++bj)
#pragma unroll
            for (int n = 0; n < 2; ++n) gv[bj][n] = *(const pg8::f32x4*)(gp + col0 + bj * 128 + n * 16);
#pragma unroll
        for (int ai = 0; ai < 2; ++ai)
#pragma unroll
            for (int m = 0; m < 4; ++m) { const size_t off = (size_t)(row0 + ai * 128 + m * 16) * D + col0;
#pragma unroll
                for (int bj = 0; bj < 2; ++bj)
#pragma unroll
                    for (int n = 0; n < 2; ++n) { const pg8::f32x4 xv = *(const pg8::f32x4*)(xin + off + bj * 128 + n * 16);
                        *(pg8::f32x4*)(out + off + bj * 128 + n * 16) = xv + gv[bj][n] * acc[ai][bj][m][n]; } }
        return false;
    }
};

__device__ __forceinline__ void transpose_item(const float* W, int ldw, int col0, bf16* WT, int ldd, int drow0, int dk0, int nblk, LAS float* scr, int item, int lane) {
    const int kb = item / nblk, nb = item % nblk, k0 = 64 * kb, n0 = 32 * nb;
#pragma unroll 8
    for (int i = 0; i < 32; ++i) { const int kk = 2 * i + (lane >> 5); scr[kk * 33 + (lane & 31)] = W[(size_t)(k0 + kk) * ldw + col0 + n0 + (lane & 31)]; }
    LDS_WAIT(); asm volatile("" ::: "memory");
    const int c = lane & 7;
#pragma unroll
    for (int j = 0; j < 4; ++j) { const int n = (lane >> 3) + 8 * j; const LAS float* s = scr + (8 * c) * 33 + n;
        v4u o; o.x = pk2(s[0 * 33], s[1 * 33]); o.y = pk2(s[2 * 33], s[3 * 33]); o.z = pk2(s[4 * 33], s[5 * 33]); o.w = pk2(s[6 * 33], s[7 * 33]);
        *(v4u*)(WT + (size_t)(drow0 + n0 + n) * ldd + dk0 + k0 + 8 * c) = o; }
    LDS_WAIT(); asm volatile("" ::: "memory");
}
__device__ __forceinline__ void p0_ada(Frame& F) {
    LAS float* cact = (LAS float*)F.lds;
    for (int i = F.tid; i < BATCH * D; i += NTHREADS) cact[i] = siluf_(F.c[i]);
    __syncthreads();
    for (int it = blockIdx.x; it < 4 * 8 * 6; it += F.G) {
        const int l = it / 48, ks = (it % 48) / 6, jc = it % 6, j = jc * 512 + F.tid;
        float a[16];
#pragma unroll
        for (int b = 0; b < 16; ++b) a[b] = 0.f;
        const float* wp = F.ada_w + ((size_t)l * D + ks * 128) * 3072 + j;
#pragma unroll 4
        for (int k = 0; k < 128; ++k) { const float w = wp[(size_t)k * 3072];
#pragma unroll
            for (int b = 0; b < 16; ++b) a[b] += cact[b * D + ks * 128 + k] * w; }
#pragma unroll
        for (int b = 0; b < 16; ++b) F.MODP[((size_t)(ks * 4 + l) * 16 + b) * 3072 + j] = a[b];
    }
}
__device__ __forceinline__ void wconv_layer(Frame& F, int l) {
    const int lane = opq(F.lane);
    LAS float* scr = (LAS float*)(F.lds + F.wave * 16384);
    const int gw = blockIdx.x * NWAVES + F.wave, NGW = F.G * NWAVES;
    constexpr int I_A = 16 * 128, I_B = 16 * 96, I_C = 16 * 96, I_SB = 8 * 32, I_GDN = 8 * 32, I_GLA = 16 * 32, I_WO = 16 * 32;
    constexpr int I_L = I_A + I_B + I_C + I_SB + I_GDN + I_GLA + I_WO;
    const float* win = F.w_in + (size_t)l * D * N_IN;
    for (int it = gw; it < I_L; it += NGW) {
        int r = it;
        if (r < I_A) { transpose_item(win, N_IN, 0, F.WIN, D, 0, 0, 128, scr, r, lane); continue; } r -= I_A;
        if (r < I_B) { transpose_item(win, N_IN, 4104, F.WIN, D, 4096, 0, 96, scr, r, lane); continue; } r -= I_B;
        if (r < I_C) { transpose_item(win, N_IN, 7192, F.WIN, D, 7168, 0, 96, scr, r, lane); continue; } r -= I_C;
        if (r < I_SB) { transpose_item(F.proj_sb + (size_t)l * 512 * D, D, 0, F.WP, 2048, 0, 0, 32, scr, r, lane); continue; } r -= I_SB;
        if (r < I_GDN) { transpose_item(F.proj_gdn + (size_t)l * 512 * D, D, 0, F.WP, 2048, 0, 512, 32, scr, r, lane); continue; } r -= I_GDN;
        if (r < I_GLA) { transpose_item(F.proj_gla + (size_t)l * D * D, D, 0, F.WP, 2048, 0, 1024, 32, scr, r, lane); continue; } r -= I_GLA;
        transpose_item(F.w_out + (size_t)l * D * D, D, 0, F.WO, D, 0, 0, 32, scr, r, lane);
    }
    for (int i = blockIdx.x * NTHREADS + opq(F.tid); i < 256 * D; i += F.G * NTHREADS) {
        const int r = i / D, k = i % D;
        float v = 0.f;
        if (r < 8) v = win[(size_t)k * N_IN + 4096 + r];
        else if (r < 24) v = win[(size_t)k * N_IN + 7176 + (r - 8)];
        F.WIN[(size_t)(10240 + r) * D + k] = (bf16)f2bf(v);
    }
    __syncthreads();
}
__device__ __forceinline__ void p1_mod(Frame& F) {
    for (int i = blockIdx.x * NTHREADS + F.tid; i < DEPTH * BATCH * D; i += F.G * NTHREADS) {
        const int l = i / (BATCH * D), b = (i / D) % BATCH, c = i % D;
        float sh = F.ada_b[l * 3072 + c], sc = F.ada_b[l * 3072 + D + c], gt = F.ada_b[l * 3072 + 2 * D + c];
#pragma unroll
        for (int ks = 0; ks < 8; ++ks) { const float* p = F.MODP + ((size_t)(ks * 4 + l) * 16 + b) * 3072; sh += p[c]; sc += p[D + c]; gt += p[2 * D + c]; }
        F.MODA[i] = F.norm_g[l * D + c] * (1.f + sc); F.MODB[i] = sh; F.MODG[i] = gt;
    }
}
__device__ __forceinline__ float wave_sum(float v) {
#pragma unroll
    for (int o = 1; o < 64; o <<= 1) v += __shfl_xor(v, o);
    return v;
}
__device__ __forceinline__ void phase_norm(Frame& F, const float* xin, int l, int g) {
    const int gw = blockIdx.x * NWAVES + F.wave, NGW = F.G * NWAVES, lane = opq(F.lane);
    for (int m = gw; m < TG; m += NGW) {
        const int grow = g * TG + m, b = grow / SEQ;
        const f32x4* xr = (const f32x4*)(xin + (size_t)grow * D) + lane;
        const f32x4* ma = (const f32x4*)(F.MODA + (size_t)(l * BATCH + b) * D) + lane;
        const f32x4* mb = (const f32x4*)(F.MODB + (size_t)(l * BATCH + b) * D) + lane;
        f32x4 v[4]; float s = 0.f;
#pragma unroll
        for (int j = 0; j < 4; ++j) { v[j] = xr[64 * j]; s += (v[j].x * v[j].x + v[j].y * v[j].y) + (v[j].z * v[j].z + v[j].w * v[j].w); }
        const float rstd = 1.f / sqrtf(wave_sum(s) * (1.f / D) + RMS_EPS);
        unsigned long long* o8 = (unsigned long long*)(F.H + (size_t)m * D) + lane;
#pragma unroll
        for (int j = 0; j < 4; ++j) { const f32x4 a = ma[64 * j], sh = mb[64 * j]; const f32x4 y = v[j] * rstd * a + sh;
            o8[64 * j] = (unsigned long long)pk2(y.x, y.y) | ((unsigned long long)pk2(y.z, y.w) << 32); }
    }
}
__device__ __forceinline__ void phase_prep(Frame& F, int l) {
    const int gw = blockIdx.x * NWAVES + F.wave, NGW = F.G * NWAVES, lane = opq(F.lane);
    for (int m = gw; m < TG; m += NGW) {
        {
            bf16* p = F.P + (size_t)m * NP + lane * 16;
            const v4u w0 = *(const v4u*)p, w1 = *(const v4u*)(p + 8);
            float x[16];
            x[0] = bflo(w0.x); x[1] = bfhi(w0.x); x[2] = bflo(w0.y); x[3] = bfhi(w0.y); x[4] = bflo(w0.z); x[5] = bfhi(w0.z); x[6] = bflo(w0.w); x[7] = bfhi(w0.w);
            x[8] = bflo(w1.x); x[9] = bfhi(w1.x); x[10] = bflo(w1.y); x[11] = bfhi(w1.y); x[12] = bflo(w1.z); x[13] = bfhi(w1.z); x[14] = bflo(w1.w); x[15] = bfhi(w1.w);
            float ss = 0.f;
#pragma unroll
            for (int i = 0; i < 16; ++i) ss += x[i] * x[i];
            ss += __shfl_xor(ss, 1); ss += __shfl_xor(ss, 2); ss += __shfl_xor(ss, 4);
            const float r = 1.f / sqrtf(ss * (1.f / 128.f) + RMS_EPS);
            const float* gn = (lane < 32 ? F.sb_qnorm : F.sb_knorm) + l * 128 + (lane & 7) * 16;
#pragma unroll
            for (int i = 0; i < 16; ++i) x[i] = x[i] * r * gn[i];
            v4u o0, o1;
            o0.x = pk2(x[0], x[1]); o0.y = pk2(x[2], x[3]); o0.z = pk2(x[4], x[5]); o0.w = pk2(x[6], x[7]);
            o1.x = pk2(x[8], x[9]); o1.y = pk2(x[10], x[11]); o1.z = pk2(x[12], x[13]); o1.w = pk2(x[14], x[15]);
            *(v4u*)p = o0; *(v4u*)(p + 8) = o1;
        }
    }
}
__device__ __forceinline__ void gdn_chain_naive(Frame& F, int l, int bh) {
    const int bl = bh >> 2, h = bh & 3, tid = opq(F.tid), v = tid & 127, kq = tid >> 7;
    LAS float* qv = (LAS float*)F.lds; LAS float* kv = qv + 128; LAS float* vv = kv + 128; LAS float* sc = vv + 128; LAS float* red = sc + 128; LAS float* red2 = red + 512;
    float s[32];
#pragma unroll
    for (int i = 0; i < 32; ++i) s[i] = 0.f;
    const float Aexp = expf(F.gdn_a_log[l * 4 + h]), dtb = F.gdn_dt_bias[l * 4 + h];
    for (int t = 0; t < SEQ; ++t) {
        const size_t row = (size_t)bl * SEQ + t;
        if (tid < 128) { const bf16* gp = F.GQKV + row * 1536 + h * 128 + tid; qv[tid] = bf2f(gp[0]); kv[tid] = bf2f(gp[512]); vv[tid] = bf2f(gp[1024]); }
        if (tid == 128) { const float db = F.PS[row * 32 + h], da = F.PS[row * 32 + 4 + h]; sc[0] = sigmoidf_(db); sc[1] = expf(-Aexp * softplusf_(da + dtb)); }
        __syncthreads();
        const float eg = sc[1]; float part = 0.f;
#pragma unroll
        for (int i = 0; i < 32; ++i) { s[i] *= eg; part += kv[kq * 32 + i] * s[i]; }
        red[kq * 128 + v] = part;
        __syncthreads();
        const float kS = (red[v] + red[128 + v]) + (red[256 + v] + red[384 + v]);
        const float delta = sc[0] * (vv[v] - kS); float part2 = 0.f;
#pragma unroll
        for (int i = 0; i < 32; ++i) { s[i] += kv[kq * 32 + i] * delta; part2 += qv[kq * 32 + i] * s[i]; }
        red2[kq * 128 + v] = part2;
        __syncthreads();
        if (tid < 128) { const float o = (red2[tid] + red2[128 + tid]) + (red2[256 + tid] + red2[384 + tid]); F.Y[row * YW + YC_GDN + h * 128 + tid] = (bf16)f2bf(o); }
    }
}
__device__ __forceinline__ void gla_chain_naive(Frame& F, int l, int bh) {
    const int bl = bh >> 2, h = bh & 3, tid = opq(F.tid), v = tid & 255, kh = tid >> 8;
    LAS float* qv = (LAS float*)F.lds; LAS float* kv = qv + 128; LAS float* ea = kv + 128; LAS float* vv = ea + 128; LAS float* red = vv + 256;
    float s[64];
#pragma unroll
    for (int i = 0; i < 64; ++i) s[i] = 0.f;
    float w2r[16]; float bb = 0.f;
    if (tid < 128) { bb = F.gla_b[l * 512 + h * 128 + tid];
#pragma unroll
        for (int r = 0; r < 16; ++r) w2r[r] = F.gla_w2[((size_t)l * 16 + r) * 512 + h * 128 + tid]; }
    else {
#pragma unroll
        for (int r = 0; r < 16; ++r) w2r[r] = 0.f; }
    for (int t = 0; t < SEQ; ++t) {
        const size_t row = (size_t)bl * SEQ + t;
        if (tid < 128) {
            const bf16* pp = F.P + row * NP + h * 128 + tid;
            qv[tid] = bf2f(pp[PC_LQ]) * 0.08838834764831845f; kv[tid] = bf2f(pp[PC_LK]);
            float xg = bb;
#pragma unroll
            for (int r = 0; r < 16; ++r) xg += F.PS[row * 32 + 8 + r] * w2r[r];
            ea[tid] = expf(logsigf_(xg) * (1.f / 16.f));
        } else if (tid >= 256) { vv[tid - 256] = bf2f(F.P[row * NP + PC_LV + h * 256 + (tid - 256)]); }
        __syncthreads();
        const float vvv = vv[v]; float part = 0.f;
#pragma unroll
        for (int i = 0; i < 64; ++i) { const int k = kh * 64 + i; s[i] = ea[k] * s[i] + kv[k] * vvv; part += qv[k] * s[i]; }
        red[kh * 256 + v] = part;
        __syncthreads();
        if (tid < 256) F.Y[row * YW + YC_GLA + h * 256 + tid] = (bf16)f2bf(red[tid] + red[256 + tid]);
    }
}
__device__ __forceinline__ void sb_naive(Frame& F, int w, int NW) {
    const int lane = opq(F.lane);
    for (int qi = w; qi < BG * 4 * SEQ; qi += NW) {
        const int bh = __builtin_amdgcn_readfirstlane(qi >> 11), t = __builtin_amdgcn_readfirstlane(qi & 2047), bl = bh >> 2, h = bh & 3;
        const size_t row = (size_t)bl * SEQ + t;
        const v4u* qp = (const v4u*)(F.P + row * NP + PC_SQ + h * 128);
        v4u qr[16];
#pragma unroll
        for (int i = 0; i < 16; ++i) qr[i] = qp[i];
        float acc0 = 0.f, acc1 = 0.f, R = 0.f;
        for (int kb = (t - 1) >> 6; kb >= 0; --kb) {
            const int s = kb * 64 + lane; const bool valid = s < t; const int sc = valid ? s : (t - 1);
            const v4u* kp = (const v4u*)(F.P + ((size_t)bl * SEQ + sc) * NP + PC_SK + h * 128);
            float dot = 0.f;
#pragma unroll
            for (int i = 0; i < 16; ++i) { const v4u kw = kp[i]; const v4u qw = qr[i];
                dot += bflo(kw.x) * bflo(qw.x) + bfhi(kw.x) * bfhi(qw.x) + bflo(kw.y) * bflo(qw.y) + bfhi(kw.y) * bfhi(qw.y)
                     + bflo(kw.z) * bflo(qw.z) + bfhi(kw.z) * bfhi(qw.z) + bflo(kw.w) * bflo(qw.w) + bfhi(kw.w) * bfhi(qw.w); }
            const float z = dot * 0.08838834764831845f;
            const float l1m = valid ? logsigf_(-z) : 0.f;
            float incl = l1m;
#pragma unroll
            for (int off = 1; off < 64; off <<= 1) { const float tmp = __shfl_down(incl, off); incl += (lane + off < 64) ? tmp : 0.f; }
            const float tail = R + incl - l1m;
            const float wgt = valid ? expf(logsigf_(z) + tail) : 0.f;
            R += __shfl(incl, 0);
            const bf16* vbase = F.P + ((size_t)bl * SEQ + kb * 64) * NP + PC_SV + h * 128 + 2 * lane;
            for (int j = 0; j < 64; ++j) { const float wj = __shfl(wgt, j);
                if (wj != 0.f) { const unsigned vw = *(const unsigned*)(vbase + (size_t)j * NP); acc0 += wj * bflo(vw); acc1 += wj * bfhi(vw); } }
            if (R < -104.f) break;
        }
        const unsigned zw = *(const unsigned*)(F.P + row * NP + PC_SZ + h * 128 + 2 * lane);
        *(unsigned*)(F.Y + row * YW + YC_SB + h * 128 + 2 * lane) = pk2(acc0 * bflo(zw), acc1 * bfhi(zw));
    }
}
typedef short bf16x8 __attribute__((ext_vector_type(8)));
__device__ __forceinline__ f32x4 mm16(const LAS bf16* A, int lda, int m0, const LAS bf16* Bt, int ldb, int n0, int K, int lane, f32x4 acc) {
    const LAS bf16* ap = A + (m0 + (lane & 15)) * lda + (lane >> 4) * 8;
    const LAS bf16* bp = Bt + (n0 + (lane & 15)) * ldb + (lane >> 4) * 8;
#pragma unroll
    for (int k0 = 0; k0 < K; k0 += 32) acc = __builtin_amdgcn_mfma_f32_16x16x32_bf16(*(const LAS bf16x8*)(ap + k0), *(const LAS bf16x8*)(bp + k0), acc, 0, 0, 0);
    return acc;
}
__device__ __forceinline__ v2u pk4(const f32x4 a) { v2u r; r.x = pk2(a[0], a[1]); r.y = pk2(a[2], a[3]); return r; }

constexpr int GP_QS = 0, GP_KN = 17408, GP_AM = 34816, GP_QK = 54272, GP_TM = 63488, GP_VBT = 72704, GP_KBT = 91136, GP_KDT = 109568, GP_SC = 128000;
constexpr int GP_UBT = 17408, GP_WKT = 35840;
__device__ __forceinline__ void conv16(const Frame& F, const bf16* prow, int pos, const float* cw, float (&y)[16]) {
#pragma unroll
    for (int e = 0; e < 16; ++e) y[e] = 0.f;
#pragma unroll
    for (int tap = 0; tap < 4; ++tap) {
        const int dt = tap - 3;
        if (pos + dt >= 0) {
            const v4u w0 = *(const v4u*)(prow + (long)dt * NP), w1 = *(const v4u*)(prow + (long)dt * NP + 8);
            const f32x4 c0 = *(const f32x4*)(cw + tap * 1536), c1 = *(const f32x4*)(cw + tap * 1536 + 4), c2 = *(const f32x4*)(cw + tap * 1536 + 8), c3 = *(const f32x4*)(cw + tap * 1536 + 12);
            y[0] += c0[0] * bflo(w0.x); y[1] += c0[1] * bfhi(w0.x); y[2] += c0[2] * bflo(w0.y); y[3] += c0[3] * bfhi(w0.y);
            y[4] += c1[0] * bflo(w0.z); y[5] += c1[1] * bfhi(w0.z); y[6] += c1[2] * bflo(w0.w); y[7] += c1[3] * bfhi(w0.w);
            y[8] += c2[0] * bflo(w1.x); y[9] += c2[1] * bfhi(w1.x); y[10] += c2[2] * bflo(w1.y); y[11] += c2[3] * bfhi(w1.y);
            y[12] += c3[0] * bflo(w1.z); y[13] += c3[1] * bfhi(w1.z); y[14] += c3[2] * bflo(w1.w); y[15] += c3[3] * bfhi(w1.w);
        }
    }
#pragma unroll
    for (int e = 0; e < 16; ++e) y[e] = siluf_(y[e]);
}
__device__ __forceinline__ void gdn_pre_unit(Frame& F, int l, int unit) {
    const int tid = opq(F.tid), lane = tid & 63, w = __builtin_amdgcn_readfirstlane(tid >> 6);
    const int n = unit & 31, bh = unit >> 5, bl = bh >> 2, h = bh & 3;
    LAS bf16* Qs = (LAS bf16*)(F.lds + GP_QS); LAS bf16* Kn = (LAS bf16*)(F.lds + GP_KN); LAS float* Am = (LAS float*)(F.lds + GP_AM);
    LAS bf16* QKm = (LAS bf16*)(F.lds + GP_QK); LAS bf16* Tm = (LAS bf16*)(F.lds + GP_TM); LAS bf16* VbT = (LAS bf16*)(F.lds + GP_VBT);
    LAS bf16* KbT = (LAS bf16*)(F.lds + GP_KBT); LAS bf16* KdT = (LAS bf16*)(F.lds + GP_KDT); LAS bf16* UbT = (LAS bf16*)(F.lds + GP_UBT); LAS bf16* WkT = (LAS bf16*)(F.lds + GP_WKT);
    LAS float* gamA = (LAS float*)(F.lds + GP_SC); LAS float* betaA = gamA + 64; LAS float* gA = betaA + 64;
    const int row0 = bl * SEQ + n * 64;
    if (tid < 64) {
        const float db = F.PS[(size_t)(row0 + tid) * 32 + h], da = F.PS[(size_t)(row0 + tid) * 32 + 4 + h];
        betaA[tid] = sigmoidf_(db);
        gA[tid] = -expf(F.gdn_a_log[l * 4 + h]) * softplusf_(da + F.gdn_dt_bias[l * 4 + h]);
    }
    __syncthreads();
    const int i = tid >> 3, sub = tid & 7, c16 = sub * 16;
    float gam_i = 0.f, gl = 0.f;
    for (int j = 0; j < 64; ++j) { const float gj = gA[j]; gl += gj; if (j <= i) gam_i += gj; }
    const float beta_i = betaA[i];
    if (sub == 0) gamA[i] = gam_i;
    {
        const int pos = n * 64 + i;
        const bf16* prow = F.P + (size_t)(row0 + i) * NP + PC_DQ + h * 128 + c16;
        const float* cw = F.gdn_conv + (size_t)l * 4 * 1536 + h * 128 + c16;
        float y[16];
        conv16(F, prow, pos, cw, y);
        { float ss = 0.f;
#pragma unroll
          for (int e = 0; e < 16; ++e) ss += y[e] * y[e];
          ss += __shfl_xor(ss, 1); ss += __shfl_xor(ss, 2); ss += __shfl_xor(ss, 4);
          const float r = 0.08838834764831845f / sqrtf(ss + L2_EPS);
          v4u o0, o1; o0.x = pk2(y[0] * r, y[1] * r); o0.y = pk2(y[2] * r, y[3] * r); o0.z = pk2(y[4] * r, y[5] * r); o0.w = pk2(y[6] * r, y[7] * r);
          o1.x = pk2(y[8] * r, y[9] * r); o1.y = pk2(y[10] * r, y[11] * r); o1.z = pk2(y[12] * r, y[13] * r); o1.w = pk2(y[14] * r, y[15] * r);
          *(LAS v4u*)(Qs + i * 136 + c16) = o0; *(LAS v4u*)(Qs + i * 136 + c16 + 8) = o1; }
        conv16(F, prow + 512, pos, cw + 512, y);
        { float ss = 0.f;
#pragma unroll
          for (int e = 0; e < 16; ++e) ss += y[e] * y[e];
          ss += __shfl_xor(ss, 1); ss += __shfl_xor(ss, 2); ss += __shfl_xor(ss, 4);
          const float r = 1.f / sqrtf(ss + L2_EPS);
#pragma unroll
          for (int e = 0; e < 16; ++e) y[e] *= r;
          v4u o0, o1; o0.x = pk2(y[0], y[1]); o0.y = pk2(y[2], y[3]); o0.z = pk2(y[4], y[5]); o0.w = pk2(y[6], y[7]);
          o1.x = pk2(y[8], y[9]); o1.y = pk2(y[10], y[11]); o1.z = pk2(y[12], y[13]); o1.w = pk2(y[14], y[15]);
          *(LAS v4u*)(Kn + i * 136 + c16) = o0; *(LAS v4u*)(Kn + i * 136 + c16 + 8) = o1;
          const float fb = beta_i * __expf(gam_i), fd = __expf(gl - gam_i);
#pragma unroll
          for (int e = 0; e < 16; ++e) { KbT[(c16 + e) * 72 + i] = (bf16)f2bf(y[e] * fb); KdT[(c16 + e) * 72 + i] = (bf16)f2bf(y[e] * fd); } }
        conv16(F, prow + 1024, pos, cw + 1024, y);
#pragma unroll
        for (int e = 0; e < 16; ++e) VbT[(c16 + e) * 72 + i] = (bf16)f2bf(y[e] * beta_i);
    }
    __syncthreads();
#pragma unroll
    for (int t = 0; t < 2; ++t) {
        const int idx = 2 * w + t, mb = idx >> 2, nb = idx & 3;
        const f32x4 z4 = {0.f, 0.f, 0.f, 0.f};
        const f32x4 akk = mm16(Kn, 136, mb * 16, Kn, 136, nb * 16, 128, lane, z4);
        const f32x4 aqk = mm16(Qs, 136, mb * 16, Kn, 136, nb * 16, 128, lane, z4);
        const int j = nb * 16 + (lane & 15); const float gj = gamA[j];
#pragma unroll
        for (int e = 0; e < 4; ++e) { const int ii = mb * 16 + 4 * (lane >> 4) + e; const float dc = __expf(fminf(gamA[ii] - gj, 0.f));
            Am[ii * 68 + j] = (ii > j) ? betaA[ii] * akk[e] * dc : 0.f;
            QKm[ii * 72 + j] = (bf16)f2bf((ii >= j) ? aqk[e] * dc : 0.f); }
    }
    __syncthreads();
#ifdef PROBE_TINV
    for (int rep_ = 0; rep_ < 2; ++rep_)
#endif
    if (w == 0) {
        float Tc[64];
#pragma clang loop unroll(full)
        for (int ii = 0; ii < 64; ++ii) {
            float s = (ii == lane) ? 1.f : 0.f;
#pragma clang loop unroll(full)
            for (int j = 0; j < ii; ++j) s -= Am[ii * 68 + j] * Tc[j];
            Tc[ii] = s;
            Tm[ii * 72 + lane] = (bf16)f2bf(s);
        }
    }
    __syncthreads();
#pragma unroll 1
    for (int b = 0; b < 8; ++b) {
        const int idx = w * 8 + b, which = idx >> 5, mb = (idx & 31) >> 3, nb = idx & 7;
        const f32x4 z4 = {0.f, 0.f, 0.f, 0.f};
        const f32x4 a = mm16(Tm, 72, mb * 16, which ? KbT : VbT, 72, nb * 16, 64, lane, z4);
        LAS bf16* dst = which ? WkT : UbT;
        *(LAS v2u*)(dst + (nb * 16 + (lane & 15)) * 72 + mb * 16 + 4 * (lane >> 4)) = pk4(a);
    }
    __syncthreads();
    bf16* gWN = (bf16*)(F.wsb + WS_GD_WN) + (size_t)unit * 16384; bf16* gBT = (bf16*)(F.wsb + WS_GD_BT) + (size_t)unit * 16384;
    bf16* gQE = (bf16*)(F.wsb + WS_GD_QE) + (size_t)unit * 8192; bf16* gOL = (bf16*)(F.wsb + WS_GD_OL) + (size_t)unit * 8192;
    if (tid == 0) ((float*)(F.wsb + WS_GD_CD))[unit] = __expf(gl);
#pragma unroll 1
    for (int b = 0; b < 24; ++b) {
        const int idx = w * 24 + b;
        const f32x4 z4 = {0.f, 0.f, 0.f, 0.f};
        const int q4 = 4 * (lane >> 4), c = lane & 15;
        if (idx < 64) {
            const int mb = idx >> 3, nb = idx & 7;
            f32x4 a = mm16(WkT, 72, mb * 16, KdT, 72, nb * 16, 64, lane, z4);
            a = -a;
            *(v2u*)(gWN + (nb * 16 + c) * 128 + mb * 16 + q4) = pk4(a);
        } else if (idx < 128) {
            const int x = idx - 64, mb = x >> 3, nb = x & 7;
            const f32x4 a = mm16(KdT, 72, mb * 16, UbT, 72, nb * 16, 64, lane, z4);
            *(v2u*)(gBT + (nb * 16 + c) * 128 + mb * 16 + q4) = pk4(a);
        } else if (idx < 160) {
            const int x = idx - 128, mb = x >> 2, nb = x & 3;
            const f32x4 a = mm16(WkT, 72, mb * 16, QKm, 72, nb * 16, 64, lane, z4);
            const int ii = nb * 16 + c, d0 = mb * 16 + q4; const float eg = __expf(gamA[ii]);
            const v2u qw = *(const LAS v2u*)(Qs + ii * 136 + d0);
            f32x4 r; r[0] = bflo(qw.x) * eg - a[0]; r[1] = bfhi(qw.x) * eg - a[1]; r[2] = bflo(qw.y) * eg - a[2]; r[3] = bfhi(qw.y) * eg - a[3];
            *(v2u*)(gQE + ii * 128 + d0) = pk4(r);
        } else {
            const int x = idx - 160, mb = x >> 3, nb = x & 7;
            const f32x4 a = mm16(QKm, 72, mb * 16, UbT, 72, nb * 16, 64, lane, z4);
            *(v2u*)(gOL + (nb * 16 + c) * 64 + mb * 16 + q4) = pk4(a);
        }
    }
    __syncthreads();
}
__device__ __forceinline__ void gdn_chain(Frame& F, int bh) {
    const int tid = opq(F.tid), lane = tid & 63, w = __builtin_amdgcn_readfirstlane(tid >> 6);
    LAS bf16* Wl = (LAS bf16*)F.lds;
    LAS bf16* Sw = (LAS bf16*)(F.lds + 2 * 34816) + w * (16 * 136);
    const bf16* gWN = (const bf16*)(F.wsb + WS_GD_WN) + (size_t)bh * 32 * 16384;
    const bf16* gBT = (const bf16*)(F.wsb + WS_GD_BT) + (size_t)bh * 32 * 16384;
    bf16* gST = (bf16*)(F.wsb + WS_GD_ST) + (size_t)bh * 32 * 16384;
    const float* gCD = (const float*)(F.wsb + WS_GD_CD) + bh * 32;
    f32x4 acc[8];
#pragma unroll
    for (int mb = 0; mb < 8; ++mb) acc[mb] = (f32x4){0.f, 0.f, 0.f, 0.f};
    const int c = lane & 15, q4 = 4 * (lane >> 4);
    v4u wreg[4]; v2u breg[8]; float cd;
#pragma unroll
    for (int k = 0; k < 4; ++k) { const int p = tid + 512 * k; wreg[k] = *(const v4u*)(gWN + (size_t)(p >> 4) * 128 + (p & 15) * 8); }
#pragma unroll
    for (int mb = 0; mb < 8; ++mb) breg[mb] = *(const v2u*)(gBT + (16 * w + c) * 128 + mb * 16 + q4);
    cd = gCD[0];
#pragma unroll
    for (int k = 0; k < 4; ++k) { const int p = tid + 512 * k; *(LAS v4u*)(Wl + (p >> 4) * 136 + (p & 15) * 8) = wreg[k]; }
    for (int n = 0; n < 32; ++n) {
        LAS bf16* Wc = Wl + (n & 1) * (128 * 136); LAS bf16* Wn = Wl + ((n + 1) & 1) * (128 * 136);
#pragma unroll
        for (int mb = 0; mb < 8; ++mb) { const v2u pk = pk4(acc[mb]);
            *(LAS v2u*)(Sw + c * 136 + mb * 16 + q4) = pk;
            *(v2u*)(gST + (size_t)n * 16384 + (16 * w + c) * 128 + mb * 16 + q4) = pk; }
        __syncthreads();
        v2u bcur[8]; const float cdc = cd;
#pragma unroll
        for (int mb = 0; mb < 8; ++mb) bcur[mb] = breg[mb];
        if (n + 1 < 32) {
#pragma unroll
            for (int k = 0; k < 4; ++k) { const int p = tid + 512 * k; wreg[k] = *(const v4u*)(gWN + (size_t)(n + 1) * 16384 + (size_t)(p >> 4) * 128 + (p & 15) * 8); }
#pragma unroll
            for (int mb = 0; mb < 8; ++mb) breg[mb] = *(const v2u*)(gBT + (size_t)(n + 1) * 16384 + (16 * w + c) * 128 + mb * 16 + q4);
            cd = gCD[n + 1];
        }
#pragma unroll
        for (int mb = 0; mb < 8; ++mb) {
            f32x4 a = acc[mb] * cdc; a[0] += bflo(bcur[mb].x); a[1] += bfhi(bcur[mb].x); a[2] += bflo(bcur[mb].y); a[3] += bfhi(bcur[mb].y);
            acc[mb] = mm16(Wc, 136, mb * 16, Sw, 136, 0, 128, lane, a);
        }
        if (n + 1 < 32) {
#pragma unroll
            for (int k = 0; k < 4; ++k) { const int p = tid + 512 * k; *(LAS v4u*)(Wn + (p >> 4) * 136 + (p & 15) * 8) = wreg[k]; } }
    }
    __syncthreads();
}
__device__ __forceinline__ void gdn_post_unit(Frame& F, int l, int unit) {
    const int tid = opq(F.tid), lane = tid & 63, w = __builtin_amdgcn_readfirstlane(tid >> 6);
    const int n = unit & 31, bh = unit >> 5, bl = bh >> 2, h = bh & 3;
    LAS bf16* QEl = (LAS bf16*)F.lds;
    LAS bf16* STl = (LAS bf16*)(F.lds + 17408);
    LAS float* Of = (LAS float*)(F.lds + 52224);
    const bf16* gQE = (const bf16*)(F.wsb + WS_GD_QE) + (size_t)unit * 8192; const bf16* gST = (const bf16*)(F.wsb + WS_GD_ST) + (size_t)unit * 16384;
    const bf16* gOL = (const bf16*)(F.wsb + WS_GD_OL) + (size_t)unit * 8192;
#pragma unroll
    for (int k = 0; k < 2; ++k) { const int p = tid + 512 * k; *(LAS v4u*)(QEl + (p >> 4) * 136 + (p & 15) * 8) = *(const v4u*)(gQE + (size_t)(p >> 4) * 128 + (p & 15) * 8); }
#pragma unroll
    for (int k = 0; k < 4; ++k) { const int p = tid + 512 * k; *(LAS v4u*)(STl + (p >> 4) * 136 + (p & 15) * 8) = *(const v4u*)(gST + (size_t)(p >> 4) * 128 + (p & 15) * 8); }
    __syncthreads();
    const int c = lane & 15, q4 = 4 * (lane >> 4);
#pragma unroll
    for (int t = 0; t < 4; ++t) {
        const int mb = w >> 1, nb = (w & 1) * 4 + t, dv = nb * 16 + c, i0 = mb * 16 + q4;
        const v2u ow = *(const v2u*)(gOL + dv * 64 + i0);
        f32x4 a; a[0] = bflo(ow.x); a[1] = bfhi(ow.x); a[2] = bflo(ow.y); a[3] = bfhi(ow.y);
        a = mm16(QEl, 136, mb * 16, STl, 136, nb * 16, 128, lane, a);
#pragma unroll
        for (int e = 0; e < 4; ++e) Of[(i0 + e) * 132 + dv] = a[e];
    }
    __syncthreads();
    {
        const int i = tid >> 3, sub = tid & 7, c16 = sub * 16; const size_t row = (size_t)bl * SEQ + n * 64 + i;
        float x[16]; float ss = 0.f;
#pragma unroll
        for (int e = 0; e < 16; ++e) { x[e] = Of[i * 132 + c16 + e]; ss += x[e] * x[e]; }
        ss += __shfl_xor(ss, 1); ss += __shfl_xor(ss, 2); ss += __shfl_xor(ss, 4);
        const float r = 1.f / sqrtf(ss * (1.f / 128.f) + RMS_EPS);
        const float* gn = F.gdn_onorm + l * 128 + c16;
        const v4u z0 = *(const v4u*)(F.P + row * NP + PC_DZ + h * 128 + c16), z1 = *(const v4u*)(F.P + row * NP + PC_DZ + h * 128 + c16 + 8);
        const float zg[16] = {bflo(z0.x), bfhi(z0.x), bflo(z0.y), bfhi(z0.y), bflo(z0.z), bfhi(z0.z), bflo(z0.w), bfhi(z0.w), bflo(z1.x), bfhi(z1.x), bflo(z1.y), bfhi(z1.y), bflo(z1.z), bfhi(z1.z), bflo(z1.w), bfhi(z1.w)};
#pragma unroll
        for (int e = 0; e < 16; ++e) x[e] = x[e] * r * gn[e] * zg[e];
        v4u o0, o1; o0.x = pk2(x[0], x[1]); o0.y = pk2(x[2], x[3]); o0.z = pk2(x[4], x[5]); o0.w = pk2(x[6], x[7]);
        o1.x = pk2(x[8], x[9]); o1.y = pk2(x[10], x[11]); o1.z = pk2(x[12], x[13]); o1.w = pk2(x[14], x[15]);
        bf16* yp = F.Y + row * YW + YC_GDN + h * 128 + c16;
        *(v4u*)yp = o0; *(v4u*)(yp + 8) = o1;
    }
    __syncthreads();
}
constexpr size_t WS_GL_BS = 40 * MiB;
constexpr size_t WS_GL_AN = 619 * MiB;
constexpr int GL_LA = 0, GL_QD = 33792, GL_KT = 51200, GL_ATT = 68608, GL_VT = 77824, GL_LR = 114688, GL_GL = 118784;
__device__ __forceinline__ void gla_gam(Frame& F, int l, int h, int row0, int tid) {
    LAS float* laL = (LAS float*)(F.lds + GL_LA); LAS float* lrL = (LAS float*)(F.lds + GL_LR); LAS float* glL = (LAS float*)(F.lds + GL_GL);
#pragma unroll
    for (int k = 0; k < 2; ++k) { const int p = tid + 512 * k; lrL[p] = F.PS[(size_t)(row0 + (p >> 4)) * 32 + 8 + (p & 15)]; }
    const int d = tid & 127, ig = tid >> 7;
    float w2r[16]; const float bb = F.gla_b[l * 512 + h * 128 + d];
#pragma unroll
    for (int r = 0; r < 16; ++r) w2r[r] = F.gla_w2[((size_t)l * 16 + r) * 512 + h * 128 + d];
    __syncthreads();
#pragma unroll 4
    for (int ii = 0; ii < 16; ++ii) { const int i = ig * 16 + ii; float x = bb;
#pragma unroll
        for (int r = 0; r < 16; ++r) x += lrL[i * 16 + r] * w2r[r];
        laL[i * 132 + d] = (fminf(x, 0.f) - __logf(1.f + __expf(-fabsf(x)))) * (1.f / 16.f); }
    __syncthreads();
    if (tid < 128) { float run = 0.f;
        for (int i = 0; i < 64; ++i) { run += laL[i * 132 + tid]; laL[i * 132 + tid] = run; }
        glL[tid] = run; }
    __syncthreads();
}
__device__ __forceinline__ void gla_pre_unit(Frame& F, int l, int unit) {
    const int tid = opq(F.tid), lane = tid & 63, w = __builtin_amdgcn_readfirstlane(tid >> 6);
    const int n = unit & 31, bh = unit >> 5, bl = bh >> 2, h = bh & 3, row0 = bl * SEQ + n * 64;
    LAS float* laL = (LAS float*)(F.lds + GL_LA); LAS float* glL = (LAS float*)(F.lds + GL_GL);
    LAS bf16* KdT = (LAS bf16*)(F.lds + GL_QD);
    LAS bf16* VT = (LAS bf16*)(F.lds + GL_VT);
    gla_gam(F, l, h, row0, tid);
    {
        const int i = tid >> 3, sub = tid & 7;
        const bf16* kp = F.P + (size_t)(row0 + i) * NP + PC_LK + h * 128 + sub * 16;
        const v4u k0 = *(const v4u*)kp, k1 = *(const v4u*)(kp + 8);
        const float kk[16] = {bflo(k0.x), bfhi(k0.x), bflo(k0.y), bfhi(k0.y), bflo(k0.z), bfhi(k0.z), bflo(k0.w), bfhi(k0.w), bflo(k1.x), bfhi(k1.x), bflo(k1.y), bfhi(k1.y), bflo(k1.z), bfhi(k1.z), bflo(k1.w), bfhi(k1.w)};
#pragma unroll
        for (int e = 0; e < 16; ++e) { const int d = sub * 16 + e; KdT[d * 72 + i] = (bf16)f2bf(kk[e] * __expf(glL[d] - laL[i * 132 + d])); }
        const bf16* vp = F.P + (size_t)(row0 + i) * NP + PC_LV + h * 256 + sub * 32;
#pragma unroll
        for (int k = 0; k < 4; ++k) { const v4u vw = *(const v4u*)(vp + 8 * k); const int dv = sub * 32 + 8 * k;
            VT[(dv + 0) * 72 + i] = (bf16)(vw.x & 0xffff); VT[(dv + 1) * 72 + i] = (bf16)(vw.x >> 16); VT[(dv + 2) * 72 + i] = (bf16)(vw.y & 0xffff); VT[(dv + 3) * 72 + i] = (bf16)(vw.y >> 16);
            VT[(dv + 4) * 72 + i] = (bf16)(vw.z & 0xffff); VT[(dv + 5) * 72 + i] = (bf16)(vw.z >> 16); VT[(dv + 6) * 72 + i] = (bf16)(vw.w & 0xffff); VT[(dv + 7) * 72 + i] = (bf16)(vw.w >> 16); }
        if (tid < 128) ((float*)(F.wsb + WS_GL_AN))[(size_t)unit * 128 + tid] = __expf(glL[tid]);
    }
    __syncthreads();
    bf16* gBS = (bf16*)(F.wsb + WS_GL_BS) + (size_t)unit * 32768;
    const int c = lane & 15, q4 = 4 * (lane >> 4);
#pragma unroll 1
    for (int b = 0; b < 16; ++b) {
        const int idx = w * 16 + b, mb = idx >> 4, nb = idx & 15;
        const f32x4 z4 = {0.f, 0.f, 0.f, 0.f};
        const f32x4 a = mm16(KdT, 72, mb * 16, VT, 72, nb * 16, 64, lane, z4);
        *(v2u*)(gBS + (nb * 16 + c) * 128 + mb * 16 + q4) = pk4(a);
    }
    __syncthreads();
}
__device__ __forceinline__ void gla_scan(Frame& F, int bidx, int nblk) {
    const int tid = opq(F.tid);
    for (int item = bidx * NTHREADS + tid; item < BG * 4 * 4096; item += nblk * NTHREADS) {
        const int bh = item >> 12, rem = item & 4095, dv = rem >> 4, d8 = (rem & 15) * 8;
        bf16* base = (bf16*)(F.wsb + WS_GL_BS) + (size_t)bh * 32 * 32768 + dv * 128 + d8;
        const float* an = (const float*)(F.wsb + WS_GL_AN) + (size_t)bh * 32 * 128 + d8;
        float s[8];
#pragma unroll
        for (int e = 0; e < 8; ++e) s[e] = 0.f;
#pragma unroll 4
        for (int n = 0; n < 32; ++n) {
            const v4u bw = *(const v4u*)(base + (size_t)n * 32768);
            const f32x4 a0 = *(const f32x4*)(an + n * 128), a1 = *(const f32x4*)(an + n * 128 + 4);
            if (n >= 1) { v4u o; o.x = pk2(s[0], s[1]); o.y = pk2(s[2], s[3]); o.z = pk2(s[4], s[5]); o.w = pk2(s[6], s[7]); *(v4u*)(base + (size_t)(n - 1) * 32768) = o; }
            s[0] = a0[0] * s[0] + bflo(bw.x); s[1] = a0[1] * s[1] + bfhi(bw.x); s[2] = a0[2] * s[2] + bflo(bw.y); s[3] = a0[3] * s[3] + bfhi(bw.y);
            s[4] = a1[0] * s[4] + bflo(bw.z); s[5] = a1[1] * s[5] + bfhi(bw.z); s[6] = a1[2] * s[6] + bflo(bw.w); s[7] = a1[3] * s[7] + bfhi(bw.w);
        }
    }
}
__device__ __forceinline__ void gla_post_unit(Frame& F, int l, int unit) {
    const int tid = opq(F.tid), lane = tid & 63, w = __builtin_amdgcn_readfirstlane(tid >> 6);
    const int n = unit & 31, bh = unit >> 5, bl = bh >> 2, h = bh & 3, row0 = bl * SEQ + n * 64;
    LAS float* laL = (LAS float*)(F.lds + GL_LA);
    LAS bf16* QdL = (LAS bf16*)(F.lds + GL_QD); LAS bf16* KtL = (LAS bf16*)(F.lds + GL_KT); LAS bf16* AttL = (LAS bf16*)(F.lds + GL_ATT); LAS bf16* VT = (LAS bf16*)(F.lds + GL_VT);
    LAS float* Of = (LAS float*)F.lds;
    gla_gam(F, l, h, row0, tid);
    {
        const int i = tid >> 3, sub = tid & 7;
        const bf16* qp = F.P + (size_t)(row0 + i) * NP + PC_LQ + h * 128 + sub * 16;
        const v4u q0 = *(const v4u*)qp, q1 = *(const v4u*)(qp + 8), k0 = *(const v4u*)(qp + 512), k1 = *(const v4u*)(qp + 520);
        const float qq[16] = {bflo(q0.x), bfhi(q0.x), bflo(q0.y), bfhi(q0.y), bflo(q0.z), bfhi(q0.z), bflo(q0.w), bfhi(q0.w), bflo(q1.x), bfhi(q1.x), bflo(q1.y), bfhi(q1.y), bflo(q1.z), bfhi(q1.z), bflo(q1.w), bfhi(q1.w)};
        const float kk[16] = {bflo(k0.x), bfhi(k0.x), bflo(k0.y), bfhi(k0.y), bflo(k0.z), bfhi(k0.z), bflo(k0.w), bfhi(k0.w), bflo(k1.x), bfhi(k1.x), bflo(k1.y), bfhi(k1.y), bflo(k1.z), bfhi(k1.z), bflo(k1.w), bfhi(k1.w)};
        float qd[16], kt[16];
#pragma unroll
        for (int e = 0; e < 16; ++e) { const float gm = laL[i * 132 + sub * 16 + e]; qd[e] = qq[e] * 0.08838834764831845f * __expf(gm); kt[e] = kk[e] * __expf(-gm); }
        v4u o0, o1; o0.x = pk2(qd[0], qd[1]); o0.y = pk2(qd[2], qd[3]); o0.z = pk2(qd[4], qd[5]); o0.w = pk2(qd[6], qd[7]);
        o1.x = pk2(qd[8], qd[9]); o1.y = pk2(qd[10], qd[11]); o1.z = pk2(qd[12], qd[13]); o1.w = pk2(qd[14], qd[15]);
        *(LAS v4u*)(QdL + i * 136 + sub * 16) = o0; *(LAS v4u*)(QdL + i * 136 + sub * 16 + 8) = o1;
        o0.x = pk2(kt[0], kt[1]); o0.y = pk2(kt[2], kt[3]); o0.z = pk2(kt[4], kt[5]); o0.w = pk2(kt[6], kt[7]);
        o1.x = pk2(kt[8], kt[9]); o1.y = pk2(kt[10], kt[11]); o1.z = pk2(kt[12], kt[13]); o1.w = pk2(kt[14], kt[15]);
        *(LAS v4u*)(KtL + i * 136 + sub * 16) = o0; *(LAS v4u*)(KtL + i * 136 + sub * 16 + 8) = o1;
        const bf16* vp = F.P + (size_t)(row0 + i) * NP + PC_LV + h * 256 + sub * 32;
#pragma unroll
        for (int k = 0; k < 4; ++k) { const v4u vw = *(const v4u*)(vp + 8 * k); const int dv = sub * 32 + 8 * k;
            VT[(dv + 0) * 72 + i] = (bf16)(vw.x & 0xffff); VT[(dv + 1) * 72 + i] = (bf16)(vw.x >> 16); VT[(dv + 2) * 72 + i] = (bf16)(vw.y & 0xffff); VT[(dv + 3) * 72 + i] = (bf16)(vw.y >> 16);
            VT[(dv + 4) * 72 + i] = (bf16)(vw.z & 0xffff); VT[(dv + 5) * 72 + i] = (bf16)(vw.z >> 16); VT[(dv + 6) * 72 + i] = (bf16)(vw.w & 0xffff); VT[(dv + 7) * 72 + i] = (bf16)(vw.w >> 16); }
    }
    __syncthreads();
    const int c = lane & 15, q4 = 4 * (lane >> 4);
#pragma unroll
    for (int t = 0; t < 2; ++t) {
        const int idx = 2 * w + t, mb = idx >> 2, nb = idx & 3;
        const f32x4 z4 = {0.f, 0.f, 0.f, 0.f};
        const f32x4 a = mm16(QdL, 136, mb * 16, KtL, 136, nb * 16, 128, lane, z4);
        const int j = nb * 16 + c;
#pragma unroll
        for (int e = 0; e < 4; ++e) { const int ii = mb * 16 + q4 + e; AttL[ii * 72 + j] = (bf16)f2bf((ii >= j) ? a[e] : 0.f); }
    }
    __syncthreads();
    f32x4 acc[2][4];
    const bf16* gS = (const bf16*)(F.wsb + WS_GL_BS) + (size_t)(unit - 1) * 32768;
#pragma unroll
    for (int t = 0; t < 2; ++t) {
        const int nb = 2 * w + t;
        bf16x8 bfr[4];
#pragma unroll
        for (int ks = 0; ks < 4; ++ks) { if (n >= 1) bfr[ks] = *(const bf16x8*)(gS + (size_t)(nb * 16 + c) * 128 + ks * 32 + 8 * (lane >> 4)); else bfr[ks] = (bf16x8){0, 0, 0, 0, 0, 0, 0, 0}; }
#pragma unroll
        for (int mb = 0; mb < 4; ++mb) {
            f32x4 a = {0.f, 0.f, 0.f, 0.f};
#pragma unroll
            for (int ks = 0; ks < 4; ++ks) a = __builtin_amdgcn_mfma_f32_16x16x32_bf16(*(const LAS bf16x8*)(QdL + (mb * 16 + c) * 136 + ks * 32 + 8 * (lane >> 4)), bfr[ks], a, 0, 0, 0);
            acc[t][mb] = mm16(AttL, 72, mb * 16, VT, 72, nb * 16, 64, lane, a);
        }
    }
    __syncthreads();
#pragma unroll
    for (int t = 0; t < 2; ++t)
#pragma unroll
        for (int mb = 0; mb < 4; ++mb)
#pragma unroll
            for (int e = 0; e < 4; ++e) Of[(mb * 16 + q4 + e) * 260 + (2 * w + t) * 16 + c] = acc[t][mb][e];
    __syncthreads();
    {
        const int i = tid >> 3, sub = tid & 7, c32 = sub * 32; const size_t row = (size_t)row0 + i;
        float x[32]; float ss = 0.f;
#pragma unroll
        for (int e = 0; e < 32; ++e) { x[e] = Of[i * 260 + c32 + e]; ss += x[e] * x[e]; }
        ss += __shfl_xor(ss, 1); ss += __shfl_xor(ss, 2); ss += __shfl_xor(ss, 4);
        const float r = 1.f / sqrtf(ss * (1.f / 256.f) + RMS_EPS);
        const float* gn = F.gla_onorm + l * 256 + c32;
        const bf16* zp = F.P + row * NP + PC_LZ + h * 256 + c32; bf16* yp = F.Y + row * YW + YC_GLA + h * 256 + c32;
#pragma unroll
        for (int k = 0; k < 4; ++k) { const v4u zw = *(const v4u*)(zp + 8 * k);
            const float zg[8] = {bflo(zw.x), bfhi(zw.x), bflo(zw.y), bfhi(zw.y), bflo(zw.z), bfhi(zw.z), bflo(zw.w), bfhi(zw.w)};
            float y[8];
#pragma unroll
            for (int e = 0; e < 8; ++e) y[e] = x[8 * k + e] * r * gn[8 * k + e] * zg[e];
            v4u o; o.x = pk2(y[0], y[1]); o.y = pk2(y[2], y[3]); o.z = pk2(y[4], y[5]); o.w = pk2(y[6], y[7]);
            *(v4u*)(yp + 8 * k) = o; }
    }
    __syncthreads();
}
constexpr int SB_QS = 0, SB_KS = 34816, SB_VT = 52224, SB_FL = 70656;
__device__ __forceinline__ void sb_unit(Frame& F, int unit) {
    const int tid = opq(F.tid), lane = tid & 63, w = __builtin_amdgcn_readfirstlane(tid >> 6);
    const int qt = ((unit >> 8) & 1) ? (unit & 15) : 15 - (unit & 15), bh = unit >> 4, bl = bh >> 2, h = bh & 3;
    LAS bf16* Qs = (LAS bf16*)(F.lds + SB_QS); LAS bf16* Ks = (LAS bf16*)(F.lds + SB_KS); LAS bf16* Vt = (LAS bf16*)(F.lds + SB_VT);
    volatile LAS unsigned* flags = (volatile LAS unsigned*)(F.lds + SB_FL);
    const size_t rowb = (size_t)bl * SEQ;
    const int c = lane & 15, q = lane >> 4, q4 = 4 * q;
#pragma unroll
    for (int k = 0; k < 4; ++k) { const int p = tid + 512 * k; *(LAS v4u*)(Qs + (p >> 4) * 136 + (p & 15) * 8) = *(const v4u*)(F.P + (rowb + qt * 128 + (p >> 4)) * NP + PC_SQ + h * 128 + (p & 15) * 8); }
    f32x4 o[8];
#pragma unroll
    for (int mb = 0; mb < 8; ++mb) o[mb] = (f32x4){0.f, 0.f, 0.f, 0.f};
    float R = 0.f;
    const int t = qt * 128 + 16 * w + c;
    for (int kb = 2 * qt + 1; kb >= 0; --kb) {
        {
            const int key = tid >> 3, sub = tid & 7;
            const bf16* kp = F.P + (rowb + kb * 64 + key) * NP + PC_SK + h * 128 + sub * 16;
            const v4u k0 = *(const v4u*)kp, k1 = *(const v4u*)(kp + 8), v0 = *(const v4u*)(kp + 512), v1 = *(const v4u*)(kp + 520);
            *(LAS v4u*)(Ks + key * 136 + sub * 16) = k0; *(LAS v4u*)(Ks + key * 136 + sub * 16 + 8) = k1;
            const int d0 = sub * 16;
            Vt[(d0 + 0) * 72 + key] = (bf16)(v0.x & 0xffff); Vt[(d0 + 1) * 72 + key] = (bf16)(v0.x >> 16); Vt[(d0 + 2) * 72 + key] = (bf16)(v0.y & 0xffff); Vt[(d0 + 3) * 72 + key] = (bf16)(v0.y >> 16);
            Vt[(d0 + 4) * 72 + key] = (bf16)(v0.z & 0xffff); Vt[(d0 + 5) * 72 + key] = (bf16)(v0.z >> 16); Vt[(d0 + 6) * 72 + key] = (bf16)(v0.w & 0xffff); Vt[(d0 + 7) * 72 + key] = (bf16)(v0.w >> 16);
            Vt[(d0 + 8) * 72 + key] = (bf16)(v1.x & 0xffff); Vt[(d0 + 9) * 72 + key] = (bf16)(v1.x >> 16); Vt[(d0 + 10) * 72 + key] = (bf16)(v1.y & 0xffff); Vt[(d0 + 11) * 72 + key] = (bf16)(v1.y >> 16);
            Vt[(d0 + 12) * 72 + key] = (bf16)(v1.z & 0xffff); Vt[(d0 + 13) * 72 + key] = (bf16)(v1.z >> 16); Vt[(d0 + 14) * 72 + key] = (bf16)(v1.w & 0xffff); Vt[(d0 + 15) * 72 + key] = (bf16)(v1.w >> 16);
        }
        __syncthreads();
        const bool active = (kb * 64 < qt * 128 + 16 * w + 15);
        if (active) {
            float wgt[4][4], l1m[4][4], tot[4], hi[4];
#pragma unroll
            for (int kk = 0; kk < 4; ++kk) {
                const f32x4 z4 = {0.f, 0.f, 0.f, 0.f};
                const f32x4 a = mm16(Ks, 136, kk * 16, Qs, 136, 16 * w, 128, lane, z4);
                float g = 0.f;
#pragma unroll
                for (int e = 0; e < 4; ++e) {
                    const int s = kb * 64 + kk * 16 + q4 + e; const bool valid = s < t;
                    const float z = a[e] * 0.08838834764831845f;
                    const float sp = fmaxf(z, 0.f) + __logf(1.f + __expf(-fabsf(z)));
                    l1m[kk][e] = valid ? -sp : 0.f;
                    wgt[kk][e] = valid ? (z - sp) : -1e30f;
                    g += l1m[kk][e];
                }
                const float b = __shfl_xor(g, 16), pr = g + b, d = __shfl_xor(pr, 32);
                hi[kk] = ((q & 1) == 0 ? b : 0.f) + ((q & 2) == 0 ? d : 0.f);
                tot[kk] = pr + d;
            }
            float after = R;
#pragma unroll
            for (int kk = 3; kk >= 0; --kk) {
                float tail = after + hi[kk];
#pragma unroll
                for (int e = 3; e >= 0; --e) { const float lw = wgt[kk][e] + tail; wgt[kk][e] = __expf(lw); tail += l1m[kk][e]; }
                after += tot[kk];
            }
            R = after;
#pragma unroll
            for (int ks = 0; ks < 2; ++ks) {
                v4u pb; pb.x = pk2(wgt[2 * ks][0], wgt[2 * ks][1]); pb.y = pk2(wgt[2 * ks][2], wgt[2 * ks][3]); pb.z = pk2(wgt[2 * ks + 1][0], wgt[2 * ks + 1][1]); pb.w = pk2(wgt[2 * ks + 1][2], wgt[2 * ks + 1][3]);
                const bf16x8 bfrag = __builtin_bit_cast(bf16x8, pb);
#pragma unroll
                for (int mb = 0; mb < 8; ++mb) {
                    const LAS bf16* vp = Vt + (mb * 16 + c) * 72 + 32 * ks + q4;
                    const v2u lo = *(const LAS v2u*)vp, hi2 = *(const LAS v2u*)(vp + 16);
                    v4u av; av.x = lo.x; av.y = lo.y; av.z = hi2.x; av.w = hi2.y;
                    o[mb] = __builtin_amdgcn_mfma_f32_16x16x32_bf16(__builtin_bit_cast(bf16x8, av), bfrag, o[mb], 0, 0, 0);
                }
            }
        }
        const bool done = __all(R < -104.f || !active) && active;
        if (lane == 0) flags[w] = done ? 1u : 0u;
        __syncthreads();
        unsigned alldone = 1u;
#pragma unroll
        for (int k = 0; k < 8; ++k) alldone &= flags[k];
        if (alldone) break;
    }
    {
        const size_t row = rowb + qt * 128 + 16 * w + c;
#pragma unroll
        for (int mb = 0; mb < 8; ++mb) {
            const int d = mb * 16 + q4;
            const v2u zw = *(const v2u*)(F.P + row * NP + PC_SZ + h * 128 + d);
            v2u ow; ow.x = pk2(o[mb][0] * bflo(zw.x), o[mb][1] * bfhi(zw.x)); ow.y = pk2(o[mb][2] * bflo(zw.y), o[mb][3] * bfhi(zw.y));
            *(v2u*)(F.Y + row * YW + YC_SB + h * 128 + d) = ow;
        }
    }
    __syncthreads();
}
__device__ __forceinline__ void phase_mix_naive(Frame& F, int l) {
    const int bx = blockIdx.x;
    if (bx < 32) gdn_chain(F, bx);
    else if (bx < 64) gla_scan(F, bx - 32, 32);
    else for (int u = bx - 64; u < BG * 4 * 16; u += F.G - 64) sb_unit(F, u);
}
__device__ __forceinline__ void phase_post(Frame& F, int l) {
    const int gw = blockIdx.x * NWAVES + F.wave, NGW = F.G * NWAVES, lane = opq(F.lane);
    for (int m = gw; m < TG; m += NGW) {
#pragma unroll
        for (int ps = 1; ps < 3; ++ps) {
            const int e = (ps == 0) ? lane * 8 : (ps - 1) * 512 + lane * 8;
            bf16* yp = F.Y + (size_t)m * YW + (ps == 0 ? YC_GDN : YC_GLA) + e;
            const bf16* zp = F.P + (size_t)m * NP + (ps == 0 ? PC_DZ : PC_LZ) + e;
            const v4u w = *(const v4u*)yp, zw = *(const v4u*)zp;
            float x[8] = {bflo(w.x), bfhi(w.x), bflo(w.y), bfhi(w.y), bflo(w.z), bfhi(w.z), bflo(w.w), bfhi(w.w)};
            const float zg[8] = {bflo(zw.x), bfhi(zw.x), bflo(zw.y), bfhi(zw.y), bflo(zw.z), bfhi(zw.z), bflo(zw.w), bfhi(zw.w)};
            float ss = 0.f;
#pragma unroll
            for (int i = 0; i < 8; ++i) ss += x[i] * x[i];
            ss += __shfl_xor(ss, 1); ss += __shfl_xor(ss, 2); ss += __shfl_xor(ss, 4); ss += __shfl_xor(ss, 8);
            float r; const float* gn;
            if (ps == 0) { r = 1.f / sqrtf(ss * (1.f / 128.f) + RMS_EPS); gn = F.gdn_onorm + l * 128 + (lane & 15) * 8; }
            else { ss += __shfl_xor(ss, 16); r = 1.f / sqrtf(ss * (1.f / 256.f) + RMS_EPS); gn = F.gla_onorm + l * 256 + (lane & 31) * 8; }
#pragma unroll
            for (int i = 0; i < 8; ++i) x[i] = x[i] * r * gn[i] * zg[i];
            v4u o; o.x = pk2(x[0], x[1]); o.y = pk2(x[2], x[3]); o.z = pk2(x[4], x[5]); o.w = pk2(x[6], x[7]);
            *(v4u*)yp = o;
        }
    }
}

__global__ void __launch_bounds__(NTHREADS, 2) fwd_kernel(Args args) {
    extern __shared__ __attribute__((aligned(16))) unsigned char lds_raw[];
    Frame F;
    F.lds = (LAS unsigned char*)lds_raw;
    volatile LAS unsigned* MISC = (volatile LAS unsigned*)(F.lds + MISC_OFF);
    F.tid = threadIdx.x; F.lane = F.tid & 63; F.wave = __builtin_amdgcn_readfirstlane(F.tid >> 6); F.G = gridDim.x;
    unsigned char* ws = args.ws;
    F.x = args.in[0]; F.c = args.in[1]; F.ada_w = args.in[2]; F.ada_b = args.in[3]; F.norm_g = args.in[4]; F.w_in = args.in[5]; F.sb_qnorm = args.in[6]; F.sb_knorm = args.in[7];
    F.gdn_conv = args.in[8]; F.gdn_a_log = args.in[9]; F.gdn_dt_bias = args.in[10]; F.gdn_onorm = args.in[11]; F.gla_w2 = args.in[12]; F.gla_b = args.in[13]; F.gla_onorm = args.in[14];
    F.merge_b = args.in[15]; F.proj_sb = args.in[16]; F.proj_gdn = args.in[17]; F.proj_gla = args.in[18]; F.w_out = args.in[19];
    F.out = args.out; F.wsb = ws;
    F.MODP = (float*)(ws + WS_MODP); F.MODA = (float*)(ws + WS_MOD); F.MODB = F.MODA + DEPTH * BATCH * D; F.MODG = F.MODB + DEPTH * BATCH * D;
    F.PS = (float*)(ws + WS_PS); F.MGF = (float*)(ws + WS_MGF);
    F.WIN = (bf16*)(ws + WS_WIN); F.WP = (bf16*)(ws + WS_WP); F.WO = (bf16*)(ws + WS_WO); F.H = (bf16*)(ws + WS_H); F.MGB = (bf16*)(ws + WS_MGB);
    F.P = (bf16*)(ws + WS_P); F.Y = (bf16*)(ws + WS_Y); F.GQKV = (bf16*)(ws + WS_H);
    for (int u = F.tid; u < 32; u += NTHREADS) MISC[u] = 0u;
    __syncthreads();
    XcdBarrier bar = xcd_barrier_post((unsigned*)(ws + WS_CTL) + CW_BAR, MISC + 8);
#define GRID_BAR() do { XcdBarrier b2_ = bar; asm volatile("" : "+s"(b2_.x)); xcd_barrier(b2_); } while (0)

    p0_ada(F);
    GRID_BAR();
    p1_mod(F);
    GRID_BAR();
    for (int l = 0; l < DEPTH; ++l) {
        const float* xin = (l == 0) ? F.x : F.out;
        for (int g = 0; g < NGRP; ++g) {
            if (g == 0) wconv_layer(F, l);
            phase_norm(F, xin, l, g);
            GRID_BAR();
#define PH_G1() do { pg8::Gemm gm{F.H, F.WIN, D, D, D}; pg8::StaticOrder S; S.init(TG, NWT, F.G, (int)blockIdx.x); \
                EpiG1 E{F.P, F.PS, F.merge_b + l * 3072}; \
                pg8::gemm_phase<EpiG1, pg8::StaticOrder, true>(F.lds, gm, S, E); GRID_BAR(); } while (0)
            PH_G1();
#ifdef PROBE_G1
            PH_G1();
#endif
            phase_prep(F, l);
#define PH_PRE() do { for (int u = blockIdx.x; u < BG * 4 * 32; u += F.G) gdn_pre_unit(F, l, u); \
                for (int u = blockIdx.x; u < BG * 4 * 32; u += F.G) gla_pre_unit(F, l, u); GRID_BAR(); } while (0)
            PH_PRE();
#ifdef PROBE_PRE
            PH_PRE();
#endif
#ifdef PROBE_GDNPRE
            for (int u = blockIdx.x; u < BG * 4 * 32; u += F.G) gdn_pre_unit(F, l, u); GRID_BAR();
#endif
#ifdef PROBE_GLAPRE
            for (int u = blockIdx.x; u < BG * 4 * 32; u += F.G) gla_pre_unit(F, l, u); GRID_BAR();
#endif
#define PH_MIX() do { const int bx = blockIdx.x; if (bx < 32) gdn_chain(F, bx); else { for (int u = bx - 32; u < BG * 4 * 16; u += F.G - 32) sb_unit(F, u); gla_scan(F, bx - 32, F.G - 32); } GRID_BAR(); } while (0)
#ifdef PROBE_CHAIN
            if (blockIdx.x < 32) gdn_chain(F, blockIdx.x); GRID_BAR();
#endif
#ifdef PROBE_SB
            if (blockIdx.x >= 32) { for (int u = blockIdx.x - 32; u < BG * 4 * 16; u += F.G - 32) sb_unit(F, u); } GRID_BAR();
#endif
            PH_MIX();
#define PH_POST() do { for (int u = blockIdx.x; u < BG * 4 * 32; u += F.G) gdn_post_unit(F, l, u); \
                for (int u = blockIdx.x; u < BG * 4 * 32; u += F.G) gla_post_unit(F, l, u); GRID_BAR(); } while (0)
            PH_POST();
#ifdef PROBE_GDNPOST
            for (int u = blockIdx.x; u < BG * 4 * 32; u += F.G) gdn_post_unit(F, l, u); GRID_BAR();
#endif
#ifdef PROBE_GLAPOST
            for (int u = blockIdx.x; u < BG * 4 * 32; u += F.G) gla_post_unit(F, l, u); GRID_BAR();
#endif
#define PH_G2() do { pg8::StaticOrder S; S.init(TG, D, F.G, (int)blockIdx.x); \
                pg8::Gemm gm{F.Y, F.WP, YW, 2048, 2048}; EpiG2R E{F.P, F.MGB}; \
                pg8::gemm_phase<EpiG2R, pg8::StaticOrder, false>(F.lds, gm, S, E); GRID_BAR(); } while (0)
            PH_G2();
#ifdef PROBE_G2
            PH_G2();
#endif
#ifndef NO_G3
            {   pg8::Gemm gm{F.MGB, F.WO, D, D, D}; pg8::StaticOrder S; S.init(TG, D, F.G, (int)blockIdx.x);
                EpiG3 E{xin, F.out, F.MODG + (size_t)l * BATCH * D, g * TG};
                pg8::gemm_phase<EpiG3, pg8::StaticOrder, false>(F.lds, gm, S, E); }
#endif
            GRID_BAR();
        }
    }
}

extern "C" void kernel_launch(void* const* d_in, const int* in_sizes, int n_in, void* d_out, int out_size, void* d_ws, size_t ws_size, hipStream_t stream) {
    static int grid = 0;
    if (grid == 0) {
        if (n_in != 20 || out_size != T * D || ws_size < WS_END) { fprintf(stderr, "kernel_launch: unexpected shapes / workspace (%d inputs, out %d, ws %zu)\n", n_in, out_size, ws_size); grid = -1; return; }
        int dev = 0, cus = 0, per_cu = 0;
        if (hipGetDevice(&dev) != hipSuccess || hipDeviceGetAttribute(&cus, hipDeviceAttributeMultiprocessorCount, dev) != hipSuccess) { grid = -1; return; }
        if (hipFuncSetAttribute((const void*)fwd_kernel, hipFuncAttributeMaxDynamicSharedMemorySize, LDS_BYTES) != hipSuccess) { grid = -1; return; }
        if (hipOccupancyMaxActiveBlocksPerMultiprocessor(&per_cu, (const void*)fwd_kernel, NTHREADS, LDS_BYTES) != hipSuccess || per_cu < 1) fprintf(stderr, "kernel_launch: occupancy query reports %d\n", per_cu);
        (void)hipGetLastError();
        grid = cus;
    }
    if (grid < 0) return;
    if (hipMemsetAsync((char*)d_ws + WS_CTL, 0, CTL_ZERO_BYTES, stream) != hipSuccess) return;
    Args a{};
    for (int i = 0; i < 20; ++i) a.in[i] = (const float*)d_in[i];
    a.out = (float*)d_out; a.ws = (unsigned char*)d_ws; a.ph_lo = 0; a.ph_hi = 0;
    hipLaunchKernelGGL(fwd_kernel, dim3(grid), dim3(NTHREADS), LDS_BYTES, stream, a);
}
```

```cpp
#include <hip/hip_runtime.h>
#include <cstdio>
#include <cstdint>

#define GAS __attribute__((address_space(1)))
#define LAS __attribute__((address_space(3)))

#define XB_TMO      128
#define XB_XCNT(j)  (256  + 64 * (j))
#define XB_XSUB(j)  (1280 + 64 * (j))
#define XB_XGEN(j)  (2304 + 64 * (j))
#define XB_TOP      3328
#define XB_TOPGEN   3392
#define XCD_BAR_WORDS 3456
#define XB_SPIN_CAP (1u << 24)

__device__ __forceinline__ unsigned xb_ld(unsigned* p)              { return __hip_atomic_load(p, __ATOMIC_RELAXED, __HIP_MEMORY_SCOPE_AGENT); }
__device__ __forceinline__ unsigned xb_add(unsigned* p, unsigned v) { return __hip_atomic_fetch_add(p, v, __ATOMIC_RELAXED, __HIP_MEMORY_SCOPE_AGENT); }
__device__ __forceinline__ unsigned xb_xcc_id() { return (unsigned)__builtin_amdgcn_s_getreg((3 << 11) | 20) & 0xFu; }
#define XB_SPIN(cond, bar) do { unsigned _sp = 0; while (cond) { __builtin_amdgcn_s_sleep(1); \
    if ((++_sp & 255u) == 0u) { if (xb_ld(&(bar)[XB_TMO])) break; if (_sp > XB_SPIN_CAP) { atomicAdd(&(bar)[XB_TMO], 1u); break; } } } } while (0)

struct XcdBarrier { unsigned* bar; unsigned x; volatile LAS unsigned* st; };

__device__ __forceinline__ XcdBarrier xcd_barrier_post(unsigned* bar, volatile LAS unsigned* st) {
    XcdBarrier b; b.bar = bar; b.x = xb_xcc_id(); b.st = st;
    if (threadIdx.x == 0) (void)xb_add(&bar[XB_XCNT(b.x)], 1u);
    return b;
}
__device__ __forceinline__ void xcd_barrier_complete(unsigned* bar, unsigned x, unsigned& nloc, unsigned& nx) {
    const unsigned G = gridDim.x * gridDim.y * gridDim.z;
    unsigned sum, cnt, mine, sp = 0u;
    for (;;) {
        sum = 0u; cnt = 0u; mine = 0u;
#pragma unroll
        for (unsigned j = 0; j < 16; ++j) { const unsigned c = xb_ld(&bar[XB_XCNT(j)]); sum += c; cnt += (c > 0u) ? 1u : 0u; mine = (j == x) ? c : mine; }
        if (sum == G) break;
        __builtin_amdgcn_s_sleep(1);
        if ((++sp & 255u) == 0u) { if (xb_ld(&bar[XB_TMO])) break; if (sp > XB_SPIN_CAP) { atomicAdd(&bar[XB_TMO], 1u); break; } }
    }
    nloc = mine > 0u ? mine : 1u; nx = cnt > 0u ? cnt : 1u;
}
__device__ __forceinline__ void xcd_barrier(const XcdBarrier& b) {
    asm volatile("s_waitcnt vmcnt(0)" ::: "memory");
    __syncthreads();
    if (threadIdx.x == 0) {
        unsigned* bar = b.bar;
        __builtin_amdgcn_s_waitcnt(0);
        unsigned nloc = b.st[0], nx = b.st[1];
        if (nloc == 0u) { xcd_barrier_complete(bar, b.x, nloc, nx); b.st[0] = nloc; b.st[1] = nx; }
        const unsigned old = xb_add(&bar[XB_XSUB(b.x)], 1u);
        const unsigned gen = old / nloc;
        if (old + 1u == (gen + 1u) * nloc) {
            __builtin_amdgcn_fence(__ATOMIC_RELEASE, "agent");
            asm volatile("s_waitcnt vmcnt(0)" ::: "memory");
            const unsigned og = xb_add(&bar[XB_TOP], 1u);
            const unsigned tg = og / nx;
            if (og + 1u == (tg + 1u) * nx) xb_add(&bar[XB_TOPGEN], 1u);
            else XB_SPIN(xb_ld(&bar[XB_TOPGEN]) == tg, bar);
            __builtin_amdgcn_fence(__ATOMIC_ACQUIRE, "agent");
            xb_add(&bar[XB_XGEN(b.x)], 1u);
            asm volatile("s_waitcnt vmcnt(0)" ::: "memory");
        } else {
            XB_SPIN(xb_ld(&bar[XB_XGEN(b.x)]) == gen, bar);
            __builtin_amdgcn_fence(__ATOMIC_ACQUIRE, "agent");
            asm volatile("s_waitcnt vmcnt(0)" ::: "memory");
        }
    }
    __syncthreads();
}
namespace pg8 {
#define PG8_LAS __attribute__((address_space(3)))
typedef unsigned short bf16_t;
typedef short bf16x8 __attribute__((ext_vector_type(8)));
typedef float f32x4 __attribute__((ext_vector_type(4)));
typedef unsigned u32x4 __attribute__((ext_vector_type(4)));
typedef unsigned u32x2 __attribute__((ext_vector_type(2)));
constexpr int BM = 256, BK = 64, HALF = 128, HTB = HALF * BK * 2, STAGE_BYTES = 8 * HTB, NXCD = 8, WGM = 8;

__host__ __device__ __forceinline__ int lds_byte(int r, int c) { const int st = (r >> 4) * 2 + (c >> 5), rr = r & 15, cc = c & 31, ob = rr * 64 + cc * 2; return st * 1024 + (ob ^ (((ob >> 9) & 1) << 5)); }
__host__ __device__ __forceinline__ void stage_rc(int b, int& R, int& C) { const int st = b / 1024, sb = b % 1024, swz = sb ^ (((sb >> 9) & 1) << 5); R = (st >> 1) * 16 + swz / 64; C = (st & 1) * 32 + (swz % 64) / 2; }
__host__ __device__ __forceinline__ int perm32(int rho) { const int n = rho >> 4, i = rho & 15; return 8 * (i >> 2) + 4 * n + (i & 3); }

struct Unit { int pm, pn, seg; };
struct Gemm { const bf16_t* A; const bf16_t* Bt; int lda, ldb, K; };

struct StaticOrder {
    int nM, nN, nwg, G, c;
    __host__ __device__ void init(int M, int N, int G_, int c_) { nM = M / BM; nN = N / BM; nwg = nM * nN; G = G_; c = c_; }
    __host__ __device__ bool next(int i, Unit& u) const {
        const long L = (long)i * G + c; if (L >= nwg) return false;
        int wgid = (int)L; { const int q = nwg / NXCD, r = nwg % NXCD, xcd = wgid % NXCD, off = wgid / NXCD; wgid = (xcd < r ? xcd * (q + 1) : r * (q + 1) + (xcd - r) * q) + off; }
        const int nig = WGM * nN, gid = wgid / nig, fm = gid * WGM, gsz = (nM - fm) < WGM ? (nM - fm) : WGM;
        u.pm = fm + ((wgid % nig) % gsz); u.pn = (wgid % nig) / gsz; u.seg = 0; return true;
    }
    __device__ __forceinline__ size_t k_off(const Unit&) const { return 0; }
    __device__ __forceinline__ void a_ready(const Unit&) const {}
    __device__ __forceinline__ void done(const Unit&) const {}
};

template <int NSEG> struct SegOrder : StaticOrder {
    int segk;
    __host__ __device__ bool next(int i, Unit& u) const { if (!StaticOrder::next(i / NSEG, u)) return false; u.seg = i % NSEG; return true; }
    __device__ __forceinline__ size_t k_off(const Unit& u) const { return (size_t)u.seg * segk * 2; }
};
__device__ __forceinline__ unsigned cvt_pk_bf16(float lo, float hi) { unsigned r; asm volatile("v_cvt_pk_bf16_f32 %0, %1, %2" : "=v"(r) : "v"(lo), "v"(hi)); return r; }

template <class Epi, class Sched, bool ALIGN_EPI>
__device__ __forceinline__ void gemm_phase(PG8_LAS unsigned char* lds, const Gemm g, const Sched& S, const Epi& E) {
    int tid = threadIdx.x; asm volatile("" : "+v"(tid));
    const int wid = __builtin_amdgcn_readfirstlane(tid >> 6), lane = tid & 63, wr = wid >> 2, wc = wid & 3, fr = lane & 15, fq = lane >> 4;
    const int K = g.K, nt = K / BK;
    unsigned voffA[2], voffB[2];
#pragma unroll
    for (int i = 0; i < 2; ++i) { int R, C; stage_rc(tid * 16 + i * 8192, R, C); const int Rb = Epi::PERM ? ((R & ~31) + perm32(R & 31)) : R;
        voffA[i] = (unsigned)(R * g.lda + C) * 2u; voffB[i] = (unsigned)(Rb * g.ldb + C) * 2u; }
    const size_t kstep = (size_t)(BK * 2);
    const size_t hstepA = (size_t)HALF * g.lda * 2, hstepB = (size_t)HALF * g.ldb * 2;
    const size_t tstepA = 2 * hstepA, tstepB = 2 * hstepB;
    const unsigned ldsw = (unsigned)wid * 1024u;
    const int aoff = lds_byte(wr * 64 + fr, fq * 8), boff = lds_byte(wc * 32 + fr, fq * 8);
#define PG8_SA(b, h) (((b) * 2 + (h)) * HTB)
#define PG8_SB(b, h) ((4 + (b) * 2 + (h)) * HTB)
#define PG8_STAGE(bufoff, gbase, voff) do { _Pragma("unroll") for (int _i = 0; _i < 2; ++_i) \
        __builtin_amdgcn_global_load_lds((const unsigned*)((const char*)(gbase) + (voff)[_i]), (PG8_LAS unsigned*)(lds + (bufoff) + ldsw + _i * 8192), 16, 0, 0); } while (0)
#define PG8_LDA(dst, b, h) do { _Pragma("unroll") for (int m = 0; m < 4; ++m) _Pragma("unroll") for (int k = 0; k < 2; ++k) dst[m][k] = *(const PG8_LAS bf16x8*)(lds + PG8_SA(b, h) + aoff + m * 2048 + k * 1024); } while (0)
#define PG8_LDB(dst, b, h) do { _Pragma("unroll") for (int n = 0; n < 2; ++n) _Pragma("unroll") for (int k = 0; k < 2; ++k) dst[n][k] = *(const PG8_LAS bf16x8*)(lds + PG8_SB(b, h) + boff + n * 2048 + k * 1024); } while (0)
#define PG8_MMA(ai, bj, At, Bt) do { __builtin_amdgcn_s_setprio(1); _Pragma("unroll") for (int m = 0; m < 4; ++m) _Pragma("unroll") for (int n = 0; n < 2; ++n) _Pragma("unroll") for (int k = 0; k < 2; ++k) \
        acc[ai][bj][m][n] = __builtin_amdgcn_mfma_f32_16x16x32_bf16(Bt[n][k], At[m][k], acc[ai][bj][m][n], 0, 0, 0); __builtin_amdgcn_s_setprio(0); } while (0)
#define PG8_WAIT_V(n) asm volatile("s_waitcnt vmcnt(" #n ")" ::: "memory")
#define PG8_WAIT_L(n) asm volatile("s_waitcnt lgkmcnt(" #n ")" ::: "memory")
#define PG8_BAR __builtin_amdgcn_s_barrier()
#define PG8_SCHED __builtin_amdgcn_sched_barrier(0)
    Unit cur, nxt; int ui = 0;
    if (!S.next(0, cur)) return;
    f32x4 acc[2][2][4][2];
#pragma unroll
    for (int a = 0; a < 2; ++a)
#pragma unroll
        for (int b = 0; b < 2; ++b)
#pragma unroll
            for (int m = 0; m < 4; ++m)
#pragma unroll
                for (int n = 0; n < 2; ++n) acc[a][b][m][n] = (f32x4){0.f, 0.f, 0.f, 0.f};
    bf16x8 At[4][2], B0[2][2], B1[2][2];
    const char* cA = (const char*)g.A + (size_t)cur.pm * tstepA + S.k_off(cur); const char* cB = (const char*)g.Bt + (size_t)cur.pn * tstepB + S.k_off(cur);
    S.a_ready(cur);
    PG8_STAGE(PG8_SB(0, 0), cB, voffB); PG8_STAGE(PG8_SB(0, 1), cB + hstepB, voffB); PG8_STAGE(PG8_SA(0, 0), cA, voffA); PG8_STAGE(PG8_SA(0, 1), cA + hstepA, voffA);
    if (wr == 1) PG8_BAR;
    PG8_WAIT_V(2); PG8_BAR;
    PG8_STAGE(PG8_SB(1, 0), cB + kstep, voffB); PG8_STAGE(PG8_SA(1, 0), cA + kstep, voffA); PG8_STAGE(PG8_SB(1, 1), cB + hstepB + kstep, voffB);
    PG8_WAIT_V(6); PG8_BAR;
    for (;;) {
        const bool has_next = S.next(ui + 1, nxt);
        const char* nA = has_next ? (const char*)g.A + (size_t)nxt.pm * tstepA + S.k_off(nxt) : cA; const char* nB = has_next ? (const char*)g.Bt + (size_t)nxt.pn * tstepB + S.k_off(nxt) : cB;
        for (int t = 0; t < nt; t += 2) {
            const bool last = (t == nt - 2);
            const char* a1 = cA + (size_t)(t + 1) * kstep;
            const char* a2 = last ? nA : cA + (size_t)(t + 2) * kstep; const char* b2 = last ? nB : cB + (size_t)(t + 2) * kstep;
            const char* a3 = a2 + kstep; const char* b3 = b2 + kstep;
            if (last && has_next) S.a_ready(nxt);
            if constexpr (Epi::MID) { if (t == Epi::MID_T0 || t == Epi::MID_T1) E.mid(acc, cur, t, wr, wc, fr, fq); }
            PG8_LDB(B0, 0, 0); PG8_LDB(B1, 0, 1); PG8_SCHED; PG8_LDA(At, 0, 0); PG8_STAGE(PG8_SA(1, 1), a1 + hstepA, voffA);
            PG8_WAIT_V(8); PG8_WAIT_L(0); PG8_BAR; PG8_MMA(0, 0, At, B0); PG8_MMA(0, 1, At, B1); PG8_BAR; PG8_SCHED;
            PG8_LDA(At, 0, 1); PG8_STAGE(PG8_SB(0, 0), b2, voffB); PG8_STAGE(PG8_SB(0, 1), b2 + hstepB, voffB); PG8_STAGE(PG8_SA(0, 0), a2, voffA);
            PG8_WAIT_V(8); PG8_WAIT_L(0); PG8_BAR; PG8_MMA(1, 0, At, B0); PG8_MMA(1, 1, At, B1); PG8_BAR; PG8_SCHED;
            PG8_LDB(B0, 1, 0); PG8_LDB(B1, 1, 1); PG8_SCHED; PG8_LDA(At, 1, 0); PG8_STAGE(PG8_SA(0, 1), a2 + hstepA, voffA);
            PG8_WAIT_V(8); PG8_WAIT_L(0); PG8_BAR; PG8_MMA(0, 0, At, B0); PG8_MMA(0, 1, At, B1); PG8_BAR; PG8_SCHED;
            PG8_LDA(At, 1, 1); PG8_STAGE(PG8_SB(1, 0), b3, voffB); PG8_STAGE(PG8_SB(1, 1), b3 + hstepB, voffB); PG8_STAGE(PG8_SA(1, 0), a3, voffA);
            PG8_WAIT_V(8); PG8_WAIT_L(0); PG8_BAR; PG8_MMA(1, 0, At, B0); PG8_MMA(1, 1, At, B1); PG8_BAR; PG8_SCHED;
        }
        if constexpr (ALIGN_EPI) { if (wr == 0) PG8_BAR; }
        E(acc, cur, wr, wc, fr, fq);
        if (!has_next) break;
        {
#pragma unroll
        for (int a = 0; a < 2; ++a)
#pragma unroll
            for (int b = 0; b < 2; ++b)
#pragma unroll
                for (int m = 0; m < 4; ++m)
#pragma unroll
                    for (int n = 0; n < 2; ++n) acc[a][b][m][n] = (f32x4){0.f, 0.f, 0.f, 0.f};
        }
        cur = nxt; cA = nA; cB = nB; ++ui;
        if constexpr (ALIGN_EPI) { if (wr == 1) PG8_BAR; }
    }
    PG8_WAIT_V(0);
    if constexpr (!ALIGN_EPI) { if (wr == 0) PG8_BAR; }
    PG8_BAR;
#undef PG8_SA
#undef PG8_SB
#undef PG8_STAGE
#undef PG8_LDA
#undef PG8_LDB
#undef PG8_MMA
#undef PG8_WAIT_V
#undef PG8_WAIT_L
#undef PG8_BAR
#undef PG8_SCHED
}
}
constexpr int D = 1024, BATCH = 16, SEQ = 2048, DEPTH = 4, T = BATCH * SEQ;
constexpr int NGRP = 2, TG = T / NGRP, BG = BATCH / NGRP;
constexpr int N_IN = 10264, NP = 10240, NWT = 10496;
constexpr int PC_SQ = 0, PC_SK = 512, PC_SV = 1024, PC_SZ = 1536, PC_DQ = 2048, PC_DZ = 3584, PC_LQ = 4096, PC_LK = 4608, PC_LV = 5120, PC_LZ = 6144, PC_MG = 7168;
constexpr int YC_SB = 0, YC_GDN = 512, YC_GLA = 1024, YW = 2048;
constexpr int NTHREADS = 512, NWAVES = 8;
constexpr float RMS_EPS = 1e-6f, L2_EPS = 1e-6f;

constexpr size_t MiB = 1u << 20;
constexpr size_t WS_CTL = 0, CTL_ZERO_BYTES = 1 * MiB;
constexpr size_t WS_MODP = 2 * MiB;
constexpr size_t WS_MOD = 8 * MiB;
constexpr size_t WS_WIN = 10 * MiB;
constexpr size_t WS_WP = 31 * MiB;
constexpr size_t WS_WO = 35 * MiB;
constexpr size_t WS_H = 40 * MiB;
constexpr size_t WS_MGB = 72 * MiB;
constexpr size_t WS_P = 104 * MiB;
constexpr size_t WS_PS = 424 * MiB;
constexpr size_t WS_Y = 426 * MiB;
constexpr size_t WS_MGF = 490 * MiB;
constexpr size_t WS_END = 640 * MiB;
constexpr size_t WS_GD_WN = 490 * MiB;
constexpr size_t WS_GD_BT = 522 * MiB;
constexpr size_t WS_GD_ST = 554 * MiB;
constexpr size_t WS_GD_QE = 586 * MiB;
constexpr size_t WS_GD_OL = 602 * MiB;
constexpr size_t WS_GD_CD = 618 * MiB;
constexpr int CW_BAR = 4096;

constexpr int RING_BYTES = 131072;
constexpr int MISC_OFF = RING_BYTES + 320;
constexpr int LDS_BYTES = 147456;

typedef unsigned short bf16;
typedef unsigned v4u __attribute__((ext_vector_type(4)));
typedef unsigned v2u __attribute__((ext_vector_type(2)));
typedef float f32x4 __attribute__((ext_vector_type(4)));
#define LDS_WAIT() asm volatile("s_waitcnt lgkmcnt(0)" ::: "memory")

__device__ __forceinline__ float bf2f(unsigned v) { return __uint_as_float(v << 16); }
__device__ __forceinline__ float bflo(unsigned w) { return __uint_as_float(w << 16); }
__device__ __forceinline__ float bfhi(unsigned w) { return __uint_as_float(w & 0xffff0000u); }
__device__ __forceinline__ unsigned f2bf(float f) { unsigned u = __float_as_uint(f); return (u + 0x7fffu + ((u >> 16) & 1u)) >> 16; }
__device__ __forceinline__ unsigned pk2(float lo, float hi) { return f2bf(lo) | (f2bf(hi) << 16); }
__device__ __forceinline__ float sigmoidf_(float x) { return 1.f / (1.f + __expf(-x)); }
__device__ __forceinline__ float siluf_(float x) { return x / (1.f + __expf(-x)); }
__device__ __forceinline__ float softplusf_(float x) { return fmaxf(x, 0.f) + log1pf(expf(-fabsf(x))); }
__device__ __forceinline__ float logsigf_(float x) { return fminf(x, 0.f) - log1pf(expf(-fabsf(x))); }

__device__ __forceinline__ int opq(int v) { asm volatile("" : "+v"(v)); return v; }
struct Args {
    const float* in[20];
    float* out; unsigned char* ws;
    int ph_lo, ph_hi;
};
struct Frame {
    LAS unsigned char* lds;
    int tid, lane, wave, G;
    const float *x, *c, *ada_w, *ada_b, *norm_g, *w_in, *sb_qnorm, *sb_knorm, *gdn_conv, *gdn_a_log, *gdn_dt_bias, *gdn_onorm, *gla_w2, *gla_b, *gla_onorm, *merge_b, *proj_sb, *proj_gdn, *proj_gla, *w_out;
    float* out; unsigned char* wsb;
    float *MODP, *MODA, *MODB, *MODG, *PS, *MGF;
    bf16 *WIN, *WP, *WO, *H, *MGB, *P, *Y, *GQKV;
};

struct EpiG1 {
    static constexpr bool PERM = true, MID = false;
    bf16* P; float* PS; const float* mb;
    __device__ __forceinline__ bool operator()(pg8::f32x4 (&acc)[2][2][4][2], const pg8::Unit& u, int wr, int wc, int fr, int fq) const {
        const int row0 = u.pm * 256 + wr * 64 + fr, pn = u.pn;
        if (pn < 40) {
            const int mode = (pn == 6 || pn == 7 || pn == 14 || pn == 15 || (pn >= 24 && pn < 28)) ? 1 : (pn >= 28 ? 2 : 0);
            const int col0 = pn * 256 + wc * 32 + 8 * fq;
            pg8::f32x4 bv[2][2];
#pragma unroll
            for (int bj = 0; bj < 2; ++bj)
#pragma unroll
                for (int n = 0; n < 2; ++n) bv[bj][n] = (mode == 2) ? *(const pg8::f32x4*)(mb + (col0 - PC_MG) + bj * 128 + 4 * n) : (pg8::f32x4){0.f, 0.f, 0.f, 0.f};
#pragma unroll
            for (int ai = 0; ai < 2; ++ai)
#pragma unroll
                for (int m = 0; m < 4; ++m) { bf16* rowp = P + (size_t)(row0 + ai * 128 + m * 16) * NP + col0;
#pragma unroll
                    for (int bj = 0; bj < 2; ++bj) { pg8::f32x4 v0 = acc[ai][bj][m][0], v1 = acc[ai][bj][m][1];
                        if (mode == 1) {
#pragma unroll
                            for (int j = 0; j < 4; ++j) { v0[j] = siluf_(v0[j]); v1[j] = siluf_(v1[j]); } }
                        else if (mode == 2) { v0 = v0 + bv[bj][0]; v1 = v1 + bv[bj][1];
#pragma unroll
                            for (int j = 0; j < 4; ++j) { v0[j] = sigmoidf_(v0[j]); v1[j] = sigmoidf_(v1[j]); } }
                        pg8::u32x4 w; w.x = pg8::cvt_pk_bf16(v0[0], v0[1]); w.y = pg8::cvt_pk_bf16(v0[2], v0[3]); w.z = pg8::cvt_pk_bf16(v1[0], v1[1]); w.w = pg8::cvt_pk_bf16(v1[2], v1[3]);
                        *(pg8::u32x4*)(rowp + bj * 128) = w; } }
        } else if (wc == 0 && fq < 3) {
#pragma unroll
            for (int ai = 0; ai < 2; ++ai)
#pragma unroll
                for (int m = 0; m < 4; ++m) { float* rowp = PS + (size_t)(row0 + ai * 128 + m * 16) * 32 + 8 * fq;
                    *(pg8::f32x4*)(rowp) = acc[ai][0][m][0]; *(pg8::f32x4*)(rowp + 4) = acc[ai][0][m][1]; }
        }
        return false;
    }
};
struct EpiG2R {
    static constexpr bool PERM = false, MID = true;
    static constexpr int MID_T0 = 8, MID_T1 = 16;
    const bf16* P; bf16* MGB;
    __device__ __forceinline__ void apply(pg8::f32x4 (&acc)[2][2][4][2], const pg8::Unit& u, int which, int wr, int wc, int fr, int fq) const {
        const unsigned row0 = u.pm * 256 + wr * 64 + fr, col0 = u.pn * 256 + wc * 32 + 4 * fq;
        const unsigned gn = (PC_MG + which * D) * 2, gd = (PC_MG + (which + 1) * D) * 2;
        const char* Pb = (const char*)P; char* Mb = (char*)MGB;
#pragma unroll
        for (int ai = 0; ai < 2; ++ai)
#pragma unroll
            for (int m = 0; m < 4; ++m) { const unsigned r = row0 + ai * 128 + m * 16; const unsigned po = (r * NP + col0) * 2u, mo = (r * D + col0) * 2u;
#pragma unroll
                for (int bj = 0; bj < 2; ++bj)
#pragma unroll
                    for (int n = 0; n < 2; ++n) { const unsigned co = (bj * 128 + n * 16) * 2;
                        const pg8::u32x2 gw = *(const pg8::u32x2*)(Pb + (po + gn + co));
                        pg8::f32x4 f; f[0] = bflo(gw.x); f[1] = bfhi(gw.x); f[2] = bflo(gw.y); f[3] = bfhi(gw.y);
                        if (which < 2) { const pg8::u32x2 dw = *(const pg8::u32x2*)(Pb + (po + gd + co));
                            f[0] *= __builtin_amdgcn_rcpf(fmaxf(bflo(dw.x), 1e-30f)); f[1] *= __builtin_amdgcn_rcpf(fmaxf(bfhi(dw.x), 1e-30f));
                            f[2] *= __builtin_amdgcn_rcpf(fmaxf(bflo(dw.y), 1e-30f)); f[3] *= __builtin_amdgcn_rcpf(fmaxf(bfhi(dw.y), 1e-30f)); }
                        const pg8::f32x4 v = acc[ai][bj][m][n] * f;
                        if (which < 2) acc[ai][bj][m][n] = v;
                        else { pg8::u32x2 w; w.x = pg8::cvt_pk_bf16(v[0], v[1]); w.y = pg8::cvt_pk_bf16(v[2], v[3]); *(pg8::u32x2*)(Mb + (mo + co)) = w; }
                        if (n == 1) asm volatile("" ::: "memory"); } }
    }
    __device__ __forceinline__ void mid(pg8::f32x4 (&acc)[2][2][4][2], const pg8::Unit& u, int t, int wr, int wc, int fr, int fq) const { apply(acc, u, t == MID_T0 ? 0 : 1, wr, wc, fr, fq); }
    __device__ __forceinline__ bool operator()(pg8::f32x4 (&acc)[2][2][4][2], const pg8::Unit& u, int wr, int wc, int fr, int fq) const { apply(acc, u, 2, wr, wc, fr, fq); return false; }
};
struct EpiG3 {
    static constexpr bool PERM = false, MID = false;
    const float* xin; float* out; const float* gate; int grow0;
    __device__ __forceinline__ bool operator()(pg8::f32x4 (&acc)[2][2][4][2], const pg8::Unit& u, int wr, int wc, int fr, int fq) const {
        const int row0 = grow0 + u.pm * 256 + wr * 64 + fr, col0 = u.pn * 256 + wc * 32 + 4 * fq;
        const float* gp = gate + (size_t)((grow0 + u.pm * 256) / SEQ) * D;
        pg8::f32x4 gv[2][2];
#pragma unroll
        for (int bj = 0; bj < 2; ++bj)
#pragma unroll
            for (int n = 0; n < 2; ++n) gv[bj][n] = *(const pg8::f32x4*)(gp + col0 + bj * 128 + n * 16);
#pragma unroll
        for (int ai = 0; ai < 2; ++ai)
#pragma unroll
            for (int m = 0; m < 4; ++m) { const size_t off = (size_t)(row0 + ai * 128 + m * 16) * D + col0;
#pragma unroll
                for (int bj = 0; bj < 2; ++bj)
#pragma unroll
                    for (int n = 0; n < 2; ++n) { const pg8::f32x4 xv = *(const pg8::f32x4*)(xin + off + bj * 128 + n * 16);
                        *(pg8::f32x4*)(out + off + bj * 128 + n * 16) = xv + gv[bj][n] * acc[ai][bj][m][n]; } }
        return false;
    }
};

__device__ __forceinline__ void transpose_item(const float* W, int ldw, int col0, bf16* WT, int ldd, int drow0, int dk0, int nblk, LAS float* scr, int item, int lane) {
    const int kb = item / nblk, nb = item % nblk, k0 = 64 * kb, n0 = 32 * nb;
#pragma unroll 8
    for (int i = 0; i < 32; ++i) { const int kk = 2 * i + (lane >> 5); scr[kk * 33 + (lane & 31)] = W[(size_t)(k0 + kk) * ldw + col0 + n0 + (lane & 31)]; }
    LDS_WAIT(); asm volatile("" ::: "memory");
    const int c = lane & 7;
#pragma unroll
    for (int j = 0; j < 4; ++j) { const int n = (lane >> 3) + 8 * j; const LAS float* s = scr + (8 * c) * 33 + n;
        v4u o; o.x = pk2(s[0 * 33], s[1 * 33]); o.y = pk2(s[2 * 33], s[3 * 33]); o.z = pk2(s[4 * 33], s[5 * 33]); o.w = pk2(s[6 * 33], s[7 * 33]);
        *(v4u*)(WT + (size_t)(drow0 + n0 + n) * ldd + dk0 + k0 + 8 * c) = o; }
    LDS_WAIT(); asm volatile("" ::: "memory");
}
__device__ __forceinline__ void p0_ada(Frame& F) {
    LAS float* cact = (LAS float*)F.lds;
    for (int i = F.tid; i < BATCH * D; i += NTHREADS) cact[i] = siluf_(F.c[i]);
    __syncthreads();
    for (int it = blockIdx.x; it < 4 * 8 * 6; it += F.G) {
        const int l = it / 48, ks = (it % 48) / 6, jc = it % 6, j = jc * 512 + F.tid;
        float a[16];
#pragma unroll
        for (int b = 0; b < 16; ++b) a[b] = 0.f;
        const float* wp = F.ada_w + ((size_t)l * D + ks * 128) * 3072 + j;
#pragma unroll 4
        for (int k = 0; k < 128; ++k) { const float w = wp[(size_t)k * 3072];
#pragma unroll
            for (int b = 0; b < 16; ++b) a[b] += cact[b * D + ks * 128 + k] * w; }
#pragma unroll
        for (int b = 0; b < 16; ++b) F.MODP[((size_t)(ks * 4 + l) * 16 + b) * 3072 + j] = a[b];
    }
}
__device__ __forceinline__ void wconv_layer(Frame& F, int l) {
    const int lane = opq(F.lane);
    LAS float* scr = (LAS float*)(F.lds + F.wave * 16384);
    const int gw = blockIdx.x * NWAVES + F.wave, NGW = F.G * NWAVES;
    constexpr int I_A = 16 * 128, I_B = 16 * 96, I_C = 16 * 96, I_SB = 8 * 32, I_GDN = 8 * 32, I_GLA = 16 * 32, I_WO = 16 * 32;
    constexpr int I_L = I_A + I_B + I_C + I_SB + I_GDN + I_GLA + I_WO;
    const float* win = F.w_in + (size_t)l * D * N_IN;
    for (int it = gw; it < I_L; it += NGW) {
        int r = it;
        if (r < I_A) { transpose_item(win, N_IN, 0, F.WIN, D, 0, 0, 128, scr, r, lane); continue; } r -= I_A;
        if (r < I_B) { transpose_item(win, N_IN, 4104, F.WIN, D, 4096, 0, 96, scr, r, lane); continue; } r -= I_B;
        if (r < I_C) { transpose_item(win, N_IN, 7192, F.WIN, D, 7168, 0, 96, scr, r, lane); continue; } r -= I_C;
        if (r < I_SB) { transpose_item(F.proj_sb + (size_t)l * 512 * D, D, 0, F.WP, 2048, 0, 0, 32, scr, r, lane); continue; } r -= I_SB;
        if (r < I_GDN) { transpose_item(F.proj_gdn + (size_t)l * 512 * D, D, 0, F.WP, 2048, 0, 512, 32, scr, r, lane); continue; } r -= I_GDN;
        if (r < I_GLA) { transpose_item(F.proj_gla + (size_t)l * D * D, D, 0, F.WP, 2048, 0, 1024, 32, scr, r, lane); continue; } r -= I_GLA;
        transpose_item(F.w_out + (size_t)l * D * D, D, 0, F.WO, D, 0, 0, 32, scr, r, lane);
    }
    for (int i = blockIdx.x * NTHREADS + opq(F.tid); i < 256 * D; i += F.G * NTHREADS) {
        const int r = i / D, k = i % D;
        float v = 0.f;
        if (r < 8) v = win[(size_t)k * N_IN + 4096 + r];
        else if (r < 24) v = win[(size_t)k * N_IN + 7176 + (r - 8)];
        F.WIN[(size_t)(10240 + r) * D + k] = (bf16)f2bf(v);
    }
    __syncthreads();
}
__device__ __forceinline__ void p1_mod(Frame& F) {
    for (int i = blockIdx.x * NTHREADS + F.tid; i < DEPTH * BATCH * D; i += F.G * NTHREADS) {
        const int l = i / (BATCH * D), b = (i / D) % BATCH, c = i % D;
        float sh = F.ada_b[l * 3072 + c], sc = F.ada_b[l * 3072 + D + c], gt = F.ada_b[l * 3072 + 2 * D + c];
#pragma unroll
        for (int ks = 0; ks < 8; ++ks) { const float* p = F.MODP + ((size_t)(ks * 4 + l) * 16 + b) * 3072; sh += p[c]; sc += p[D + c]; gt += p[2 * D + c]; }
        F.MODA[i] = F.norm_g[l * D + c] * (1.f + sc); F.MODB[i] = sh; F.MODG[i] = gt;
    }
}
__device__ __forceinline__ float wave_sum(float v) {
#pragma unroll
    for (int o = 1; o < 64; o <<= 1) v += __shfl_xor(v, o);
    return v;
}
__device__ __forceinline__ void phase_norm(Frame& F, const float* xin, int l, int g) {
    const int gw = blockIdx.x * NWAVES + F.wave, NGW = F.G * NWAVES, lane = opq(F.lane);
    for (int m = gw; m < TG; m += NGW) {
        const int grow = g * TG + m, b = grow / SEQ;
        const f32x4* xr = (const f32x4*)(xin + (size_t)grow * D) + lane;
        const f32x4* ma = (const f32x4*)(F.MODA + (size_t)(l * BATCH + b) * D) + lane;
        const f32x4* mb = (const f32x4*)(F.MODB + (size_t)(l * BATCH + b) * D) + lane;
        f32x4 v[4]; float s = 0.f;
#pragma unroll
        for (int j = 0; j < 4; ++j) { v[j] = xr[64 * j]; s += (v[j].x * v[j].x + v[j].y * v[j].y) + (v[j].z * v[j].z + v[j].w * v[j].w); }
        const float rstd = 1.f / sqrtf(wave_sum(s) * (1.f / D) + RMS_EPS);
        unsigned long long* o8 = (unsigned long long*)(F.H + (size_t)m * D) + lane;
#pragma unroll
        for (int j = 0; j < 4; ++j) { const f32x4 a = ma[64 * j], sh = mb[64 * j]; const f32x4 y = v[j] * rstd * a + sh;
            o8[64 * j] = (unsigned long long)pk2(y.x, y.y) | ((unsigned long long)pk2(y.z, y.w) << 32); }
    }
}
__device__ __forceinline__ void phase_prep(Frame& F, int l) {
    const int gw = blockIdx.x * NWAVES + F.wave, NGW = F.G * NWAVES, lane = opq(F.lane);
    for (int m = gw; m < TG; m += NGW) {
        {
            bf16* p = F.P + (size_t)m * NP + lane * 16;
            const v4u w0 = *(const v4u*)p, w1 = *(const v4u*)(p + 8);
            float x[16];
            x[0] = bflo(w0.x); x[1] = bfhi(w0.x); x[2] = bflo(w0.y); x[3] = bfhi(w0.y); x[4] = bflo(w0.z); x[5] = bfhi(w0.z); x[6] = bflo(w0.w); x[7] = bfhi(w0.w);
            x[8] = bflo(w1.x); x[9] = bfhi(w1.x); x[10] = bflo(w1.y); x[11] = bfhi(w1.y); x[12] = bflo(w1.z); x[13] = bfhi(w1.z); x[14] = bflo(w1.w); x[15] = bfhi(w1.w);
            float ss = 0.f;
#pragma unroll
            for (int i = 0; i < 16; ++i) ss += x[i] * x[i];
            ss += __shfl_xor(ss, 1); ss += __shfl_xor(ss, 2); ss += __shfl_xor(ss, 4);
            const float r = 1.f / sqrtf(ss * (1.f / 128.f) + RMS_EPS);
            const float* gn = (lane < 32 ? F.sb_qnorm : F.sb_knorm) + l * 128 + (lane & 7) * 16;
#pragma unroll
            for (int i = 0; i < 16; ++i) x[i] = x[i] * r * gn[i];
            v4u o0, o1;
            o0.x = pk2(x[0], x[1]); o0.y = pk2(x[2], x[3]); o0.z = pk2(x[4], x[5]); o0.w = pk2(x[6], x[7]);
            o1.x = pk2(x[8], x[9]); o1.y = pk2(x[10], x[11]); o1.z = pk2(x[12], x[13]); o1.w = pk2(x[14], x[15]);
            *(v4u*)p = o0; *(v4u*)(p + 8) = o1;
        }
    }
}
__device__ __forceinline__ void gdn_chain_naive(Frame& F, int l, int bh) {
    const int bl = bh >> 2, h = bh & 3, tid = opq(F.tid), v = tid & 127, kq = tid >> 7;
    LAS float* qv = (LAS float*)F.lds; LAS float* kv = qv + 128; LAS float* vv = kv + 128; LAS float* sc = vv + 128; LAS float* red = sc + 128; LAS float* red2 = red + 512;
    float s[32];
#pragma unroll
    for (int i = 0; i < 32; ++i) s[i] = 0.f;
    const float Aexp = expf(F.gdn_a_log[l * 4 + h]), dtb = F.gdn_dt_bias[l * 4 + h];
    for (int t = 0; t < SEQ; ++t) {
        const size_t row = (size_t)bl * SEQ + t;
        if (tid < 128) { const bf16* gp = F.GQKV + row * 1536 + h * 128 + tid; qv[tid] = bf2f(gp[0]); kv[tid] = bf2f(gp[512]); vv[tid] = bf2f(gp[1024]); }
        if (tid == 128) { const float db = F.PS[row * 32 + h], da = F.PS[row * 32 + 4 + h]; sc[0] = sigmoidf_(db); sc[1] = expf(-Aexp * softplusf_(da + dtb)); }
        __syncthreads();
        const float eg = sc[1]; float part = 0.f;
#pragma unroll
        for (int i = 0; i < 32; ++i) { s[i] *= eg; part += kv[kq * 32 + i] * s[i]; }
        red[kq * 128 + v] = part;
        __syncthreads();
        const float kS = (red[v] + red[128 + v]) + (red[256 + v] + red[384 + v]);
        const float delta = sc[0] * (vv[v] - kS); float part2 = 0.f;
#pragma unroll
        for (int i = 0; i < 32; ++i) { s[i] += kv[kq * 32 + i] * delta; part2 += qv[kq * 32 + i] * s[i]; }
        red2[kq * 128 + v] = part2;
        __syncthreads();
        if (tid < 128) { const float o = (red2[tid] + red2[128 + tid]) + (red2[256 + tid] + red2[384 + tid]); F.Y[row * YW + YC_GDN + h * 128 + tid] = (bf16)f2bf(o); }
    }
}
__device__ __forceinline__ void gla_chain_naive(Frame& F, int l, int bh) {
    const int bl = bh >> 2, h = bh & 3, tid = opq(F.tid), v = tid & 255, kh = tid >> 8;
    LAS float* qv = (LAS float*)F.lds; LAS float* kv = qv + 128; LAS float* ea = kv + 128; LAS float* vv = ea + 128; LAS float* red = vv + 256;
    float s[64];
#pragma unroll
    for (int i = 0; i < 64; ++i) s[i] = 0.f;
    float w2r[16]; float bb = 0.f;
    if (tid < 128) { bb = F.gla_b[l * 512 + h * 128 + tid];
#pragma unroll
        for (int r = 0; r < 16; ++r) w2r[r] = F.gla_w2[((size_t)l * 16 + r) * 512 + h * 128 + tid]; }
    else {
#pragma unroll
        for (int r = 0; r < 16; ++r) w2r[r] = 0.f; }
    for (int t = 0; t < SEQ; ++t) {
        const size_t row = (size_t)bl * SEQ + t;
        if (tid < 128) {
            const bf16* pp = F.P + row * NP + h * 128 + tid;
            qv[tid] = bf2f(pp[PC_LQ]) * 0.08838834764831845f; kv[tid] = bf2f(pp[PC_LK]);
            float xg = bb;
#pragma unroll
            for (int r = 0; r < 16; ++r) xg += F.PS[row * 32 + 8 + r] * w2r[r];
            ea[tid] = expf(logsigf_(xg) * (1.f / 16.f));
        } else if (tid >= 256) { vv[tid - 256] = bf2f(F.P[row * NP + PC_LV + h * 256 + (tid - 256)]); }
        __syncthreads();
        const float vvv = vv[v]; float part = 0.f;
#pragma unroll
        for (int i = 0; i < 64; ++i) { const int k = kh * 64 + i; s[i] = ea[k] * s[i] + kv[k] * vvv; part += qv[k] * s[i]; }
        red[kh * 256 + v] = part;
        __syncthreads();
        if (tid < 256) F.Y[row * YW + YC_GLA + h * 256 + tid] = (bf16)f2bf(red[tid] + red[256 + tid]);
    }
}
__device__ __forceinline__ void sb_naive(Frame& F, int w, int NW) {
    const int lane = opq(F.lane);
    for (int qi = w; qi < BG * 4 * SEQ; qi += NW) {
        const int bh = __builtin_amdgcn_readfirstlane(qi >> 11), t = __builtin_amdgcn_readfirstlane(qi & 2047), bl = bh >> 2, h = bh & 3;
        const size_t row = (size_t)bl * SEQ + t;
        const v4u* qp = (const v4u*)(F.P + row * NP + PC_SQ + h * 128);
        v4u qr[16];
#pragma unroll
        for (int i = 0; i < 16; ++i) qr[i] = qp[i];
        float acc0 = 0.f, acc1 = 0.f, R = 0.f;
        for (int kb = (t - 1) >> 6; kb >= 0; --kb) {
            const int s = kb * 64 + lane; const bool valid = s < t; const int sc = valid ? s : (t - 1);
            const v4u* kp = (const v4u*)(F.P + ((size_t)bl * SEQ + sc) * NP + PC_SK + h * 128);
            float dot = 0.f;
#pragma unroll
            for (int i = 0; i < 16; ++i) { const v4u kw = kp[i]; const v4u qw = qr[i];
                dot += bflo(kw.x) * bflo(qw.x) + bfhi(kw.x) * bfhi(qw.x) + bflo(kw.y) * bflo(qw.y) + bfhi(kw.y) * bfhi(qw.y)
                     + bflo(kw.z) * bflo(qw.z) + bfhi(kw.z) * bfhi(qw.z) + bflo(kw.w) * bflo(qw.w) + bfhi(kw.w) * bfhi(qw.w); }
            const float z = dot * 0.08838834764831845f;
            const float l1m = valid ? logsigf_(-z) : 0.f;
            float incl = l1m;
#pragma unroll
            for (int off = 1; off < 64; off <<= 1) { const float tmp = __shfl_down(incl, off); incl += (lane + off < 64) ? tmp : 0.f; }
            const float tail = R + incl - l1m;
            const float wgt = valid ? expf(logsigf_(z) + tail) : 0.f;
            R += __shfl(incl, 0);
            const bf16* vbase = F.P + ((size_t)bl * SEQ + kb * 64) * NP + PC_SV + h * 128 + 2 * lane;
            for (int j = 0; j < 64; ++j) { const float wj = __shfl(wgt, j);
                if (wj != 0.f) { const unsigned vw = *(const unsigned*)(vbase + (size_t)j * NP); acc0 += wj * bflo(vw); acc1 += wj * bfhi(vw); } }
            if (R < -104.f) break;
        }
        const unsigned zw = *(const unsigned*)(F.P + row * NP + PC_SZ + h * 128 + 2 * lane);
        *(unsigned*)(F.Y + row * YW + YC_SB + h * 128 + 2 * lane) = pk2(acc0 * bflo(zw), acc1 * bfhi(zw));
    }
}
typedef short bf16x8 __attribute__((ext_vector_type(8)));
__device__ __forceinline__ f32x4 mm16(const LAS bf16* A, int lda, int m0, const LAS bf16* Bt, int ldb, int n0, int K, int lane, f32x4 acc) {
    const LAS bf16* ap = A + (m0 + (lane & 15)) * lda + (lane >> 4) * 8;
    const LAS bf16* bp = Bt + (n0 + (lane & 15)) * ldb + (lane >> 4) * 8;
#pragma unroll
    for (int k0 = 0; k0 < K; k0 += 32) acc = __builtin_amdgcn_mfma_f32_16x16x32_bf16(*(const LAS bf16x8*)(ap + k0), *(const LAS bf16x8*)(bp + k0), acc, 0, 0, 0);
    return acc;
}
__device__ __forceinline__ int swz(int i, int g) { return (((i >> 3) ^ g) << 3) | (i & 7); }
__device__ __forceinline__ f32x4 mm16k64(const LAS bf16* A, int m0, int shA, const LAS bf16* Bt, int n0, int shB, int lane, f32x4 acc) {
    const int ga = shA ? ((m0 >> shA) & 7) : 0, gb = shB ? ((n0 >> shB) & 7) : 0, q = lane >> 4;
    const LAS bf16* ap = A + (m0 + (lane & 15)) * 72; const LAS bf16* bp = Bt + (n0 + (lane & 15)) * 72;
#pragma unroll
    for (int ks = 0; ks < 2; ++ks) acc = __builtin_amdgcn_mfma_f32_16x16x32_bf16(*(const LAS bf16x8*)(ap + (((ks * 4 + q) ^ ga) << 3)), *(const LAS bf16x8*)(bp + (((ks * 4 + q) ^ gb) << 3)), acc, 0, 0, 0);
    return acc;
}
__device__ __forceinline__ v2u pk4(const f32x4 a) { v2u r; r.x = pk2(a[0], a[1]); r.y = pk2(a[2], a[3]); return r; }

constexpr int GP_QS = 0, GP_KN = 17408, GP_AM = 34816, GP_QK = 54272, GP_TM = 63488, GP_VBT = 72704, GP_KBT = 91136, GP_KDT = 109568, GP_SC = 128000;
constexpr int GP_UBT = 17408, GP_WKT = 35840;
__device__ __forceinline__ void conv16(const Frame& F, const bf16* prow, int pos, const float* cw, float (&y)[16]) {
#pragma unroll
    for (int e = 0; e < 16; ++e) y[e] = 0.f;
#pragma unroll
    for (int tap = 0; tap < 4; ++tap) {
        const int dt = tap - 3;
        if (pos + dt >= 0) {
            const v4u w0 = *(const v4u*)(prow + (long)dt * NP), w1 = *(const v4u*)(prow + (long)dt * NP + 8);
            const f32x4 c0 = *(const f32x4*)(cw + tap * 1536), c1 = *(const f32x4*)(cw + tap * 1536 + 4), c2 = *(const f32x4*)(cw + tap * 1536 + 8), c3 = *(const f32x4*)(cw + tap * 1536 + 12);
            y[0] += c0[0] * bflo(w0.x); y[1] += c0[1] * bfhi(w0.x); y[2] += c0[2] * bflo(w0.y); y[3] += c0[3] * bfhi(w0.y);
            y[4] += c1[0] * bflo(w0.z); y[5] += c1[1] * bfhi(w0.z); y[6] += c1[2] * bflo(w0.w); y[7] += c1[3] * bfhi(w0.w);
            y[8] += c2[0] * bflo(w1.x); y[9] += c2[1] * bfhi(w1.x); y[10] += c2[2] * bflo(w1.y); y[11] += c2[3] * bfhi(w1.y);
            y[12] += c3[0] * bflo(w1.z); y[13] += c3[1] * bfhi(w1.z); y[14] += c3[2] * bflo(w1.w); y[15] += c3[3] * bfhi(w1.w);
        }
    }
#pragma unroll
    for (int e = 0; e < 16; ++e) y[e] = siluf_(y[e]);
}
__device__ __forceinline__ void gdn_pre_unit(Frame& F, int l, int unit) {
    const int tid = opq(F.tid), lane = tid & 63, w = __builtin_amdgcn_readfirstlane(tid >> 6);
    const int n = unit & 31, bh = unit >> 5, bl = bh >> 2, h = bh & 3;
    LAS bf16* Qs = (LAS bf16*)(F.lds + GP_QS); LAS bf16* Kn = (LAS bf16*)(F.lds + GP_KN); LAS float* Am = (LAS float*)(F.lds + GP_AM);
    LAS bf16* QKm = (LAS bf16*)(F.lds + GP_QK); LAS bf16* Tm = (LAS bf16*)(F.lds + GP_TM); LAS bf16* VbT = (LAS bf16*)(F.lds + GP_VBT);
    LAS bf16* KbT = (LAS bf16*)(F.lds + GP_KBT); LAS bf16* KdT = (LAS bf16*)(F.lds + GP_KDT); LAS bf16* UbT = (LAS bf16*)(F.lds + GP_UBT); LAS bf16* WkT = (LAS bf16*)(F.lds + GP_WKT);
    LAS float* gamA = (LAS float*)(F.lds + GP_SC); LAS float* betaA = gamA + 64; LAS float* gA = betaA + 64;
    const int row0 = bl * SEQ + n * 64;
    if (tid < 64) {
        const float db = F.PS[(size_t)(row0 + tid) * 32 + h], da = F.PS[(size_t)(row0 + tid) * 32 + 4 + h];
        betaA[tid] = sigmoidf_(db);
        gA[tid] = -expf(F.gdn_a_log[l * 4 + h]) * softplusf_(da + F.gdn_dt_bias[l * 4 + h]);
    }
    __syncthreads();
    const int i = tid >> 3, sub = tid & 7, c16 = sub * 16;
    float gam_i = 0.f, gl = 0.f;
    for (int j = 0; j < 64; ++j) { const float gj = gA[j]; gl += gj; if (j <= i) gam_i += gj; }
    const float beta_i = betaA[i];
    if (sub == 0) gamA[i] = gam_i;
    {
        const int pos = n * 64 + i;
        const bf16* prow = F.P + (size_t)(row0 + i) * NP + PC_DQ + h * 128 + c16;
        const float* cw = F.gdn_conv + (size_t)l * 4 * 1536 + h * 128 + c16;
        float y[16];
        conv16(F, prow, pos, cw, y);
        { float ss = 0.f;
#pragma unroll
          for (int e = 0; e < 16; ++e) ss += y[e] * y[e];
          ss += __shfl_xor(ss, 1); ss += __shfl_xor(ss, 2); ss += __shfl_xor(ss, 4);
          const float r = 0.08838834764831845f / sqrtf(ss + L2_EPS);
          v4u o0, o1; o0.x = pk2(y[0] * r, y[1] * r); o0.y = pk2(y[2] * r, y[3] * r); o0.z = pk2(y[4] * r, y[5] * r); o0.w = pk2(y[6] * r, y[7] * r);
          o1.x = pk2(y[8] * r, y[9] * r); o1.y = pk2(y[10] * r, y[11] * r); o1.z = pk2(y[12] * r, y[13] * r); o1.w = pk2(y[14] * r, y[15] * r);
          *(LAS v4u*)(Qs + i * 136 + c16) = o0; *(LAS v4u*)(Qs + i * 136 + c16 + 8) = o1; }
        conv16(F, prow + 512, pos, cw + 512, y);
        { float ss = 0.f;
#pragma unroll
          for (int e = 0; e < 16; ++e) ss += y[e] * y[e];
          ss += __shfl_xor(ss, 1); ss += __shfl_xor(ss, 2); ss += __shfl_xor(ss, 4);
          const float r = 1.f / sqrtf(ss + L2_EPS);
#pragma unroll
          for (int e = 0; e < 16; ++e) y[e] *= r;
          v4u o0, o1; o0.x = pk2(y[0], y[1]); o0.y = pk2(y[2], y[3]); o0.z = pk2(y[4], y[5]); o0.w = pk2(y[6], y[7]);
          o1.x = pk2(y[8], y[9]); o1.y = pk2(y[10], y[11]); o1.z = pk2(y[12], y[13]); o1.w = pk2(y[14], y[15]);
          *(LAS v4u*)(Kn + i * 136 + c16) = o0; *(LAS v4u*)(Kn + i * 136 + c16 + 8) = o1;
          const float fb = beta_i * __expf(gam_i), fd = __expf(gl - gam_i);
#pragma unroll
          for (int e = 0; e < 16; ++e) { KbT[(c16 + e) * 72 + swz(i, sub)] = (bf16)f2bf(y[e] * fb); KdT[(c16 + e) * 72 + swz(i, sub)] = (bf16)f2bf(y[e] * fd); } }
        conv16(F, prow + 1024, pos, cw + 1024, y);
#pragma unroll
        for (int e = 0; e < 16; ++e) VbT[(c16 + e) * 72 + swz(i, sub)] = (bf16)f2bf(y[e] * beta_i);
    }
    __syncthreads();
#pragma unroll
    for (int t = 0; t < 2; ++t) {
        const int idx = 2 * w + t, mb = idx >> 2, nb = idx & 3;
        const f32x4 z4 = {0.f, 0.f, 0.f, 0.f};
        const f32x4 akk = mm16(Kn, 136, mb * 16, Kn, 136, nb * 16, 128, lane, z4);
        const f32x4 aqk = mm16(Qs, 136, mb * 16, Kn, 136, nb * 16, 128, lane, z4);
        const int j = nb * 16 + (lane & 15); const float gj = gamA[j];
#pragma unroll
        for (int e = 0; e < 4; ++e) { const int ii = mb * 16 + 4 * (lane >> 4) + e; const float dc = __expf(fminf(gamA[ii] - gj, 0.f));
            Am[ii * 68 + j] = (ii > j) ? betaA[ii] * akk[e] * dc : 0.f;
            QKm[ii * 72 + j] = (bf16)f2bf((ii >= j) ? aqk[e] * dc : 0.f); }
    }
    __syncthreads();
#ifdef PROBE_TINV
    for (int rep_ = 0; rep_ < 2; ++rep_)
#endif
    if (w == 0) {
        float Tc[64];
#pragma clang loop unroll(full)
        for (int ii = 0; ii < 64; ++ii) {
            float s = (ii == lane) ? 1.f : 0.f;
#pragma clang loop unroll(full)
            for (int j = 0; j < ii; ++j) s -= Am[ii * 68 + j] * Tc[j];
            Tc[ii] = s;
            Tm[ii * 72 + lane] = (bf16)f2bf(s);
        }
    }
    __syncthreads();
#pragma unroll 1
    for (int b = 0; b < 8; ++b) {
        const int idx = w * 8 + b, which = idx >> 5, mb = (idx & 31) >> 3, nb = idx & 7;
        const f32x4 z4 = {0.f, 0.f, 0.f, 0.f};
        const f32x4 a = mm16k64(Tm, mb * 16, 0, which ? KbT : VbT, nb * 16, 4, lane, z4);
        LAS bf16* dst = which ? WkT : UbT;
        *(LAS v2u*)(dst + (nb * 16 + (lane & 15)) * 72 + mb * 16 + 4 * (lane >> 4)) = pk4(a);
    }
    __syncthreads();
    bf16* gWN = (bf16*)(F.wsb + WS_GD_WN) + (size_t)unit * 16384; bf16* gBT = (bf16*)(F.wsb + WS_GD_BT) + (size_t)unit * 16384;
    bf16* gQE = (bf16*)(F.wsb + WS_GD_QE) + (size_t)unit * 8192; bf16* gOL = (bf16*)(F.wsb + WS_GD_OL) + (size_t)unit * 8192;
    if (tid == 0) ((float*)(F.wsb + WS_GD_CD))[unit] = __expf(gl);
#pragma unroll 1
    for (int b = 0; b < 24; ++b) {
        const int idx = w * 24 + b;
        const f32x4 z4 = {0.f, 0.f, 0.f, 0.f};
        const int q4 = 4 * (lane >> 4), c = lane & 15;
        if (idx < 64) {
            const int mb = idx >> 3, nb = idx & 7;
            f32x4 a = mm16k64(WkT, mb * 16, 0, KdT, nb * 16, 4, lane, z4);
            a = -a;
            *(v2u*)(gWN + (nb * 16 + c) * 128 + mb * 16 + q4) = pk4(a);
        } else if (idx < 128) {
            const int x = idx - 64, mb = x >> 3, nb = x & 7;
            const f32x4 a = mm16k64(KdT, mb * 16, 4, UbT, nb * 16, 0, lane, z4);
            *(v2u*)(gBT + (nb * 16 + c) * 128 + mb * 16 + q4) = pk4(a);
        } else if (idx < 160) {
            const int x = idx - 128, mb = x >> 2, nb = x & 3;
            const f32x4 a = mm16(WkT, 72, mb * 16, QKm, 72, nb * 16, 64, lane, z4);
            const int ii = nb * 16 + c, d0 = mb * 16 + q4; const float eg = __expf(gamA[ii]);
            const v2u qw = *(const LAS v2u*)(Qs + ii * 136 + d0);
            f32x4 r; r[0] = bflo(qw.x) * eg - a[0]; r[1] = bfhi(qw.x) * eg - a[1]; r[2] = bflo(qw.y) * eg - a[2]; r[3] = bfhi(qw.y) * eg - a[3];
            *(v2u*)(gQE + ii * 128 + d0) = pk4(r);
        } else {
            const int x = idx - 160, mb = x >> 3, nb = x & 7;
            const f32x4 a = mm16(QKm, 72, mb * 16, UbT, 72, nb * 16, 64, lane, z4);
            *(v2u*)(gOL + (nb * 16 + c) * 64 + mb * 16 + q4) = pk4(a);
        }
    }
    __syncthreads();
}
__device__ __forceinline__ void gdn_chain(Frame& F, int bh) {
    const int tid = opq(F.tid), lane = tid & 63, w = __builtin_amdgcn_readfirstlane(tid >> 6);
    LAS bf16* Wl = (LAS bf16*)F.lds;
    LAS bf16* Sw = (LAS bf16*)(F.lds + 2 * 34816) + w * (16 * 136);
    const bf16* gWN = (const bf16*)(F.wsb + WS_GD_WN) + (size_t)bh * 32 * 16384;
    const bf16* gBT = (const bf16*)(F.wsb + WS_GD_BT) + (size_t)bh * 32 * 16384;
    bf16* gST = (bf16*)(F.wsb + WS_GD_ST) + (size_t)bh * 32 * 16384;
    const float* gCD = (const float*)(F.wsb + WS_GD_CD) + bh * 32;
    f32x4 acc[8];
#pragma unroll
    for (int mb = 0; mb < 8; ++mb) acc[mb] = (f32x4){0.f, 0.f, 0.f, 0.f};
    const int c = lane & 15, q4 = 4 * (lane >> 4);
    v4u wreg[4]; v2u breg[8]; float cd;
#pragma unroll
    for (int k = 0; k < 4; ++k) { const int p = tid + 512 * k; wreg[k] = *(const v4u*)(gWN + (size_t)(p >> 4) * 128 + (p & 15) * 8); }
#pragma unroll
    for (int mb = 0; mb < 8; ++mb) breg[mb] = *(const v2u*)(gBT + (16 * w + c) * 128 + mb * 16 + q4);
    cd = gCD[0];
#pragma unroll
    for (int k = 0; k < 4; ++k) { const int p = tid + 512 * k; *(LAS v4u*)(Wl + (p >> 4) * 136 + (p & 15) * 8) = wreg[k]; }
    for (int n = 0; n < 32; ++n) {
        LAS bf16* Wc = Wl + (n & 1) * (128 * 136); LAS bf16* Wn = Wl + ((n + 1) & 1) * (128 * 136);
#pragma unroll
        for (int mb = 0; mb < 8; ++mb) { const v2u pk = pk4(acc[mb]);
            *(LAS v2u*)(Sw + c * 136 + mb * 16 + q4) = pk;
            *(v2u*)(gST + (size_t)n * 16384 + (16 * w + c) * 128 + mb * 16 + q4) = pk; }
        __syncthreads();
        v2u bcur[8]; const float cdc = cd;
#pragma unroll
        for (int mb = 0; mb < 8; ++mb) bcur[mb] = breg[mb];
        if (n + 1 < 32) {
#pragma unroll
            for (int k = 0; k < 4; ++k) { const int p = tid + 512 * k; wreg[k] = *(const v4u*)(gWN + (size_t)(n + 1) * 16384 + (size_t)(p >> 4) * 128 + (p & 15) * 8); }
#pragma unroll
            for (int mb = 0; mb < 8; ++mb) breg[mb] = *(const v2u*)(gBT + (size_t)(n + 1) * 16384 + (16 * w + c) * 128 + mb * 16 + q4);
            cd = gCD[n + 1];
        }
#pragma unroll
        for (int mb = 0; mb < 8; ++mb) {
            f32x4 a = acc[mb] * cdc; a[0] += bflo(bcur[mb].x); a[1] += bfhi(bcur[mb].x); a[2] += bflo(bcur[mb].y); a[3] += bfhi(bcur[mb].y);
            acc[mb] = mm16(Wc, 136, mb * 16, Sw, 136, 0, 128, lane, a);
        }
        if (n + 1 < 32) {
#pragma unroll
            for (int k = 0; k < 4; ++k) { const int p = tid + 512 * k; *(LAS v4u*)(Wn + (p >> 4) * 136 + (p & 15) * 8) = wreg[k]; } }
    }
    __syncthreads();
}
__device__ __forceinline__ void gdn_post_unit(Frame& F, int l, int unit) {
    const int tid = opq(F.tid), lane = tid & 63, w = __builtin_amdgcn_readfirstlane(tid >> 6);
    const int n = unit & 31, bh = unit >> 5, bl = bh >> 2, h = bh & 3;
    LAS bf16* QEl = (LAS bf16*)F.lds;
    LAS bf16* STl = (LAS bf16*)(F.lds + 17408);
    LAS float* Of = (LAS float*)(F.lds + 52224);
    const bf16* gQE = (const bf16*)(F.wsb + WS_GD_QE) + (size_t)unit * 8192; const bf16* gST = (const bf16*)(F.wsb + WS_GD_ST) + (size_t)unit * 16384;
    const bf16* gOL = (const bf16*)(F.wsb + WS_GD_OL) + (size_t)unit * 8192;
#pragma unroll
    for (int k = 0; k < 2; ++k) { const int p = tid + 512 * k; *(LAS v4u*)(QEl + (p >> 4) * 136 + (p & 15) * 8) = *(const v4u*)(gQE + (size_t)(p >> 4) * 128 + (p & 15) * 8); }
#pragma unroll
    for (int k = 0; k < 4; ++k) { const int p = tid + 512 * k; *(LAS v4u*)(STl + (p >> 4) * 136 + (p & 15) * 8) = *(const v4u*)(gST + (size_t)(p >> 4) * 128 + (p & 15) * 8); }
    __syncthreads();
    const int c = lane & 15, q4 = 4 * (lane >> 4);
#pragma unroll
    for (int t = 0; t < 4; ++t) {
        const int mb = w >> 1, nb = (w & 1) * 4 + t, dv = nb * 16 + c, i0 = mb * 16 + q4;
        const v2u ow = *(const v2u*)(gOL + dv * 64 + i0);
        f32x4 a; a[0] = bflo(ow.x); a[1] = bfhi(ow.x); a[2] = bflo(ow.y); a[3] = bfhi(ow.y);
        a = mm16(QEl, 136, mb * 16, STl, 136, nb * 16, 128, lane, a);
#pragma unroll
        for (int e = 0; e < 4; ++e) Of[(i0 + e) * 132 + dv] = a[e];
    }
    __syncthreads();
    {
        const int i = tid >> 3, sub = tid & 7, c16 = sub * 16; const size_t row = (size_t)bl * SEQ + n * 64 + i;
        float x[16]; float ss = 0.f;
#pragma unroll
        for (int e = 0; e < 16; ++e) { x[e] = Of[i * 132 + c16 + e]; ss += x[e] * x[e]; }
        ss += __shfl_xor(ss, 1); ss += __shfl_xor(ss, 2); ss += __shfl_xor(ss, 4);
        const float r = 1.f / sqrtf(ss * (1.f / 128.f) + RMS_EPS);
        const float* gn = F.gdn_onorm + l * 128 + c16;
        const v4u z0 = *(const v4u*)(F.P + row * NP + PC_DZ + h * 128 + c16), z1 = *(const v4u*)(F.P + row * NP + PC_DZ + h * 128 + c16 + 8);
        const float zg[16] = {bflo(z0.x), bfhi(z0.x), bflo(z0.y), bfhi(z0.y), bflo(z0.z), bfhi(z0.z), bflo(z0.w), bfhi(z0.w), bflo(z1.x), bfhi(z1.x), bflo(z1.y), bfhi(z1.y), bflo(z1.z), bfhi(z1.z), bflo(z1.w), bfhi(z1.w)};
#pragma unroll
        for (int e = 0; e < 16; ++e) x[e] = x[e] * r * gn[e] * zg[e];
        v4u o0, o1; o0.x = pk2(x[0], x[1]); o0.y = pk2(x[2], x[3]); o0.z = pk2(x[4], x[5]); o0.w = pk2(x[6], x[7]);
        o1.x = pk2(x[8], x[9]); o1.y = pk2(x[10], x[11]); o1.z = pk2(x[12], x[13]); o1.w = pk2(x[14], x[15]);
        bf16* yp = F.Y + row * YW + YC_GDN + h * 128 + c16;
        *(v4u*)yp = o0; *(v4u*)(yp + 8) = o1;
    }
    __syncthreads();
}
constexpr size_t WS_GL_BS = 40 * MiB;
constexpr size_t WS_GL_AN = 619 * MiB;
constexpr int GL_LA = 0, GL_QD = 33792, GL_KT = 51200, GL_ATT = 68608, GL_VT = 77824, GL_LR = 114688, GL_GL = 118784;
__device__ __forceinline__ void gla_gam(Frame& F, int l, int h, int row0, int tid) {
    LAS float* laL = (LAS float*)(F.lds + GL_LA); LAS float* lrL = (LAS float*)(F.lds + GL_LR); LAS float* glL = (LAS float*)(F.lds + GL_GL);
#pragma unroll
    for (int k = 0; k < 2; ++k) { const int p = tid + 512 * k; lrL[p] = F.PS[(size_t)(row0 + (p >> 4)) * 32 + 8 + (p & 15)]; }
    const int d = tid & 127, ig = tid >> 7;
    float w2r[16]; const float bb = F.gla_b[l * 512 + h * 128 + d];
#pragma unroll
    for (int r = 0; r < 16; ++r) w2r[r] = F.gla_w2[((size_t)l * 16 + r) * 512 + h * 128 + d];
    __syncthreads();
#pragma unroll 4
    for (int ii = 0; ii < 16; ++ii) { const int i = ig * 16 + ii; float x = bb;
#pragma unroll
        for (int r = 0; r < 16; ++r) x += lrL[i * 16 + r] * w2r[r];
        laL[i * 132 + d] = (fminf(x, 0.f) - __logf(1.f + __expf(-fabsf(x)))) * (1.f / 16.f); }
    __syncthreads();
    if (tid < 128) { float run = 0.f;
        for (int i = 0; i < 64; ++i) { run += laL[i * 132 + tid]; laL[i * 132 + tid] = run; }
        glL[tid] = run; }
    __syncthreads();
}
__device__ __forceinline__ void gla_pre_unit(Frame& F, int l, int unit) {
    const int tid = opq(F.tid), lane = tid & 63, w = __builtin_amdgcn_readfirstlane(tid >> 6);
    const int n = unit & 31, bh = unit >> 5, bl = bh >> 2, h = bh & 3, row0 = bl * SEQ + n * 64;
    LAS float* laL = (LAS float*)(F.lds + GL_LA); LAS float* glL = (LAS float*)(F.lds + GL_GL);
    LAS bf16* KdT = (LAS bf16*)(F.lds + GL_QD);
    LAS bf16* VT = (LAS bf16*)(F.lds + GL_VT);
    gla_gam(F, l, h, row0, tid);
    {
        const int i = tid >> 3, sub = tid & 7;
        const bf16* kp = F.P + (size_t)(row0 + i) * NP + PC_LK + h * 128 + sub * 16;
        const v4u k0 = *(const v4u*)kp, k1 = *(const v4u*)(kp + 8);
        const float kk[16] = {bflo(k0.x), bfhi(k0.x), bflo(k0.y), bfhi(k0.y), bflo(k0.z), bfhi(k0.z), bflo(k0.w), bfhi(k0.w), bflo(k1.x), bfhi(k1.x), bflo(k1.y), bfhi(k1.y), bflo(k1.z), bfhi(k1.z), bflo(k1.w), bfhi(k1.w)};
#pragma unroll
        for (int e = 0; e < 16; ++e) { const int d = sub * 16 + e; KdT[d * 72 + swz(i, sub)] = (bf16)f2bf(kk[e] * __expf(glL[d] - laL[i * 132 + d])); }
        const bf16* vp = F.P + (size_t)(row0 + i) * NP + PC_LV + h * 256 + sub * 32;
#pragma unroll
        for (int k = 0; k < 4; ++k) { const v4u vw = *(const v4u*)(vp + 8 * k); const int dv = sub * 32 + 8 * k;
            const int si = swz(i, sub);
            VT[(dv + 0) * 72 + si] = (bf16)(vw.x & 0xffff); VT[(dv + 1) * 72 + si] = (bf16)(vw.x >> 16); VT[(dv + 2) * 72 + si] = (bf16)(vw.y & 0xffff); VT[(dv + 3) * 72 + si] = (bf16)(vw.y >> 16);
            VT[(dv + 4) * 72 + si] = (bf16)(vw.z & 0xffff); VT[(dv + 5) * 72 + si] = (bf16)(vw.z >> 16); VT[(dv + 6) * 72 + si] = (bf16)(vw.w & 0xffff); VT[(dv + 7) * 72 + si] = (bf16)(vw.w >> 16); }
        if (tid < 128) ((float*)(F.wsb + WS_GL_AN))[(size_t)unit * 128 + tid] = __expf(glL[tid]);
    }
    __syncthreads();
    bf16* gBS = (bf16*)(F.wsb + WS_GL_BS) + (size_t)unit * 32768;
    const int c = lane & 15, q4 = 4 * (lane >> 4);
#pragma unroll 1
    for (int b = 0; b < 16; ++b) {
        const int idx = w * 16 + b, mb = idx >> 4, nb = idx & 15;
        const f32x4 z4 = {0.f, 0.f, 0.f, 0.f};
        const f32x4 a = mm16k64(KdT, mb * 16, 4, VT, nb * 16, 5, lane, z4);
        *(v2u*)(gBS + (nb * 16 + c) * 128 + mb * 16 + q4) = pk4(a);
    }
    __syncthreads();
}
__device__ __forceinline__ void gla_scan(Frame& F, int bidx, int nblk) {
    const int tid = opq(F.tid);
    for (int item = bidx * NTHREADS + tid; item < BG * 4 * 4096; item += nblk * NTHREADS) {
        const int bh = item >> 12, rem = item & 4095, dv = rem >> 4, d8 = (rem & 15) * 8;
        bf16* base = (bf16*)(F.wsb + WS_GL_BS) + (size_t)bh * 32 * 32768 + dv * 128 + d8;
        const float* an = (const float*)(F.wsb + WS_GL_AN) + (size_t)bh * 32 * 128 + d8;
        float s[8];
#pragma unroll
        for (int e = 0; e < 8; ++e) s[e] = 0.f;
#pragma unroll 4
        for (int n = 0; n < 32; ++n) {
            const v4u bw = *(const v4u*)(base + (size_t)n * 32768);
            const f32x4 a0 = *(const f32x4*)(an + n * 128), a1 = *(const f32x4*)(an + n * 128 + 4);
            if (n >= 1) { v4u o; o.x = pk2(s[0], s[1]); o.y = pk2(s[2], s[3]); o.z = pk2(s[4], s[5]); o.w = pk2(s[6], s[7]); *(v4u*)(base + (size_t)(n - 1) * 32768) = o; }
            s[0] = a0[0] * s[0] + bflo(bw.x); s[1] = a0[1] * s[1] + bfhi(bw.x); s[2] = a0[2] * s[2] + bflo(bw.y); s[3] = a0[3] * s[3] + bfhi(bw.y);
            s[4] = a1[0] * s[4] + bflo(bw.z); s[5] = a1[1] * s[5] + bfhi(bw.z); s[6] = a1[2] * s[6] + bflo(bw.w); s[7] = a1[3] * s[7] + bfhi(bw.w);
        }
    }
}
__device__ __forceinline__ void gla_post_unit(Frame& F, int l, int unit) {
    const int tid = opq(F.tid), lane = tid & 63, w = __builtin_amdgcn_readfirstlane(tid >> 6);
    const int n = unit & 31, bh = unit >> 5, bl = bh >> 2, h = bh & 3, row0 = bl * SEQ + n * 64;
    LAS float* laL = (LAS float*)(F.lds + GL_LA);
    LAS bf16* QdL = (LAS bf16*)(F.lds + GL_QD); LAS bf16* KtL = (LAS bf16*)(F.lds + GL_KT); LAS bf16* AttL = (LAS bf16*)(F.lds + GL_ATT); LAS bf16* VT = (LAS bf16*)(F.lds + GL_VT);
    LAS float* Of = (LAS float*)F.lds;
    gla_gam(F, l, h, row0, tid);
    {
        const int i = tid >> 3, sub = tid & 7;
        const bf16* qp = F.P + (size_t)(row0 + i) * NP + PC_LQ + h * 128 + sub * 16;
        const v4u q0 = *(const v4u*)qp, q1 = *(const v4u*)(qp + 8), k0 = *(const v4u*)(qp + 512), k1 = *(const v4u*)(qp + 520);
        const float qq[16] = {bflo(q0.x), bfhi(q0.x), bflo(q0.y), bfhi(q0.y), bflo(q0.z), bfhi(q0.z), bflo(q0.w), bfhi(q0.w), bflo(q1.x), bfhi(q1.x), bflo(q1.y), bfhi(q1.y), bflo(q1.z), bfhi(q1.z), bflo(q1.w), bfhi(q1.w)};
        const float kk[16] = {bflo(k0.x), bfhi(k0.x), bflo(k0.y), bfhi(k0.y), bflo(k0.z), bfhi(k0.z), bflo(k0.w), bfhi(k0.w), bflo(k1.x), bfhi(k1.x), bflo(k1.y), bfhi(k1.y), bflo(k1.z), bfhi(k1.z), bflo(k1.w), bfhi(k1.w)};
        float qd[16], kt[16];
#pragma unroll
        for (int e = 0; e < 16; ++e) { const float gm = laL[i * 132 + sub * 16 + e]; qd[e] = qq[e] * 0.08838834764831845f * __expf(gm); kt[e] = kk[e] * __expf(-gm); }
        v4u o0, o1; o0.x = pk2(qd[0], qd[1]); o0.y = pk2(qd[2], qd[3]); o0.z = pk2(qd[4], qd[5]); o0.w = pk2(qd[6], qd[7]);
        o1.x = pk2(qd[8], qd[9]); o1.y = pk2(qd[10], qd[11]); o1.z = pk2(qd[12], qd[13]); o1.w = pk2(qd[14], qd[15]);
        *(LAS v4u*)(QdL + i * 136 + sub * 16) = o0; *(LAS v4u*)(QdL + i * 136 + sub * 16 + 8) = o1;
        o0.x = pk2(kt[0], kt[1]); o0.y = pk2(kt[2], kt[3]); o0.z = pk2(kt[4], kt[5]); o0.w = pk2(kt[6], kt[7]);
        o1.x = pk2(kt[8], kt[9]); o1.y = pk2(kt[10], kt[11]); o1.z = pk2(kt[12], kt[13]); o1.w = pk2(kt[14], kt[15]);
        *(LAS v4u*)(KtL + i * 136 + sub * 16) = o0; *(LAS v4u*)(KtL + i * 136 + sub * 16 + 8) = o1;
        const bf16* vp = F.P + (size_t)(row0 + i) * NP + PC_LV + h * 256 + sub * 32;
#pragma unroll
        for (int k = 0; k < 4; ++k) { const v4u vw = *(const v4u*)(vp + 8 * k); const int dv = sub * 32 + 8 * k;
            const int si = swz(i, sub);
            VT[(dv + 0) * 72 + si] = (bf16)(vw.x & 0xffff); VT[(dv + 1) * 72 + si] = (bf16)(vw.x >> 16); VT[(dv + 2) * 72 + si] = (bf16)(vw.y & 0xffff); VT[(dv + 3) * 72 + si] = (bf16)(vw.y >> 16);
            VT[(dv + 4) * 72 + si] = (bf16)(vw.z & 0xffff); VT[(dv + 5) * 72 + si] = (bf16)(vw.z >> 16); VT[(dv + 6) * 72 + si] = (bf16)(vw.w & 0xffff); VT[(dv + 7) * 72 + si] = (bf16)(vw.w >> 16); }
    }
    __syncthreads();
    const int c = lane & 15, q4 = 4 * (lane >> 4);
#pragma unroll
    for (int t = 0; t < 2; ++t) {
        const int idx = 2 * w + t, mb = idx >> 2, nb = idx & 3;
        const f32x4 z4 = {0.f, 0.f, 0.f, 0.f};
        const f32x4 a = mm16(QdL, 136, mb * 16, KtL, 136, nb * 16, 128, lane, z4);
        const int j = nb * 16 + c;
#pragma unroll
        for (int e = 0; e < 4; ++e) { const int ii = mb * 16 + q4 + e; AttL[ii * 72 + j] = (bf16)f2bf((ii >= j) ? a[e] : 0.f); }
    }
    __syncthreads();
    f32x4 acc[2][4];
    const bf16* gS = (const bf16*)(F.wsb + WS_GL_BS) + (size_t)(unit - 1) * 32768;
#pragma unroll
    for (int t = 0; t < 2; ++t) {
        const int nb = 2 * w + t;
        bf16x8 bfr[4];
#pragma unroll
        for (int ks = 0; ks < 4; ++ks) { if (n >= 1) bfr[ks] = *(const bf16x8*)(gS + (size_t)(nb * 16 + c) * 128 + ks * 32 + 8 * (lane >> 4)); else bfr[ks] = (bf16x8){0, 0, 0, 0, 0, 0, 0, 0}; }
#pragma unroll
        for (int mb = 0; mb < 4; ++mb) {
            f32x4 a = {0.f, 0.f, 0.f, 0.f};
#pragma unroll
            for (int ks = 0; ks < 4; ++ks) a = __builtin_amdgcn_mfma_f32_16x16x32_bf16(*(const LAS bf16x8*)(QdL + (mb * 16 + c) * 136 + ks * 32 + 8 * (lane >> 4)), bfr[ks], a, 0, 0, 0);
            acc[t][mb] = mm16k64(AttL, mb * 16, 0, VT, nb * 16, 5, lane, a);
        }
    }
    __syncthreads();
#pragma unroll
    for (int t = 0; t < 2; ++t)
#pragma unroll
        for (int mb = 0; mb < 4; ++mb)
#pragma unroll
            for (int e = 0; e < 4; ++e) Of[(mb * 16 + q4 + e) * 260 + (2 * w + t) * 16 + c] = acc[t][mb][e];
    __syncthreads();
    {
        const int i = tid >> 3, sub = tid & 7, c32 = sub * 32; const size_t row = (size_t)row0 + i;
        float x[32]; float ss = 0.f;
#pragma unroll
        for (int e = 0; e < 32; ++e) { x[e] = Of[i * 260 + c32 + e]; ss += x[e] * x[e]; }
        ss += __shfl_xor(ss, 1); ss += __shfl_xor(ss, 2); ss += __shfl_xor(ss, 4);
        const float r = 1.f / sqrtf(ss * (1.f / 256.f) + RMS_EPS);
        const float* gn = F.gla_onorm + l * 256 + c32;
        const bf16* zp = F.P + row * NP + PC_LZ + h * 256 + c32; bf16* yp = F.Y + row * YW + YC_GLA + h * 256 + c32;
#pragma unroll
        for (int k = 0; k < 4; ++k) { const v4u zw = *(const v4u*)(zp + 8 * k);
            const float zg[8] = {bflo(zw.x), bfhi(zw.x), bflo(zw.y), bfhi(zw.y), bflo(zw.z), bfhi(zw.z), bflo(zw.w), bfhi(zw.w)};
            float y[8];
#pragma unroll
            for (int e = 0; e < 8; ++e) y[e] = x[8 * k + e] * r * gn[8 * k + e] * zg[e];
            v4u o; o.x = pk2(y[0], y[1]); o.y = pk2(y[2], y[3]); o.z = pk2(y[4], y[5]); o.w = pk2(y[6], y[7]);
            *(v4u*)(yp + 8 * k) = o; }
    }
    __syncthreads();
}
constexpr int SB_QS = 0, SB_KS = 34816, SB_VT = 52224, SB_FL = 70656;
__device__ __forceinline__ void sb_unit(Frame& F, int unit) {
    const int tid = opq(F.tid), lane = tid & 63, w = __builtin_amdgcn_readfirstlane(tid >> 6);
    const int qt = ((unit >> 8) & 1) ? (unit & 15) : 15 - (unit & 15), bh = unit >> 4, bl = bh >> 2, h = bh & 3;
    LAS bf16* Qs = (LAS bf16*)(F.lds + SB_QS); LAS bf16* Ks = (LAS bf16*)(F.lds + SB_KS); LAS bf16* Vt = (LAS bf16*)(F.lds + SB_VT);
    volatile LAS unsigned* flags = (volatile LAS unsigned*)(F.lds + SB_FL);
    const size_t rowb = (size_t)bl * SEQ;
    const int c = lane & 15, q = lane >> 4, q4 = 4 * q;
#pragma unroll
    for (int k = 0; k < 4; ++k) { const int p = tid + 512 * k; *(LAS v4u*)(Qs + (p >> 4) * 136 + (p & 15) * 8) = *(const v4u*)(F.P + (rowb + qt * 128 + (p >> 4)) * NP + PC_SQ + h * 128 + (p & 15) * 8); }
    f32x4 o[8];
#pragma unroll
    for (int mb = 0; mb < 8; ++mb) o[mb] = (f32x4){0.f, 0.f, 0.f, 0.f};
    float R = 0.f;
    const int t = qt * 128 + 16 * w + c;
    for (int kb = 2 * qt + 1; kb >= 0; --kb) {
        {
            const int key = tid >> 3, sub = tid & 7;
            const bf16* kp = F.P + (rowb + kb * 64 + key) * NP + PC_SK + h * 128 + sub * 16;
            const v4u k0 = *(const v4u*)kp, k1 = *(const v4u*)(kp + 8), v0 = *(const v4u*)(kp + 512), v1 = *(const v4u*)(kp + 520);
            *(LAS v4u*)(Ks + key * 136 + sub * 16) = k0; *(LAS v4u*)(Ks + key * 136 + sub * 16 + 8) = k1;
            const int d0 = sub * 16, sk = swz(key, sub);
            Vt[(d0 + 0) * 72 + sk] = (bf16)(v0.x & 0xffff); Vt[(d0 + 1) * 72 + sk] = (bf16)(v0.x >> 16); Vt[(d0 + 2) * 72 + sk] = (bf16)(v0.y & 0xffff); Vt[(d0 + 3) * 72 + sk] = (bf16)(v0.y >> 16);
            Vt[(d0 + 4) * 72 + sk] = (bf16)(v0.z & 0xffff); Vt[(d0 + 5) * 72 + sk] = (bf16)(v0.z >> 16); Vt[(d0 + 6) * 72 + sk] = (bf16)(v0.w & 0xffff); Vt[(d0 + 7) * 72 + sk] = (bf16)(v0.w >> 16);
            Vt[(d0 + 8) * 72 + sk] = (bf16)(v1.x & 0xffff); Vt[(d0 + 9) * 72 + sk] = (bf16)(v1.x >> 16); Vt[(d0 + 10) * 72 + sk] = (bf16)(v1.y & 0xffff); Vt[(d0 + 11) * 72 + sk] = (bf16)(v1.y >> 16);
            Vt[(d0 + 12) * 72 + sk] = (bf16)(v1.z & 0xffff); Vt[(d0 + 13) * 72 + sk] = (bf16)(v1.z >> 16); Vt[(d0 + 14) * 72 + sk] = (bf16)(v1.w & 0xffff); Vt[(d0 + 15) * 72 + sk] = (bf16)(v1.w >> 16);
        }
        __syncthreads();
        const bool active = (kb * 64 < qt * 128 + 16 * w + 15);
        if (active) {
            float wgt[4][4], l1m[4][4], tot[4], hi[4];
#pragma unroll
            for (int kk = 0; kk < 4; ++kk) {
                const f32x4 z4 = {0.f, 0.f, 0.f, 0.f};
                const f32x4 a = mm16(Ks, 136, kk * 16, Qs, 136, 16 * w, 128, lane, z4);
                float g = 0.f;
#pragma unroll
                for (int e = 0; e < 4; ++e) {
                    const int s = kb * 64 + kk * 16 + q4 + e; const bool valid = s < t;
                    const float z = a[e] * 0.08838834764831845f;
                    const float sp = fmaxf(z, 0.f) + __logf(1.f + __expf(-fabsf(z)));
                    l1m[kk][e] = valid ? -sp : 0.f;
                    wgt[kk][e] = valid ? (z - sp) : -1e30f;
                    g += l1m[kk][e];
                }
                const float b = __shfl_xor(g, 16), pr = g + b, d = __shfl_xor(pr, 32);
                hi[kk] = ((q & 1) == 0 ? b : 0.f) + ((q & 2) == 0 ? d : 0.f);
                tot[kk] = pr + d;
            }
            float after = R;
#pragma unroll
            for (int kk = 3; kk >= 0; --kk) {
                float tail = after + hi[kk];
#pragma unroll
                for (int e = 3; e >= 0; --e) { const float lw = wgt[kk][e] + tail; wgt[kk][e] = __expf(lw); tail += l1m[kk][e]; }
                after += tot[kk];
            }
            R = after;
#pragma unroll
            for (int ks = 0; ks < 2; ++ks) {
                v4u pb; pb.x = pk2(wgt[2 * ks][0], wgt[2 * ks][1]); pb.y = pk2(wgt[2 * ks][2], wgt[2 * ks][3]); pb.z = pk2(wgt[2 * ks + 1][0], wgt[2 * ks + 1][1]); pb.w = pk2(wgt[2 * ks + 1][2], wgt[2 * ks + 1][3]);
                const bf16x8 bfrag = __builtin_bit_cast(bf16x8, pb);
#pragma unroll
                for (int mb = 0; mb < 8; ++mb) {
                    const LAS bf16* vp = Vt + (mb * 16 + c) * 72 + 4 * (q & 1);
                    const v2u lo = *(const LAS v2u*)(vp + (((4 * ks + (q >> 1)) ^ mb) << 3)), hi2 = *(const LAS v2u*)(vp + (((4 * ks + 2 + (q >> 1)) ^ mb) << 3));
                    v4u av; av.x = lo.x; av.y = lo.y; av.z = hi2.x; av.w = hi2.y;
                    o[mb] = __builtin_amdgcn_mfma_f32_16x16x32_bf16(__builtin_bit_cast(bf16x8, av), bfrag, o[mb], 0, 0, 0);
                }
            }
        }
        const bool done = __all(R < -104.f || !active) && active;
        if (lane == 0) flags[w] = done ? 1u : 0u;
        __syncthreads();
        unsigned alldone = 1u;
#pragma unroll
        for (int k = 0; k < 8; ++k) alldone &= flags[k];
        if (alldone) break;
    }
    {
        const size_t row = rowb + qt * 128 + 16 * w + c;
#pragma unroll
        for (int mb = 0; mb < 8; ++mb) {
            const int d = mb * 16 + q4;
            const v2u zw = *(const v2u*)(F.P + row * NP + PC_SZ + h * 128 + d);
            v2u ow; ow.x = pk2(o[mb][0] * bflo(zw.x), o[mb][1] * bfhi(zw.x)); ow.y = pk2(o[mb][2] * bflo(zw.y), o[mb][3] * bfhi(zw.y));
            *(v2u*)(F.Y + row * YW + YC_SB + h * 128 + d) = ow;
        }
    }
    __syncthreads();
}
__device__ __forceinline__ void phase_mix_naive(Frame& F, int l) {
    const int bx = blockIdx.x;
    if (bx < 32) gdn_chain(F, bx);
    else if (bx < 64) gla_scan(F, bx - 32, 32);
    else for (int u = bx - 64; u < BG * 4 * 16; u += F.G - 64) sb_unit(F, u);
}
__device__ __forceinline__ void phase_post(Frame& F, int l) {
    const int gw = blockIdx.x * NWAVES + F.wave, NGW = F.G * NWAVES, lane = opq(F.lane);
    for (int m = gw; m < TG; m += NGW) {
#pragma unroll
        for (int ps = 1; ps < 3; ++ps) {
            const int e = (ps == 0) ? lane * 8 : (ps - 1) * 512 + lane * 8;
            bf16* yp = F.Y + (size_t)m * YW + (ps == 0 ? YC_GDN : YC_GLA) + e;
            const bf16* zp = F.P + (size_t)m * NP + (ps == 0 ? PC_DZ : PC_LZ) + e;
            const v4u w = *(const v4u*)yp, zw = *(const v4u*)zp;
            float x[8] = {bflo(w.x), bfhi(w.x), bflo(w.y), bfhi(w.y), bflo(w.z), bfhi(w.z), bflo(w.w), bfhi(w.w)};
            const float zg[8] = {bflo(zw.x), bfhi(zw.x), bflo(zw.y), bfhi(zw.y), bflo(zw.z), bfhi(zw.z), bflo(zw.w), bfhi(zw.w)};
            float ss = 0.f;
#pragma unroll
            for (int i = 0; i < 8; ++i) ss += x[i] * x[i];
            ss += __shfl_xor(ss, 1); ss += __shfl_xor(ss, 2); ss += __shfl_xor(ss, 4); ss += __shfl_xor(ss, 8);
            float r; const float* gn;
            if (ps == 0) { r = 1.f / sqrtf(ss * (1.f / 128.f) + RMS_EPS); gn = F.gdn_onorm + l * 128 + (lane & 15) * 8; }
            else { ss += __shfl_xor(ss, 16); r = 1.f / sqrtf(ss * (1.f / 256.f) + RMS_EPS); gn = F.gla_onorm + l * 256 + (lane & 31) * 8; }
#pragma unroll
            for (int i = 0; i < 8; ++i) x[i] = x[i] * r * gn[i] * zg[i];
            v4u o; o.x = pk2(x[0], x[1]); o.y = pk2(x[2], x[3]); o.z = pk2(x[4], x[5]); o.w = pk2(x[6], x[7]);
            *(v4u*)yp = o;
        }
    }
}

__global__ void __launch_bounds__(NTHREADS, 2) fwd_kernel(Args args) {
    extern __shared__ __attribute__((aligned(16))) unsigned char lds_raw[];
    Frame F;
    F.lds = (LAS unsigned char*)lds_raw;
    volatile LAS unsigned* MISC = (volatile LAS unsigned*)(F.lds + MISC_OFF);
    F.tid = threadIdx.x; F.lane = F.tid & 63; F.wave = __builtin_amdgcn_readfirstlane(F.tid >> 6); F.G = gridDim.x;
    unsigned char* ws = args.ws;
    F.x = args.in[0]; F.c = args.in[1]; F.ada_w = args.in[2]; F.ada_b = args.in[3]; F.norm_g = args.in[4]; F.w_in = args.in[5]; F.sb_qnorm = args.in[6]; F.sb_knorm = args.in[7];
    F.gdn_conv = args.in[8]; F.gdn_a_log = args.in[9]; F.gdn_dt_bias = args.in[10]; F.gdn_onorm = args.in[11]; F.gla_w2 = args.in[12]; F.gla_b = args.in[13]; F.gla_onorm = args.in[14];
    F.merge_b = args.in[15]; F.proj_sb = args.in[16]; F.proj_gdn = args.in[17]; F.proj_gla = args.in[18]; F.w_out = args.in[19];
    F.out = args.out; F.wsb = ws;
    F.MODP = (float*)(ws + WS_MODP); F.MODA = (float*)(ws + WS_MOD); F.MODB = F.MODA + DEPTH * BATCH * D; F.MODG = F.MODB + DEPTH * BATCH * D;
    F.PS = (float*)(ws + WS_PS); F.MGF = (float*)(ws + WS_MGF);
    F.WIN = (bf16*)(ws + WS_WIN); F.WP = (bf16*)(ws + WS_WP); F.WO = (bf16*)(ws + WS_WO); F.H = (bf16*)(ws + WS_H); F.MGB = (bf16*)(ws + WS_MGB);
    F.P = (bf16*)(ws + WS_P); F.Y = (bf16*)(ws + WS_Y); F.GQKV = (bf16*)(ws + WS_H);
    for (int u = F.tid; u < 32; u += NTHREADS) MISC[u] = 0u;
    __syncthreads();
    XcdBarrier bar = xcd_barrier_post((unsigned*)(ws + WS_CTL) + CW_BAR, MISC + 8);
#define GRID_BAR() do { XcdBarrier b2_ = bar; asm volatile("" : "+s"(b2_.x)); xcd_barrier(b2_); } while (0)

    p0_ada(F);
    GRID_BAR();
    p1_mod(F);
    GRID_BAR();
    for (int l = 0; l < DEPTH; ++l) {
        const float* xin = (l == 0) ? F.x : F.out;
        for (int g = 0; g < NGRP; ++g) {
            if (g == 0) wconv_layer(F, l);
            phase_norm(F, xin, l, g);
            GRID_BAR();
#define PH_G1() do { pg8::Gemm gm{F.H, F.WIN, D, D, D}; pg8::StaticOrder S; S.init(TG, NWT, F.G, (int)blockIdx.x); \
                EpiG1 E{F.P, F.PS, F.merge_b + l * 3072}; \
                pg8::gemm_phase<EpiG1, pg8::StaticOrder, true>(F.lds, gm, S, E); GRID_BAR(); } while (0)
            PH_G1();
#ifdef PROBE_G1
            PH_G1();
#endif
            phase_prep(F, l);
#define PH_PRE() do { for (int u = blockIdx.x; u < BG * 4 * 32; u += F.G) gdn_pre_unit(F, l, u); \
                for (int u = blockIdx.x; u < BG * 4 * 32; u += F.G) gla_pre_unit(F, l, u); GRID_BAR(); } while (0)
            PH_PRE();
#ifdef PROBE_PRE
            PH_PRE();
#endif
#ifdef PROBE_GDNPRE
            for (int u = blockIdx.x; u < BG * 4 * 32; u += F.G) gdn_pre_unit(F, l, u); GRID_BAR();
#endif
#ifdef PROBE_GLAPRE
            for (int u = blockIdx.x; u < BG * 4 * 32; u += F.G) gla_pre_unit(F, l, u); GRID_BAR();
#endif
#define PH_MIX() do { const int bx = blockIdx.x; if (bx < 32) gdn_chain(F, bx); else { for (int u = bx - 32; u < BG * 4 * 16; u += F.G - 32) sb_unit(F, u); gla_scan(F, bx - 32, F.G - 32); } GRID_BAR(); } while (0)
#ifdef PROBE_CHAIN
            if (blockIdx.x < 32) gdn_chain(F, blockIdx.x); GRID_BAR();
#endif
#ifdef PROBE_SB
            if (blockIdx.x >= 32) { for (int u = blockIdx.x - 32; u < BG * 4 * 16; u += F.G - 32) sb_unit(F, u); } GRID_BAR();
#endif
            PH_MIX();
#define PH_POST() do { for (int u = blockIdx.x; u < BG * 4 * 32; u += F.G) gdn_post_unit(F, l, u); \
                for (int u = blockIdx.x; u < BG * 4 * 32; u += F.G) gla_post_unit(F, l, u); GRID_BAR(); } while (0)
            PH_POST();
#ifdef PROBE_GDNPOST
            for (int u = blockIdx.x; u < BG * 4 * 32; u += F.G) gdn_post_unit(F, l, u); GRID_BAR();
#endif
#ifdef PROBE_GLAPOST
            for (int u = blockIdx.x; u < BG * 4 * 32; u += F.G) gla_post_unit(F, l, u); GRID_BAR();
#endif
#define PH_G2() do { pg8::StaticOrder S; S.init(TG, D, F.G, (int)blockIdx.x); \
                pg8::Gemm gm{F.Y, F.WP, YW, 2048, 2048}; EpiG2R E{F.P, F.MGB}; \
                pg8::gemm_phase<EpiG2R, pg8::StaticOrder, false>(F.lds, gm, S, E); GRID_BAR(); } while (0)
            PH_G2();
#ifdef PROBE_G2
            PH_G2();
#endif
#ifndef NO_G3
            {   pg8::Gemm gm{F.MGB, F.WO, D, D, D}; pg8::StaticOrder S; S.init(TG, D, F.G, (int)blockIdx.x);
                EpiG3 E{xin, F.out, F.MODG + (size_t)l * BATCH * D, g * TG};
                pg8::gemm_phase<EpiG3, pg8::StaticOrder, false>(F.lds, gm, S, E); }
#endif
            GRID_BAR();
        }
    }
}

extern "C" void kernel_launch(void* const* d_in, const int* in_sizes, int n_in, void* d_out, int out_size, void* d_ws, size_t ws_size, hipStream_t stream) {
    static int grid = 0;
    if (grid == 0) {
        if (n_in != 20 || out_size != T * D || ws_size < WS_END) { fprintf(stderr, "kernel_launch: unexpected shapes / workspace (%d inputs, out %d, ws %zu)\n", n_in, out_size, ws_size); grid = -1; return; }
        int dev = 0, cus = 0, per_cu = 0;
        if (hipGetDevice(&dev) != hipSuccess || hipDeviceGetAttribute(&cus, hipDeviceAttributeMultiprocessorCount, dev) != hipSuccess) { grid = -1; return; }
        if (hipFuncSetAttribute((const void*)fwd_kernel, hipFuncAttributeMaxDynamicSharedMemorySize, LDS_BYTES) != hipSuccess) { grid = -1; return; }
        if (hipOccupancyMaxActiveBlocksPerMultiprocessor(&per_cu, (const void*)fwd_kernel, NTHREADS, LDS_BYTES) != hipSuccess || per_cu < 1) fprintf(stderr, "kernel_launch: occupancy query reports %d\n", per_cu);
        (void)hipGetLastError();
        grid = cus;
    }
    if (grid < 0) return;
    if (hipMemsetAsync((char*)d_ws + WS_CTL, 0, CTL_ZERO_BYTES, stream) != hipSuccess) return;
    Args a{};
    for (int i = 0; i < 20; ++i) a.in[i] = (const float*)d_in[i];
    a.out = (float*)d_out; a.ws = (unsigned char*)d_ws; a.ph_lo = 0; a.ph_hi = 0;
    hipLaunchKernelGGL(fwd_kernel, dim3(grid), dim3(NTHREADS), LDS_BYTES, stream, a);
}
```

```cpp
#include <hip/hip_runtime.h>
#include <cstdio>
#include <cstdint>

#define GAS __attribute__((address_space(1)))
#define LAS __attribute__((address_space(3)))

#define XB_TMO      128
#define XB_XCNT(j)  (256  + 64 * (j))
#define XB_XSUB(j)  (1280 + 64 * (j))
#define XB_XGEN(j)  (2304 + 64 * (j))
#define XB_TOP      3328
#define XB_TOPGEN   3392
#define XCD_BAR_WORDS 3456
#define XB_SPIN_CAP (1u << 24)

__device__ __forceinline__ unsigned xb_ld(unsigned* p)              { return __hip_atomic_load(p, __ATOMIC_RELAXED, __HIP_MEMORY_SCOPE_AGENT); }
__device__ __forceinline__ unsigned xb_add(unsigned* p, unsigned v) { return __hip_atomic_fetch_add(p, v, __ATOMIC_RELAXED, __HIP_MEMORY_SCOPE_AGENT); }
__device__ __forceinline__ unsigned xb_xcc_id() { return (unsigned)__builtin_amdgcn_s_getreg((3 << 11) | 20) & 0xFu; }
#define XB_SPIN(cond, bar) do { unsigned _sp = 0; while (cond) { __builtin_amdgcn_s_sleep(1); \
    if ((++_sp & 255u) == 0u) { if (xb_ld(&(bar)[XB_TMO])) break; if (_sp > XB_SPIN_CAP) { atomicAdd(&(bar)[XB_TMO], 1u); break; } } } } while (0)

struct XcdBarrier { unsigned* bar; unsigned x; volatile LAS unsigned* st; };

__device__ __forceinline__ XcdBarrier xcd_barrier_post(unsigned* bar, volatile LAS unsigned* st) {
    XcdBarrier b; b.bar = bar; b.x = xb_xcc_id(); b.st = st;
    if (threadIdx.x == 0) (void)xb_add(&bar[XB_XCNT(b.x)], 1u);
    return b;
}
__device__ __forceinline__ void xcd_barrier_complete(unsigned* bar, unsigned x, unsigned& nloc, unsigned& nx) {
    const unsigned G = gridDim.x * gridDim.y * gridDim.z;
    unsigned sum, cnt, mine, sp = 0u;
    for (;;) {
        sum = 0u; cnt = 0u; mine = 0u;
#pragma unroll
        for (unsigned j = 0; j < 16; ++j) { const unsigned c = xb_ld(&bar[XB_XCNT(j)]); sum += c; cnt += (c > 0u) ? 1u : 0u; mine = (j == x) ? c : mine; }
        if (sum == G) break;
        __builtin_amdgcn_s_sleep(1);
        if ((++sp & 255u) == 0u) { if (xb_ld(&bar[XB_TMO])) break; if (sp > XB_SPIN_CAP) { atomicAdd(&bar[XB_TMO], 1u); break; } }
    }
    nloc = mine > 0u ? mine : 1u; nx = cnt > 0u ? cnt : 1u;
}
__device__ __forceinline__ void xcd_barrier(const XcdBarrier& b) {
    asm volatile("s_waitcnt vmcnt(0)" ::: "memory");
    __syncthreads();
    if (threadIdx.x == 0) {
        unsigned* bar = b.bar;
        __builtin_amdgcn_s_waitcnt(0);
        unsigned nloc = b.st[0], nx = b.st[1];
        if (nloc == 0u) { xcd_barrier_complete(bar, b.x, nloc, nx); b.st[0] = nloc; b.st[1] = nx; }
        const unsigned old = xb_add(&bar[XB_XSUB(b.x)], 1u);
        const unsigned gen = old / nloc;
        if (old + 1u == (gen + 1u) * nloc) {
            __builtin_amdgcn_fence(__ATOMIC_RELEASE, "agent");
            asm volatile("s_waitcnt vmcnt(0)" ::: "memory");
            const unsigned og = xb_add(&bar[XB_TOP], 1u);
            const unsigned tg = og / nx;
            if (og + 1u == (tg + 1u) * nx) xb_add(&bar[XB_TOPGEN], 1u);
            else XB_SPIN(xb_ld(&bar[XB_TOPGEN]) == tg, bar);
            __builtin_amdgcn_fence(__ATOMIC_ACQUIRE, "agent");
            xb_add(&bar[XB_XGEN(b.x)], 1u);
            asm volatile("s_waitcnt vmcnt(0)" ::: "memory");
        } else {
            XB_SPIN(xb_ld(&bar[XB_XGEN(b.x)]) == gen, bar);
            __builtin_amdgcn_fence(__ATOMIC_ACQUIRE, "agent");
            asm volatile("s_waitcnt vmcnt(0)" ::: "memory");
        }
    }
    __syncthreads();
}
namespace pg8 {
#define PG8_LAS __attribute__((address_space(3)))
typedef unsigned short bf16_t;
typedef short bf16x8 __attribute__((ext_vector_type(8)));
typedef float f32x4 __attribute__((ext_vector_type(4)));
typedef unsigned u32x4 __attribute__((ext_vector_type(4)));
typedef unsigned u32x2 __attribute__((ext_vector_type(2)));
constexpr int BM = 256, BK = 64, HALF = 128, HTB = HALF * BK * 2, STAGE_BYTES = 8 * HTB, NXCD = 8, WGM = 8;

__host__ __device__ __forceinline__ int lds_byte(int r, int c) { const int st = (r >> 4) * 2 + (c >> 5), rr = r & 15, cc = c & 31, ob = rr * 64 + cc * 2; return st * 1024 + (ob ^ (((ob >> 9) & 1) << 5)); }
__host__ __device__ __forceinline__ void stage_rc(int b, int& R, int& C) { const int st = b / 1024, sb = b % 1024, swz = sb ^ (((sb >> 9) & 1) << 5); R = (st >> 1) * 16 + swz / 64; C = (st & 1) * 32 + (swz % 64) / 2; }
__host__ __device__ __forceinline__ int perm32(int rho) { const int n = rho >> 4, i = rho & 15; return 8 * (i >> 2) + 4 * n + (i & 3); }

struct Unit { int pm, pn, seg; };
struct Gemm { const bf16_t* A; const bf16_t* Bt; int lda, ldb, K; };

struct StaticOrder {
    int nM, nN, nwg, G, c;
    __host__ __device__ void init(int M, int N, int G_, int c_) { nM = M / BM; nN = N / BM; nwg = nM * nN; G = G_; c = c_; }
    __host__ __device__ bool next(int i, Unit& u) const {
        const long L = (long)i * G + c; if (L >= nwg) return false;
        int wgid = (int)L; { const int q = nwg / NXCD, r = nwg % NXCD, xcd = wgid % NXCD, off = wgid / NXCD; wgid = (xcd < r ? xcd * (q + 1) : r * (q + 1) + (xcd - r) * q) + off; }
        const int nig = WGM * nN, gid = wgid / nig, fm = gid * WGM, gsz = (nM - fm) < WGM ? (nM - fm) : WGM;
        u.pm = fm + ((wgid % nig) % gsz); u.pn = (wgid % nig) / gsz; u.seg = 0; return true;
    }
    __device__ __forceinline__ size_t k_off(const Unit&) const { return 0; }
    __device__ __forceinline__ void a_ready(const Unit&) const {}
    __device__ __forceinline__ void done(const Unit&) const {}
};

template <int NSEG> struct SegOrder : StaticOrder {
    int segk;
    __host__ __device__ bool next(int i, Unit& u) const { if (!StaticOrder::next(i / NSEG, u)) return false; u.seg = i % NSEG; return true; }
    __device__ __forceinline__ size_t k_off(const Unit& u) const { return (size_t)u.seg * segk * 2; }
};
__device__ __forceinline__ unsigned cvt_pk_bf16(float lo, float hi) { unsigned r; asm volatile("v_cvt_pk_bf16_f32 %0, %1, %2" : "=v"(r) : "v"(lo), "v"(hi)); return r; }

template <class Epi, class Sched, bool ALIGN_EPI>
__device__ __forceinline__ void gemm_phase(PG8_LAS unsigned char* lds, const Gemm g, const Sched& S, const Epi& E) {
    int tid = threadIdx.x; asm volatile("" : "+v"(tid));
    const int wid = __builtin_amdgcn_readfirstlane(tid >> 6), lane = tid & 63, wr = wid >> 2, wc = wid & 3, fr = lane & 15, fq = lane >> 4;
    const int K = g.K, nt = K / BK;
    unsigned voffA[2], voffB[2];
#pragma unroll
    for (int i = 0; i < 2; ++i) { int R, C; stage_rc(tid * 16 + i * 8192, R, C); const int Rb = Epi::PERM ? ((R & ~31) + perm32(R & 31)) : R;
        voffA[i] = (unsigned)(R * g.lda + C) * 2u; voffB[i] = (unsigned)(Rb * g.ldb + C) * 2u; }
    const size_t kstep = (size_t)(BK * 2);
    const size_t hstepA = (size_t)HALF * g.lda * 2, hstepB = (size_t)HALF * g.ldb * 2;
    const size_t tstepA = 2 * hstepA, tstepB = 2 * hstepB;
    const unsigned ldsw = (unsigned)wid * 1024u;
    const int aoff = lds_byte(wr * 64 + fr, fq * 8), boff = lds_byte(wc * 32 + fr, fq * 8);
#define PG8_SA(b, h) (((b) * 2 + (h)) * HTB)
#define PG8_SB(b, h) ((4 + (b) * 2 + (h)) * HTB)
#define PG8_STAGE(bufoff, gbase, voff) do { _Pragma("unroll") for (int _i = 0; _i < 2; ++_i) \
        __builtin_amdgcn_global_load_lds((const unsigned*)((const char*)(gbase) + (voff)[_i]), (PG8_LAS unsigned*)(lds + (bufoff) + ldsw + _i * 8192), 16, 0, 0); } while (0)
#define PG8_LDA(dst, b, h) do { _Pragma("unroll") for (int m = 0; m < 4; ++m) _Pragma("unroll") for (int k = 0; k < 2; ++k) dst[m][k] = *(const PG8_LAS bf16x8*)(lds + PG8_SA(b, h) + aoff + m * 2048 + k * 1024); } while (0)
#define PG8_LDB(dst, b, h) do { _Pragma("unroll") for (int n = 0; n < 2; ++n) _Pragma("unroll") for (int k = 0; k < 2; ++k) dst[n][k] = *(const PG8_LAS bf16x8*)(lds + PG8_SB(b, h) + boff + n * 2048 + k * 1024); } while (0)
#define PG8_MMA(ai, bj, At, Bt) do { __builtin_amdgcn_s_setprio(1); _Pragma("unroll") for (int m = 0; m < 4; ++m) _Pragma("unroll") for (int n = 0; n < 2; ++n) _Pragma("unroll") for (int k = 0; k < 2; ++k) \
        acc[ai][bj][m][n] = __builtin_amdgcn_mfma_f32_16x16x32_bf16(Bt[n][k], At[m][k], acc[ai][bj][m][n], 0, 0, 0); __builtin_amdgcn_s_setprio(0); } while (0)
#define PG8_WAIT_V(n) asm volatile("s_waitcnt vmcnt(" #n ")" ::: "memory")
#define PG8_WAIT_L(n) asm volatile("s_waitcnt lgkmcnt(" #n ")" ::: "memory")
#define PG8_BAR __builtin_amdgcn_s_barrier()
#define PG8_SCHED __builtin_amdgcn_sched_barrier(0)
    Unit cur, nxt; int ui = 0;
    if (!S.next(0, cur)) return;
    f32x4 acc[2][2][4][2];
#pragma unroll
    for (int a = 0; a < 2; ++a)
#pragma unroll
        for (int b = 0; b < 2; ++b)
#pragma unroll
            for (int m = 0; m < 4; ++m)
#pragma unroll
                for (int n = 0; n < 2; ++n) acc[a][b][m][n] = (f32x4){0.f, 0.f, 0.f, 0.f};
    bf16x8 At[4][2], B0[2][2], B1[2][2];
    const char* cA = (const char*)g.A + (size_t)cur.pm * tstepA + S.k_off(cur); const char* cB = (const char*)g.Bt + (size_t)cur.pn * tstepB + S.k_off(cur);
    S.a_ready(cur);
    PG8_STAGE(PG8_SB(0, 0), cB, voffB); PG8_STAGE(PG8_SB(0, 1), cB + hstepB, voffB); PG8_STAGE(PG8_SA(0, 0), cA, voffA); PG8_STAGE(PG8_SA(0, 1), cA + hstepA, voffA);
    if (wr == 1) PG8_BAR;
    PG8_WAIT_V(2); PG8_BAR;
    PG8_STAGE(PG8_SB(1, 0), cB + kstep, voffB); PG8_STAGE(PG8_SA(1, 0), cA + kstep, voffA); PG8_STAGE(PG8_SB(1, 1), cB + hstepB + kstep, voffB);
    PG8_WAIT_V(6); PG8_BAR;
    for (;;) {
        const bool has_next = S.next(ui + 1, nxt);
        const char* nA = has_next ? (const char*)g.A + (size_t)nxt.pm * tstepA + S.k_off(nxt) : cA; const char* nB = has_next ? (const char*)g.Bt + (size_t)nxt.pn * tstepB + S.k_off(nxt) : cB;
        for (int t = 0; t < nt; t += 2) {
            const bool last = (t == nt - 2);
            const char* a1 = cA + (size_t)(t + 1) * kstep;
            const char* a2 = last ? nA : cA + (size_t)(t + 2) * kstep; const char* b2 = last ? nB : cB + (size_t)(t + 2) * kstep;
            const char* a3 = a2 + kstep; const char* b3 = b2 + kstep;
            if (last && has_next) S.a_ready(nxt);
            if constexpr (Epi::MID) { if (t == Epi::MID_T0 || t == Epi::MID_T1) E.mid(acc, cur, t, wr, wc, fr, fq); }
            PG8_LDB(B0, 0, 0); PG8_LDB(B1, 0, 1); PG8_SCHED; PG8_LDA(At, 0, 0); PG8_STAGE(PG8_SA(1, 1), a1 + hstepA, voffA);
            PG8_WAIT_V(8); PG8_WAIT_L(0); PG8_BAR; PG8_MMA(0, 0, At, B0); PG8_MMA(0, 1, At, B1); PG8_BAR; PG8_SCHED;
            PG8_LDA(At, 0, 1); PG8_STAGE(PG8_SB(0, 0), b2, voffB); PG8_STAGE(PG8_SB(0, 1), b2 + hstepB, voffB); PG8_STAGE(PG8_SA(0, 0), a2, voffA);
            PG8_WAIT_V(8); PG8_WAIT_L(0); PG8_BAR; PG8_MMA(1, 0, At, B0); PG8_MMA(1, 1, At, B1); PG8_BAR; PG8_SCHED;
            PG8_LDB(B0, 1, 0); PG8_LDB(B1, 1, 1); PG8_SCHED; PG8_LDA(At, 1, 0); PG8_STAGE(PG8_SA(0, 1), a2 + hstepA, voffA);
            PG8_WAIT_V(8); PG8_WAIT_L(0); PG8_BAR; PG8_MMA(0, 0, At, B0); PG8_MMA(0, 1, At, B1); PG8_BAR; PG8_SCHED;
            PG8_LDA(At, 1, 1); PG8_STAGE(PG8_SB(1, 0), b3, voffB); PG8_STAGE(PG8_SB(1, 1), b3 + hstepB, voffB); PG8_STAGE(PG8_SA(1, 0), a3, voffA);
            PG8_WAIT_V(8); PG8_WAIT_L(0); PG8_BAR; PG8_MMA(1, 0, At, B0); PG8_MMA(1, 1, At, B1); PG8_BAR; PG8_SCHED;
        }
        if constexpr (ALIGN_EPI) { if (wr == 0) PG8_BAR; }
        E(acc, cur, wr, wc, fr, fq);
        if (!has_next) break;
        {
#pragma unroll
        for (int a = 0; a < 2; ++a)
#pragma unroll
            for (int b = 0; b < 2; ++b)
#pragma unroll
                for (int m = 0; m < 4; ++m)
#pragma unroll
                    for (int n = 0; n < 2; ++n) acc[a][b][m][n] = (f32x4){0.f, 0.f, 0.f, 0.f};
        }
        cur = nxt; cA = nA; cB = nB; ++ui;
        if constexpr (ALIGN_EPI) { if (wr == 1) PG8_BAR; }
    }
    PG8_WAIT_V(0);
    if constexpr (!ALIGN_EPI) { if (wr == 0) PG8_BAR; }
    PG8_BAR;
#undef PG8_SA
#undef PG8_SB
#undef PG8_STAGE
#undef PG8_LDA
#undef PG8_LDB
#undef PG8_MMA
#undef PG8_WAIT_V
#undef PG8_WAIT_L
#undef PG8_BAR
#undef PG8_SCHED
}
}
constexpr int D = 1024, BATCH = 16, SEQ = 2048, DEPTH = 4, T = BATCH * SEQ;
constexpr int NGRP = 2, TG = T / NGRP, BG = BATCH / NGRP;
constexpr int N_IN = 10264, NP = 10240, NWT = 10496;
constexpr int PC_SQ = 0, PC_SK = 512, PC_SV = 1024, PC_SZ = 1536, PC_DQ = 2048, PC_DZ = 3584, PC_LQ = 4096, PC_LK = 4608, PC_LV = 5120, PC_LZ = 6144, PC_MG = 7168;
constexpr int YC_SB = 0, YC_GDN = 512, YC_GLA = 1024, YW = 2048;
constexpr int NTHREADS = 512, NWAVES = 8;
constexpr float RMS_EPS = 1e-6f, L2_EPS = 1e-6f;

constexpr size_t MiB = 1u << 20;
constexpr size_t WS_CTL = 0, CTL_ZERO_BYTES = 1 * MiB;
constexpr size_t WS_MODP = 2 * MiB;
constexpr size_t WS_MOD = 8 * MiB;
constexpr size_t WS_WIN = 10 * MiB;
constexpr size_t WS_WP = 31 * MiB;
constexpr size_t WS_WO = 35 * MiB;
constexpr size_t WS_H = 40 * MiB;
constexpr size_t WS_MGB = 72 * MiB;
constexpr size_t WS_P = 104 * MiB;
constexpr size_t WS_PS = 424 * MiB;
constexpr size_t WS_Y = 426 * MiB;
constexpr size_t WS_MGF = 490 * MiB;
constexpr size_t WS_END = 640 * MiB;
constexpr size_t WS_GD_WN = 490 * MiB;
constexpr size_t WS_GD_BT = 522 * MiB;
constexpr size_t WS_GD_ST = 554 * MiB;
constexpr size_t WS_GD_QE = 586 * MiB;
constexpr size_t WS_GD_OL = 602 * MiB;
constexpr size_t WS_GD_CD = 618 * MiB;
constexpr int CW_BAR = 4096;

constexpr int RING_BYTES = 131072;
constexpr int MISC_OFF = RING_BYTES + 320;
constexpr int LDS_BYTES = 147456;

typedef unsigned short bf16;
typedef unsigned v4u __attribute__((ext_vector_type(4)));
typedef unsigned v2u __attribute__((ext_vector_type(2)));
typedef float f32x4 __attribute__((ext_vector_type(4)));
#define LDS_WAIT() asm volatile("s_waitcnt lgkmcnt(0)" ::: "memory")

__device__ __forceinline__ float bf2f(unsigned v) { return __uint_as_float(v << 16); }
__device__ __forceinline__ float bflo(unsigned w) { return __uint_as_float(w << 16); }
__device__ __forceinline__ float bfhi(unsigned w) { return __uint_as_float(w & 0xffff0000u); }
typedef __bf16 bf2_t __attribute__((ext_vector_type(2)));
typedef float f2_t __attribute__((ext_vector_type(2)));
__device__ __forceinline__ unsigned f2bf(float f) { return (unsigned)__builtin_bit_cast(unsigned short, (__bf16)f); }
__device__ __forceinline__ unsigned pk2(float lo, float hi) { return __builtin_bit_cast(unsigned, __builtin_convertvector((f2_t){lo, hi}, bf2_t)); }
__device__ __forceinline__ float sigmoidf_(float x) { return __builtin_amdgcn_rcpf(1.f + __expf(-x)); }
__device__ __forceinline__ float siluf_(float x) { return x * __builtin_amdgcn_rcpf(1.f + __expf(-x)); }
__device__ __forceinline__ float softplusf_(float x) { return fmaxf(x, 0.f) + log1pf(expf(-fabsf(x))); }
__device__ __forceinline__ float logsigf_(float x) { return fminf(x, 0.f) - log1pf(expf(-fabsf(x))); }

__device__ __forceinline__ int opq(int v) { asm volatile("" : "+v"(v)); return v; }
struct Args {
    const float* in[20];
    float* out; unsigned char* ws;
    int ph_lo, ph_hi;
};
struct Frame {
    LAS unsigned char* lds;
    int tid, lane, wave, G;
    const float *x, *c, *ada_w, *ada_b, *norm_g, *w_in, *sb_qnorm, *sb_knorm, *gdn_conv, *gdn_a_log, *gdn_dt_bias, *gdn_onorm, *gla_w2, *gla_b, *gla_onorm, *merge_b, *proj_sb, *proj_gdn, *proj_gla, *w_out;
    float* out; unsigned char* wsb;
    float *MODP, *MODA, *MODB, *MODG, *PS, *MGF;
    bf16 *WIN, *WP, *WO, *H, *MGB, *P, *Y, *GQKV;
};

struct EpiG1 {
    static constexpr bool PERM = true, MID = false;
    bf16* P; float* PS; const float* mb;
    __device__ __forceinline__ bool operator()(pg8::f32x4 (&acc)[2][2][4][2], const pg8::Unit& u, int wr, int wc, int fr, int fq) const {
        const int row0 = u.pm * 256 + wr * 64 + fr, pn = u.pn;
        if (pn < 40) {
            const int mode = (pn == 6 || pn == 7 || pn == 14 || pn == 15 || (pn >= 24 && pn < 28)) ? 1 : (pn >= 28 ? 2 : 0);
            const int col0 = pn * 256 + wc * 32 + 8 * fq;
            pg8::f32x4 bv[2][2];
#pragma unroll
            for (int bj = 0; bj < 2; ++bj)
#pragma unroll
                for (int n = 0; n < 2; ++n) bv[bj][n] = (mode == 2) ? *(const pg8::f32x4*)(mb + (col0 - PC_MG) + bj * 128 + 4 * n) : (pg8::f32x4){0.f, 0.f, 0.f, 0.f};
#pragma unroll
            for (int ai = 0; ai < 2; ++ai)
#pragma unroll
                for (int m = 0; m < 4; ++m) { bf16* rowp = P + (size_t)(row0 + ai * 128 + m * 16) * NP + col0;
#pragma unroll
                    for (int bj = 0; bj < 2; ++bj) { pg8::f32x4 v0 = acc[ai][bj][m][0], v1 = acc[ai][bj][m][1];
                        if (mode == 1) {
#pragma unroll
                            for (int j = 0; j < 4; ++j) { v0[j] = siluf_(v0[j]); v1[j] = siluf_(v1[j]); } }
                        else if (mode == 2) { v0 = v0 + bv[bj][0]; v1 = v1 + bv[bj][1];
#pragma unroll
                            for (int j = 0; j < 4; ++j) { v0[j] = sigmoidf_(v0[j]); v1[j] = sigmoidf_(v1[j]); } }
                        pg8::u32x4 w; w.x = pg8::cvt_pk_bf16(v0[0], v0[1]); w.y = pg8::cvt_pk_bf16(v0[2], v0[3]); w.z = pg8::cvt_pk_bf16(v1[0], v1[1]); w.w = pg8::cvt_pk_bf16(v1[2], v1[3]);
                        *(pg8::u32x4*)(rowp + bj * 128) = w; } }
        } else if (wc == 0 && fq < 3) {
#pragma unroll
            for (int ai = 0; ai < 2; ++ai)
#pragma unroll
                for (int m = 0; m < 4; ++m) { float* rowp = PS + (size_t)(row0 + ai * 128 + m * 16) * 32 + 8 * fq;
                    *(pg8::f32x4*)(rowp) = acc[ai][0][m][0]; *(pg8::f32x4*)(rowp + 4) = acc[ai][0][m][1]; }
        }
        return false;
    }
};
struct EpiG2R {
    static constexpr bool PERM = false, MID = true;
    static constexpr int MID_T0 = 8, MID_T1 = 16;
    const bf16* P; bf16* MGB;
    __device__ __forceinline__ void apply(pg8::f32x4 (&acc)[2][2][4][2], const pg8::Unit& u, int which, int wr, int wc, int fr, int fq) const {
        const unsigned row0 = u.pm * 256 + wr * 64 + fr, col0 = u.pn * 256 + wc * 32 + 4 * fq;
        const unsigned gn = (PC_MG + which * D) * 2, gd = (PC_MG + (which + 1) * D) * 2;
        const char* Pb = (const char*)P; char* Mb = (char*)MGB;
#pragma unroll
        for (int ai = 0; ai < 2; ++ai)
#pragma unroll
            for (int m = 0; m < 4; ++m) { const unsigned r = row0 + ai * 128 + m * 16; const unsigned po = (r * NP + col0) * 2u, mo = (r * D + col0) * 2u;
#pragma unroll
                for (int bj = 0; bj < 2; ++bj)
#pragma unroll
                    for (int n = 0; n < 2; ++n) { const unsigned co = (bj * 128 + n * 16) * 2;
                        const pg8::u32x2 gw = *(const pg8::u32x2*)(Pb + (po + gn + co));
                        pg8::f32x4 f; f[0] = bflo(gw.x); f[1] = bfhi(gw.x); f[2] = bflo(gw.y); f[3] = bfhi(gw.y);
                        if (which < 2) { const pg8::u32x2 dw = *(const pg8::u32x2*)(Pb + (po + gd + co));
                            f[0] *= __builtin_amdgcn_rcpf(fmaxf(bflo(dw.x), 1e-30f)); f[1] *= __builtin_amdgcn_rcpf(fmaxf(bfhi(dw.x), 1e-30f));
                            f[2] *= __builtin_amdgcn_rcpf(fmaxf(bflo(dw.y), 1e-30f)); f[3] *= __builtin_amdgcn_rcpf(fmaxf(bfhi(dw.y), 1e-30f)); }
                        const pg8::f32x4 v = acc[ai][bj][m][n] * f;
                        if (which < 2) acc[ai][bj][m][n] = v;
                        else { pg8::u32x2 w; w.x = pg8::cvt_pk_bf16(v[0], v[1]); w.y = pg8::cvt_pk_bf16(v[2], v[3]); *(pg8::u32x2*)(Mb + (mo + co)) = w; }
                        if (n == 1) asm volatile("" ::: "memory"); } }
    }
    __device__ __forceinline__ void mid(pg8::f32x4 (&acc)[2][2][4][2], const pg8::Unit& u, int t, int wr, int wc, int fr, int fq) const { apply(acc, u, t == MID_T0 ? 0 : 1, wr, wc, fr, fq); }
    __device__ __forceinline__ bool operator()(pg8::f32x4 (&acc)[2][2][4][2], const pg8::Unit& u, int wr, int wc, int fr, int fq) const { apply(acc, u, 2, wr, wc, fr, fq); return false; }
};
struct EpiG3 {
    static constexpr bool PERM = false, MID = false;
    const float* xin; float* out; const float* gate; int grow0;
    __device__ __forceinline__ bool operator()(pg8::f32x4 (&acc)[2][2][4][2], const pg8::Unit& u, int wr, int wc, int fr, int fq) const {
        const int row0 = grow0 + u.pm * 256 + wr * 64 + fr, col0 = u.pn * 256 + wc * 32 + 4 * fq;
        const float* gp = gate + (size_t)((grow0 + u.pm * 256) / SEQ) * D;
        pg8::f32x4 gv[2][2];
#pragma unroll
        for (int bj = 0; bj < 2; ++bj)
#pragma unroll
            for (int n = 0; n < 2; ++n) gv[bj][n] = *(const pg8::f32x4*)(gp + col0 + bj * 128 + n * 16);
#pragma unroll
        for (int ai = 0; ai < 2; ++ai)
#pragma unroll
            for (int m = 0; m < 4; ++m) { const size_t off = (size_t)(row0 + ai * 128 + m * 16) * D + col0;
#pragma unroll
                for (int bj = 0; bj < 2; ++bj)
#pragma unroll
                    for (int n = 0; n < 2; ++n) { const pg8::f32x4 xv = *(const pg8::f32x4*)(xin + off + bj * 128 + n * 16);
                        *(pg8::f32x4*)(out + off + bj * 128 + n * 16) = xv + gv[bj][n] * acc[ai][bj][m][n]; } }
        return false;
    }
};

__device__ __forceinline__ void transpose_item(const float* W, int ldw, int col0, bf16* WT, int ldd, int drow0, int dk0, int nblk, LAS float* scr, int item, int lane) {
    const int kb = item / nblk, nb = item % nblk, k0 = 64 * kb, n0 = 32 * nb;
#pragma unroll 8
    for (int i = 0; i < 32; ++i) { const int kk = 2 * i + (lane >> 5); scr[kk * 33 + (lane & 31)] = W[(size_t)(k0 + kk) * ldw + col0 + n0 + (lane & 31)]; }
    LDS_WAIT(); asm volatile("" ::: "memory");
    const int c = lane & 7;
#pragma unroll
    for (int j = 0; j < 4; ++j) { const int n = (lane >> 3) + 8 * j; const LAS float* s = scr + (8 * c) * 33 + n;
        v4u o; o.x = pk2(s[0 * 33], s[1 * 33]); o.y = pk2(s[2 * 33], s[3 * 33]); o.z = pk2(s[4 * 33], s[5 * 33]); o.w = pk2(s[6 * 33], s[7 * 33]);
        *(v4u*)(WT + (size_t)(drow0 + n0 + n) * ldd + dk0 + k0 + 8 * c) = o; }
    LDS_WAIT(); asm volatile("" ::: "memory");
}
__device__ __forceinline__ void p0_ada(Frame& F) {
    LAS float* cact = (LAS float*)F.lds;
    for (int i = F.tid; i < BATCH * D; i += NTHREADS) cact[i] = siluf_(F.c[i]);
    __syncthreads();
    for (int it = blockIdx.x; it < 4 * 8 * 6; it += F.G) {
        const int l = it / 48, ks = (it % 48) / 6, jc = it % 6, j = jc * 512 + F.tid;
        float a[16];
#pragma unroll
        for (int b = 0; b < 16; ++b) a[b] = 0.f;
        const float* wp = F.ada_w + ((size_t)l * D + ks * 128) * 3072 + j;
#pragma unroll 4
        for (int k = 0; k < 128; ++k) { const float w = wp[(size_t)k * 3072];
#pragma unroll
            for (int b = 0; b < 16; ++b) a[b] += cact[b * D + ks * 128 + k] * w; }
#pragma unroll
        for (int b = 0; b < 16; ++b) F.MODP[((size_t)(ks * 4 + l) * 16 + b) * 3072 + j] = a[b];
    }
}
__device__ __forceinline__ void wconv_layer(Frame& F, int l) {
    const int lane = opq(F.lane);
    LAS float* scr = (LAS float*)(F.lds + F.wave * 16384);
    const int gw = blockIdx.x * NWAVES + F.wave, NGW = F.G * NWAVES;
    constexpr int I_A = 16 * 128, I_B = 16 * 96, I_C = 16 * 96, I_SB = 8 * 32, I_GDN = 8 * 32, I_GLA = 16 * 32, I_WO = 16 * 32;
    constexpr int I_L = I_A + I_B + I_C + I_SB + I_GDN + I_GLA + I_WO;
    const float* win = F.w_in + (size_t)l * D * N_IN;
    for (int it = gw; it < I_L; it += NGW) {
        int r = it;
        if (r < I_A) { transpose_item(win, N_IN, 0, F.WIN, D, 0, 0, 128, scr, r, lane); continue; } r -= I_A;
        if (r < I_B) { transpose_item(win, N_IN, 4104, F.WIN, D, 4096, 0, 96, scr, r, lane); continue; } r -= I_B;
        if (r < I_C) { transpose_item(win, N_IN, 7192, F.WIN, D, 7168, 0, 96, scr, r, lane); continue; } r -= I_C;
        if (r < I_SB) { transpose_item(F.proj_sb + (size_t)l * 512 * D, D, 0, F.WP, 2048, 0, 0, 32, scr, r, lane); continue; } r -= I_SB;
        if (r < I_GDN) { transpose_item(F.proj_gdn + (size_t)l * 512 * D, D, 0, F.WP, 2048, 0, 512, 32, scr, r, lane); continue; } r -= I_GDN;
        if (r < I_GLA) { transpose_item(F.proj_gla + (size_t)l * D * D, D, 0, F.WP, 2048, 0, 1024, 32, scr, r, lane); continue; } r -= I_GLA;
        transpose_item(F.w_out + (size_t)l * D * D, D, 0, F.WO, D, 0, 0, 32, scr, r, lane);
    }
    for (int i = blockIdx.x * NTHREADS + opq(F.tid); i < 256 * D; i += F.G * NTHREADS) {
        const int r = i / D, k = i % D;
        float v = 0.f;
        if (r < 8) v = win[(size_t)k * N_IN + 4096 + r];
        else if (r < 24) v = win[(size_t)k * N_IN + 7176 + (r - 8)];
        F.WIN[(size_t)(10240 + r) * D + k] = (bf16)f2bf(v);
    }
    __syncthreads();
}
__device__ __forceinline__ void p1_mod(Frame& F) {
    for (int i = blockIdx.x * NTHREADS + F.tid; i < DEPTH * BATCH * D; i += F.G * NTHREADS) {
        const int l = i / (BATCH * D), b = (i / D) % BATCH, c = i % D;
        float sh = F.ada_b[l * 3072 + c], sc = F.ada_b[l * 3072 + D + c], gt = F.ada_b[l * 3072 + 2 * D + c];
#pragma unroll
        for (int ks = 0; ks < 8; ++ks) { const float* p = F.MODP + ((size_t)(ks * 4 + l) * 16 + b) * 3072; sh += p[c]; sc += p[D + c]; gt += p[2 * D + c]; }
        F.MODA[i] = F.norm_g[l * D + c] * (1.f + sc); F.MODB[i] = sh; F.MODG[i] = gt;
    }
}
__device__ __forceinline__ float wave_sum(float v) {
#pragma unroll
    for (int o = 1; o < 64; o <<= 1) v += __shfl_xor(v, o);
    return v;
}
__device__ __forceinline__ void phase_norm(Frame& F, const float* xin, int l, int g) {
    const int gw = blockIdx.x * NWAVES + F.wave, NGW = F.G * NWAVES, lane = opq(F.lane);
    for (int m = gw; m < TG; m += NGW) {
        const int grow = g * TG + m, b = grow / SEQ;
        const f32x4* xr = (const f32x4*)(xin + (size_t)grow * D) + lane;
        const f32x4* ma = (const f32x4*)(F.MODA + (size_t)(l * BATCH + b) * D) + lane;
        const f32x4* mb = (const f32x4*)(F.MODB + (size_t)(l * BATCH + b) * D) + lane;
        f32x4 v[4]; float s = 0.f;
#pragma unroll
        for (int j = 0; j < 4; ++j) { v[j] = xr[64 * j]; s += (v[j].x * v[j].x + v[j].y * v[j].y) + (v[j].z * v[j].z + v[j].w * v[j].w); }
        const float rstd = 1.f / sqrtf(wave_sum(s) * (1.f / D) + RMS_EPS);
        unsigned long long* o8 = (unsigned long long*)(F.H + (size_t)m * D) + lane;
#pragma unroll
        for (int j = 0; j < 4; ++j) { const f32x4 a = ma[64 * j], sh = mb[64 * j]; const f32x4 y = v[j] * rstd * a + sh;
            o8[64 * j] = (unsigned long long)pk2(y.x, y.y) | ((unsigned long long)pk2(y.z, y.w) << 32); }
    }
}
__device__ __forceinline__ void phase_prep(Frame& F, int l) {
    const int gw = blockIdx.x * NWAVES + F.wave, NGW = F.G * NWAVES, lane = opq(F.lane);
    for (int m = gw; m < TG; m += NGW) {
        {
            bf16* p = F.P + (size_t)m * NP + lane * 16;
            const v4u w0 = *(const v4u*)p, w1 = *(const v4u*)(p + 8);
            float x[16];
            x[0] = bflo(w0.x); x[1] = bfhi(w0.x); x[2] = bflo(w0.y); x[3] = bfhi(w0.y); x[4] = bflo(w0.z); x[5] = bfhi(w0.z); x[6] = bflo(w0.w); x[7] = bfhi(w0.w);
            x[8] = bflo(w1.x); x[9] = bfhi(w1.x); x[10] = bflo(w1.y); x[11] = bfhi(w1.y); x[12] = bflo(w1.z); x[13] = bfhi(w1.z); x[14] = bflo(w1.w); x[15] = bfhi(w1.w);
            float ss = 0.f;
#pragma unroll
            for (int i = 0; i < 16; ++i) ss += x[i] * x[i];
            ss += __shfl_xor(ss, 1); ss += __shfl_xor(ss, 2); ss += __shfl_xor(ss, 4);
            const float r = 1.f / sqrtf(ss * (1.f / 128.f) + RMS_EPS);
            const float* gn = (lane < 32 ? F.sb_qnorm : F.sb_knorm) + l * 128 + (lane & 7) * 16;
#pragma unroll
            for (int i = 0; i < 16; ++i) x[i] = x[i] * r * gn[i];
            v4u o0, o1;
            o0.x = pk2(x[0], x[1]); o0.y = pk2(x[2], x[3]); o0.z = pk2(x[4], x[5]); o0.w = pk2(x[6], x[7]);
            o1.x = pk2(x[8], x[9]); o1.y = pk2(x[10], x[11]); o1.z = pk2(x[12], x[13]); o1.w = pk2(x[14], x[15]);
            *(v4u*)p = o0; *(v4u*)(p + 8) = o1;
        }
    }
}
typedef short bf16x8 __attribute__((ext_vector_type(8)));
__device__ __forceinline__ f32x4 mm16(const LAS bf16* A, int lda, int m0, const LAS bf16* Bt, int ldb, int n0, int K, int lane, f32x4 acc) {
    const LAS bf16* ap = A + (m0 + (lane & 15)) * lda + (lane >> 4) * 8;
    const LAS bf16* bp = Bt + (n0 + (lane & 15)) * ldb + (lane >> 4) * 8;
#pragma unroll
    for (int k0 = 0; k0 < K; k0 += 32) acc = __builtin_amdgcn_mfma_f32_16x16x32_bf16(*(const LAS bf16x8*)(ap + k0), *(const LAS bf16x8*)(bp + k0), acc, 0, 0, 0);
    return acc;
}
__device__ __forceinline__ int swz(int i, int g) { return (((i >> 3) ^ g) << 3) | (i & 7); }
__device__ __forceinline__ f32x4 mm16k64(const LAS bf16* A, int m0, int shA, const LAS bf16* Bt, int n0, int shB, int lane, f32x4 acc) {
    const int ga = shA ? ((m0 >> shA) & 7) : 0, gb = shB ? ((n0 >> shB) & 7) : 0, q = lane >> 4;
    const LAS bf16* ap = A + (m0 + (lane & 15)) * 72; const LAS bf16* bp = Bt + (n0 + (lane & 15)) * 72;
#pragma unroll
    for (int ks = 0; ks < 2; ++ks) acc = __builtin_amdgcn_mfma_f32_16x16x32_bf16(*(const LAS bf16x8*)(ap + (((ks * 4 + q) ^ ga) << 3)), *(const LAS bf16x8*)(bp + (((ks * 4 + q) ^ gb) << 3)), acc, 0, 0, 0);
    return acc;
}
__device__ __forceinline__ v2u pk4(const f32x4 a) { v2u r; r.x = pk2(a[0], a[1]); r.y = pk2(a[2], a[3]); return r; }

constexpr int GP_QS = 0, GP_KN = 17408, GP_AM = 34816, GP_QK = 54272, GP_TM = 63488, GP_VBT = 72704, GP_KBT = 91136, GP_KDT = 109568, GP_SC = 128000;
constexpr int GP_UBT = 17408, GP_WKT = 35840;
__device__ __forceinline__ void conv16(const Frame& F, const bf16* prow, int pos, const float* cw, float (&y)[16]) {
#pragma unroll
    for (int e = 0; e < 16; ++e) y[e] = 0.f;
#pragma unroll
    for (int tap = 0; tap < 4; ++tap) {
        const int dt = tap - 3;
        if (pos + dt >= 0) {
            const v4u w0 = *(const v4u*)(prow + (long)dt * NP), w1 = *(const v4u*)(prow + (long)dt * NP + 8);
            const f32x4 c0 = *(const f32x4*)(cw + tap * 1536), c1 = *(const f32x4*)(cw + tap * 1536 + 4), c2 = *(const f32x4*)(cw + tap * 1536 + 8), c3 = *(const f32x4*)(cw + tap * 1536 + 12);
            y[0] += c0[0] * bflo(w0.x); y[1] += c0[1] * bfhi(w0.x); y[2] += c0[2] * bflo(w0.y); y[3] += c0[3] * bfhi(w0.y);
            y[4] += c1[0] * bflo(w0.z); y[5] += c1[1] * bfhi(w0.z); y[6] += c1[2] * bflo(w0.w); y[7] += c1[3] * bfhi(w0.w);
            y[8] += c2[0] * bflo(w1.x); y[9] += c2[1] * bfhi(w1.x); y[10] += c2[2] * bflo(w1.y); y[11] += c2[3] * bfhi(w1.y);
            y[12] += c3[0] * bflo(w1.z); y[13] += c3[1] * bfhi(w1.z); y[14] += c3[2] * bflo(w1.w); y[15] += c3[3] * bfhi(w1.w);
        }
    }
#pragma unroll
    for (int e = 0; e < 16; ++e) y[e] = siluf_(y[e]);
}
__device__ __forceinline__ void gdn_pre_unit(Frame& F, int l, int unit) {
    const int tid = opq(F.tid), lane = tid & 63, w = __builtin_amdgcn_readfirstlane(tid >> 6);
    const int n = unit & 31, bh = unit >> 5, bl = bh >> 2, h = bh & 3;
    LAS bf16* Qs = (LAS bf16*)(F.lds + GP_QS); LAS bf16* Kn = (LAS bf16*)(F.lds + GP_KN); LAS float* Am = (LAS float*)(F.lds + GP_AM);
    LAS bf16* QKm = (LAS bf16*)(F.lds + GP_QK); LAS bf16* Tm = (LAS bf16*)(F.lds + GP_TM); LAS bf16* VbT = (LAS bf16*)(F.lds + GP_VBT);
    LAS bf16* KbT = (LAS bf16*)(F.lds + GP_KBT); LAS bf16* KdT = (LAS bf16*)(F.lds + GP_KDT); LAS bf16* UbT = (LAS bf16*)(F.lds + GP_UBT); LAS bf16* WkT = (LAS bf16*)(F.lds + GP_WKT);
    LAS float* gamA = (LAS float*)(F.lds + GP_SC); LAS float* betaA = gamA + 64; LAS float* gA = betaA + 64;
    const int row0 = bl * SEQ + n * 64;
    if (tid < 64) {
        const float db = F.PS[(size_t)(row0 + tid) * 32 + h], da = F.PS[(size_t)(row0 + tid) * 32 + 4 + h];
        betaA[tid] = sigmoidf_(db);
        gA[tid] = -expf(F.gdn_a_log[l * 4 + h]) * softplusf_(da + F.gdn_dt_bias[l * 4 + h]);
    }
    __syncthreads();
    const int i = tid >> 3, sub = tid & 7, c16 = sub * 16;
    float gam_i = 0.f, gl = 0.f;
    for (int j = 0; j < 64; ++j) { const float gj = gA[j]; gl += gj; if (j <= i) gam_i += gj; }
    const float beta_i = betaA[i];
    if (sub == 0) gamA[i] = gam_i;
    {
        const int pos = n * 64 + i;
        const bf16* prow = F.P + (size_t)(row0 + i) * NP + PC_DQ + h * 128 + c16;
        const float* cw = F.gdn_conv + (size_t)l * 4 * 1536 + h * 128 + c16;
        float y[16];
        conv16(F, prow, pos, cw, y);
        { float ss = 0.f;
#pragma unroll
          for (int e = 0; e < 16; ++e) ss += y[e] * y[e];
          ss += __shfl_xor(ss, 1); ss += __shfl_xor(ss, 2); ss += __shfl_xor(ss, 4);
          const float r = 0.08838834764831845f / sqrtf(ss + L2_EPS);
          v4u o0, o1; o0.x = pk2(y[0] * r, y[1] * r); o0.y = pk2(y[2] * r, y[3] * r); o0.z = pk2(y[4] * r, y[5] * r); o0.w = pk2(y[6] * r, y[7] * r);
          o1.x = pk2(y[8] * r, y[9] * r); o1.y = pk2(y[10] * r, y[11] * r); o1.z = pk2(y[12] * r, y[13] * r); o1.w = pk2(y[14] * r, y[15] * r);
          *(LAS v4u*)(Qs + i * 136 + c16) = o0; *(LAS v4u*)(Qs + i * 136 + c16 + 8) = o1; }
        conv16(F, prow + 512, pos, cw + 512, y);
        { float ss = 0.f;
#pragma unroll
          for (int e = 0; e < 16; ++e) ss += y[e] * y[e];
          ss += __shfl_xor(ss, 1); ss += __shfl_xor(ss, 2); ss += __shfl_xor(ss, 4);
          const float r = 1.f / sqrtf(ss + L2_EPS);
#pragma unroll
          for (int e = 0; e < 16; ++e) y[e] *= r;
          v4u o0, o1; o0.x = pk2(y[0], y[1]); o0.y = pk2(y[2], y[3]); o0.z = pk2(y[4], y[5]); o0.w = pk2(y[6], y[7]);
          o1.x = pk2(y[8], y[9]); o1.y = pk2(y[10], y[11]); o1.z = pk2(y[12], y[13]); o1.w = pk2(y[14], y[15]);
          *(LAS v4u*)(Kn + i * 136 + c16) = o0; *(LAS v4u*)(Kn + i * 136 + c16 + 8) = o1;
          const float fb = beta_i * __expf(gam_i), fd = __expf(gl - gam_i);
#pragma unroll
          for (int e = 0; e < 16; ++e) { KbT[(c16 + e) * 72 + swz(i, sub)] = (bf16)f2bf(y[e] * fb); KdT[(c16 + e) * 72 + swz(i, sub)] = (bf16)f2bf(y[e] * fd); } }
        conv16(F, prow + 1024, pos, cw + 1024, y);
#pragma unroll
        for (int e = 0; e < 16; ++e) VbT[(c16 + e) * 72 + swz(i, sub)] = (bf16)f2bf(y[e] * beta_i);
    }
    __syncthreads();
#pragma unroll
    for (int t = 0; t < 2; ++t) {
        const int idx = 2 * w + t, mb = idx >> 2, nb = idx & 3;
        const f32x4 z4 = {0.f, 0.f, 0.f, 0.f};
        const f32x4 akk = mm16(Kn, 136, mb * 16, Kn, 136, nb * 16, 128, lane, z4);
        const f32x4 aqk = mm16(Qs, 136, mb * 16, Kn, 136, nb * 16, 128, lane, z4);
        const int j = nb * 16 + (lane & 15); const float gj = gamA[j];
#pragma unroll
        for (int e = 0; e < 4; ++e) { const int ii = mb * 16 + 4 * (lane >> 4) + e; const float dc = __expf(fminf(gamA[ii] - gj, 0.f));
            Am[ii * 68 + j] = (ii > j) ? betaA[ii] * akk[e] * dc : 0.f;
            QKm[ii * 72 + j] = (bf16)f2bf((ii >= j) ? aqk[e] * dc : 0.f); }
    }
    __syncthreads();
    if (w == 0) {
        float Tc[64];
#pragma clang loop unroll(full)
        for (int ii = 0; ii < 64; ++ii) {
            float s = (ii == lane) ? 1.f : 0.f;
#pragma clang loop unroll(full)
            for (int j = 0; j < ii; ++j) s -= Am[ii * 68 + j] * Tc[j];
            Tc[ii] = s;
            Tm[ii * 72 + lane] = (bf16)f2bf(s);
        }
    }
    __syncthreads();
    {
        const int q = lane >> 4, c = lane & 15, mb = w & 3;
        const LAS bf16* Bsrc = (w >> 2) ? KbT : VbT; LAS bf16* dst = (w >> 2) ? WkT : UbT;
        bf16x8 af[2];
#pragma unroll
        for (int ks = 0; ks < 2; ++ks) af[ks] = *(const LAS bf16x8*)(Tm + (16 * mb + c) * 72 + (ks * 4 + q) * 8);
#pragma unroll
        for (int nb = 0; nb < 8; ++nb) {
            f32x4 a = {0.f, 0.f, 0.f, 0.f};
#pragma unroll
            for (int ks = 0; ks < 2; ++ks) a = __builtin_amdgcn_mfma_f32_16x16x32_bf16(af[ks], *(const LAS bf16x8*)(Bsrc + (16 * nb + c) * 72 + (((ks * 4 + q) ^ nb) << 3)), a, 0, 0, 0);
            *(LAS v2u*)(dst + (nb * 16 + c) * 72 + mb * 16 + 4 * q) = pk4(a);
        }
    }
    __syncthreads();
    bf16* gWN = (bf16*)(F.wsb + WS_GD_WN) + (size_t)unit * 16384; bf16* gBT = (bf16*)(F.wsb + WS_GD_BT) + (size_t)unit * 16384;
    bf16* gQE = (bf16*)(F.wsb + WS_GD_QE) + (size_t)unit * 8192; bf16* gOL = (bf16*)(F.wsb + WS_GD_OL) + (size_t)unit * 8192;
    if (tid == 0) ((float*)(F.wsb + WS_GD_CD))[unit] = __expf(gl);
    {
        const int q = lane >> 4, c = lane & 15, q4 = 4 * q, mq = w >> 1;
        bf16x8 aW[2], aK[2], aQ[2];
#pragma unroll
        for (int ks = 0; ks < 2; ++ks) { aW[ks] = *(const LAS bf16x8*)(WkT + (16 * w + c) * 72 + (ks * 4 + q) * 8);
            aK[ks] = *(const LAS bf16x8*)(KdT + (16 * w + c) * 72 + (((ks * 4 + q) ^ w) << 3));
            aQ[ks] = *(const LAS bf16x8*)(QKm + (16 * mq + c) * 72 + (ks * 4 + q) * 8); }
#pragma unroll
        for (int nb = 0; nb < 8; ++nb) {
            bf16x8 bk[2], bu[2];
#pragma unroll
            for (int ks = 0; ks < 2; ++ks) { bk[ks] = *(const LAS bf16x8*)(KdT + (16 * nb + c) * 72 + (((ks * 4 + q) ^ nb) << 3)); bu[ks] = *(const LAS bf16x8*)(UbT + (16 * nb + c) * 72 + (ks * 4 + q) * 8); }
            f32x4 a = {0.f, 0.f, 0.f, 0.f}, b2 = {0.f, 0.f, 0.f, 0.f};
#pragma unroll
            for (int ks = 0; ks < 2; ++ks) { a = __builtin_amdgcn_mfma_f32_16x16x32_bf16(aW[ks], bk[ks], a, 0, 0, 0); b2 = __builtin_amdgcn_mfma_f32_16x16x32_bf16(aK[ks], bu[ks], b2, 0, 0, 0); }
            a = -a;
            *(v2u*)(gWN + (nb * 16 + c) * 128 + 16 * w + q4) = pk4(a);
            *(v2u*)(gBT + (nb * 16 + c) * 128 + 16 * w + q4) = pk4(b2);
            if ((nb >> 2) == (w & 1)) {
                f32x4 o = {0.f, 0.f, 0.f, 0.f};
#pragma unroll
                for (int ks = 0; ks < 2; ++ks) o = __builtin_amdgcn_mfma_f32_16x16x32_bf16(aQ[ks], bu[ks], o, 0, 0, 0);
                *(v2u*)(gOL + (nb * 16 + c) * 64 + 16 * mq + q4) = pk4(o);
            }
        }
#pragma unroll
        for (int nb = 0; nb < 4; ++nb) {
            f32x4 a = {0.f, 0.f, 0.f, 0.f};
#pragma unroll
            for (int ks = 0; ks < 2; ++ks) a = __builtin_amdgcn_mfma_f32_16x16x32_bf16(aW[ks], *(const LAS bf16x8*)(QKm + (16 * nb + c) * 72 + (ks * 4 + q) * 8), a, 0, 0, 0);
            const int ii = nb * 16 + c, d0 = 16 * w + q4; const float eg = __expf(gamA[ii]);
            const v2u qw = *(const LAS v2u*)(Qs + ii * 136 + d0);
            f32x4 r; r[0] = bflo(qw.x) * eg - a[0]; r[1] = bfhi(qw.x) * eg - a[1]; r[2] = bflo(qw.y) * eg - a[2]; r[3] = bfhi(qw.y) * eg - a[3];
            *(v2u*)(gQE + ii * 128 + d0) = pk4(r);
        }
    }
    __syncthreads();
}
__device__ __forceinline__ void gdn_chain(Frame& F, int bh) {
    const int tid = opq(F.tid), lane = tid & 63, w = __builtin_amdgcn_readfirstlane(tid >> 6);
    LAS bf16* Wl = (LAS bf16*)F.lds;
    LAS bf16* Sw = (LAS bf16*)(F.lds + 2 * 34816) + w * (16 * 136);
    const bf16* gWN = (const bf16*)(F.wsb + WS_GD_WN) + (size_t)bh * 32 * 16384;
    const bf16* gBT = (const bf16*)(F.wsb + WS_GD_BT) + (size_t)bh * 32 * 16384;
    bf16* gST = (bf16*)(F.wsb + WS_GD_ST) + (size_t)bh * 32 * 16384;
    const float* gCD = (const float*)(F.wsb + WS_GD_CD) + bh * 32;
    f32x4 acc[8];
#pragma unroll
    for (int mb = 0; mb < 8; ++mb) acc[mb] = (f32x4){0.f, 0.f, 0.f, 0.f};
    const int c = lane & 15, q4 = 4 * (lane >> 4);
    v4u wreg[4]; v2u breg[8]; float cd;
#pragma unroll
    for (int k = 0; k < 4; ++k) { const int p = tid + 512 * k; wreg[k] = *(const v4u*)(gWN + (size_t)(p >> 4) * 128 + (p & 15) * 8); }
#pragma unroll
    for (int mb = 0; mb < 8; ++mb) breg[mb] = *(const v2u*)(gBT + (16 * w + c) * 128 + mb * 16 + q4);
    cd = gCD[0];
#pragma unroll
    for (int k = 0; k < 4; ++k) { const int p = tid + 512 * k; *(LAS v4u*)(Wl + (p >> 4) * 136 + (p & 15) * 8) = wreg[k]; }
    for (int n = 0; n < 32; ++n) {
        LAS bf16* Wc = Wl + (n & 1) * (128 * 136); LAS bf16* Wn = Wl + ((n + 1) & 1) * (128 * 136);
#pragma unroll
        for (int mb = 0; mb < 8; ++mb) { const v2u pk = pk4(acc[mb]);
            *(LAS v2u*)(Sw + c * 136 + mb * 16 + q4) = pk;
            *(v2u*)(gST + (size_t)n * 16384 + (16 * w + c) * 128 + mb * 16 + q4) = pk; }
        __syncthreads();
        v2u bcur[8]; const float cdc = cd;
#pragma unroll
        for (int mb = 0; mb < 8; ++mb) bcur[mb] = breg[mb];
        if (n + 1 < 32) {
#pragma unroll
            for (int k = 0; k < 4; ++k) { const int p = tid + 512 * k; wreg[k] = *(const v4u*)(gWN + (size_t)(n + 1) * 16384 + (size_t)(p >> 4) * 128 + (p & 15) * 8); }
#pragma unroll
            for (int mb = 0; mb < 8; ++mb) breg[mb] = *(const v2u*)(gBT + (size_t)(n + 1) * 16384 + (16 * w + c) * 128 + mb * 16 + q4);
            cd = gCD[n + 1];
        }
#pragma unroll
        for (int mb = 0; mb < 8; ++mb) {
            f32x4 a = acc[mb] * cdc; a[0] += bflo(bcur[mb].x); a[1] += bfhi(bcur[mb].x); a[2] += bflo(bcur[mb].y); a[3] += bfhi(bcur[mb].y);
            acc[mb] = mm16(Wc, 136, mb * 16, Sw, 136, 0, 128, lane, a);
        }
        if (n + 1 < 32) {
#pragma unroll
            for (int k = 0; k < 4; ++k) { const int p = tid + 512 * k; *(LAS v4u*)(Wn + (p >> 4) * 136 + (p & 15) * 8) = wreg[k]; } }
    }
    __syncthreads();
}
__device__ __forceinline__ void gdn_post_unit(Frame& F, int l, int unit) {
    const int tid = opq(F.tid), lane = tid & 63, w = __builtin_amdgcn_readfirstlane(tid >> 6);
    const int n = unit & 31, bh = unit >> 5, bl = bh >> 2, h = bh & 3;
    LAS bf16* QEl = (LAS bf16*)F.lds;
    LAS bf16* STl = (LAS bf16*)(F.lds + 17408);
    LAS float* Of = (LAS float*)(F.lds + 52224);
    const bf16* gQE = (const bf16*)(F.wsb + WS_GD_QE) + (size_t)unit * 8192; const bf16* gST = (const bf16*)(F.wsb + WS_GD_ST) + (size_t)unit * 16384;
    const bf16* gOL = (const bf16*)(F.wsb + WS_GD_OL) + (size_t)unit * 8192;
#pragma unroll
    for (int k = 0; k < 2; ++k) { const int p = tid + 512 * k; *(LAS v4u*)(QEl + (p >> 4) * 136 + (p & 15) * 8) = *(const v4u*)(gQE + (size_t)(p >> 4) * 128 + (p & 15) * 8); }
#pragma unroll
    for (int k = 0; k < 4; ++k) { const int p = tid + 512 * k; *(LAS v4u*)(STl + (p >> 4) * 136 + (p & 15) * 8) = *(const v4u*)(gST + (size_t)(p >> 4) * 128 + (p & 15) * 8); }
    __syncthreads();
    const int c = lane & 15, q4 = 4 * (lane >> 4);
#pragma unroll
    for (int t = 0; t < 4; ++t) {
        const int mb = w >> 1, nb = (w & 1) * 4 + t, dv = nb * 16 + c, i0 = mb * 16 + q4;
        const v2u ow = *(const v2u*)(gOL + dv * 64 + i0);
        f32x4 a; a[0] = bflo(ow.x); a[1] = bfhi(ow.x); a[2] = bflo(ow.y); a[3] = bfhi(ow.y);
        a = mm16(QEl, 136, mb * 16, STl, 136, nb * 16, 128, lane, a);
#pragma unroll
        for (int e = 0; e < 4; ++e) Of[(i0 + e) * 132 + dv] = a[e];
    }
    __syncthreads();
    {
        const int i = tid >> 3, sub = tid & 7, c16 = sub * 16; const size_t row = (size_t)bl * SEQ + n * 64 + i;
        float x[16]; float ss = 0.f;
#pragma unroll
        for (int e = 0; e < 16; ++e) { x[e] = Of[i * 132 + c16 + e]; ss += x[e] * x[e]; }
        ss += __shfl_xor(ss, 1); ss += __shfl_xor(ss, 2); ss += __shfl_xor(ss, 4);
        const float r = 1.f / sqrtf(ss * (1.f / 128.f) + RMS_EPS);
        const float* gn = F.gdn_onorm + l * 128 + c16;
        const v4u z0 = *(const v4u*)(F.P + row * NP + PC_DZ + h * 128 + c16), z1 = *(const v4u*)(F.P + row * NP + PC_DZ + h * 128 + c16 + 8);
        const float zg[16] = {bflo(z0.x), bfhi(z0.x), bflo(z0.y), bfhi(z0.y), bflo(z0.z), bfhi(z0.z), bflo(z0.w), bfhi(z0.w), bflo(z1.x), bfhi(z1.x), bflo(z1.y), bfhi(z1.y), bflo(z1.z), bfhi(z1.z), bflo(z1.w), bfhi(z1.w)};
#pragma unroll
        for (int e = 0; e < 16; ++e) x[e] = x[e] * r * gn[e] * zg[e];
        v4u o0, o1; o0.x = pk2(x[0], x[1]); o0.y = pk2(x[2], x[3]); o0.z = pk2(x[4], x[5]); o0.w = pk2(x[6], x[7]);
        o1.x = pk2(x[8], x[9]); o1.y = pk2(x[10], x[11]); o1.z = pk2(x[12], x[13]); o1.w = pk2(x[14], x[15]);
        bf16* yp = F.Y + row * YW + YC_GDN + h * 128 + c16;
        *(v4u*)yp = o0; *(v4u*)(yp + 8) = o1;
    }
    __syncthreads();
}
constexpr size_t WS_GL_BS = 40 * MiB;
constexpr size_t WS_GL_AN = 619 * MiB;
constexpr int GL_LA = 0, GL_QD = 33792, GL_KT = 51200, GL_ATT = 68608, GL_VT = 77824, GL_LR = 114688, GL_GL = 118784;
__device__ __forceinline__ void gla_gam(Frame& F, int l, int h, int row0, int tid) {
    LAS float* laL = (LAS float*)(F.lds + GL_LA); LAS float* lrL = (LAS float*)(F.lds + GL_LR); LAS float* glL = (LAS float*)(F.lds + GL_GL); LAS float* totL = glL + 256;
#pragma unroll
    for (int k = 0; k < 2; ++k) { const int p = tid + 512 * k; lrL[p] = F.PS[(size_t)(row0 + (p >> 4)) * 32 + 8 + (p & 15)]; }
    const int d = tid & 127, ig = tid >> 7;
    float w2r[16]; const float bb = F.gla_b[l * 512 + h * 128 + d];
#pragma unroll
    for (int r = 0; r < 16; ++r) w2r[r] = F.gla_w2[((size_t)l * 16 + r) * 512 + h * 128 + d];
    __syncthreads();
    float la[16]; float run = 0.f;
#pragma unroll
    for (int ii = 0; ii < 16; ++ii) { const int i = ig * 16 + ii; float x = bb;
#pragma unroll
        for (int r = 0; r < 16; ++r) x += lrL[i * 16 + r] * w2r[r];
        run += (fminf(x, 0.f) - __logf(1.f + __expf(-fabsf(x)))) * (1.f / 16.f); la[ii] = run; }
    totL[ig * 128 + d] = run;
    __syncthreads();
    const float t0 = totL[d], t1 = totL[128 + d], t2 = totL[256 + d], t3 = totL[384 + d];
    const float off = (ig > 0 ? t0 : 0.f) + (ig > 1 ? t1 : 0.f) + (ig > 2 ? t2 : 0.f);
#pragma unroll
    for (int ii = 0; ii < 16; ++ii) laL[(ig * 16 + ii) * 132 + d] = la[ii] + off;
    if (ig == 0) glL[d] = (t0 + t1) + (t2 + t3);
    __syncthreads();
}
__device__ __forceinline__ void gla_pre_unit(Frame& F, int l, int unit) {
    const int tid = opq(F.tid), lane = tid & 63, w = __builtin_amdgcn_readfirstlane(tid >> 6);
    const int n = unit & 31, bh = unit >> 5, bl = bh >> 2, h = bh & 3, row0 = bl * SEQ + n * 64;
    LAS float* laL = (LAS float*)(F.lds + GL_LA); LAS float* glL = (LAS float*)(F.lds + GL_GL);
    LAS bf16* KdT = (LAS bf16*)(F.lds + GL_QD);
    LAS bf16* VT = (LAS bf16*)(F.lds + GL_VT);
    gla_gam(F, l, h, row0, tid);
    {
        const int i = tid >> 3, sub = tid & 7;
        const bf16* kp = F.P + (size_t)(row0 + i) * NP + PC_LK + h * 128 + sub * 16;
        const v4u k0 = *(const v4u*)kp, k1 = *(const v4u*)(kp + 8);
        const float kk[16] = {bflo(k0.x), bfhi(k0.x), bflo(k0.y), bfhi(k0.y), bflo(k0.z), bfhi(k0.z), bflo(k0.w), bfhi(k0.w), bflo(k1.x), bfhi(k1.x), bflo(k1.y), bfhi(k1.y), bflo(k1.z), bfhi(k1.z), bflo(k1.w), bfhi(k1.w)};
#pragma unroll
        for (int e = 0; e < 16; ++e) { const int d = sub * 16 + e; KdT[d * 72 + swz(i, sub)] = (bf16)f2bf(kk[e] * __expf(glL[d] - laL[i * 132 + d])); }
        const bf16* vp = F.P + (size_t)(row0 + i) * NP + PC_LV + h * 256 + sub * 32;
#pragma unroll
        for (int k = 0; k < 4; ++k) { const v4u vw = *(const v4u*)(vp + 8 * k); const int dv = sub * 32 + 8 * k;
            const int si = swz(i, sub);
            VT[(dv + 0) * 72 + si] = (bf16)(vw.x & 0xffff); VT[(dv + 1) * 72 + si] = (bf16)(vw.x >> 16); VT[(dv + 2) * 72 + si] = (bf16)(vw.y & 0xffff); VT[(dv + 3) * 72 + si] = (bf16)(vw.y >> 16);
            VT[(dv + 4) * 72 + si] = (bf16)(vw.z & 0xffff); VT[(dv + 5) * 72 + si] = (bf16)(vw.z >> 16); VT[(dv + 6) * 72 + si] = (bf16)(vw.w & 0xffff); VT[(dv + 7) * 72 + si] = (bf16)(vw.w >> 16); }
        if (tid < 128) ((float*)(F.wsb + WS_GL_AN))[(size_t)unit * 128 + tid] = __expf(glL[tid]);
    }
    __syncthreads();
    bf16* gBS = (bf16*)(F.wsb + WS_GL_BS) + (size_t)unit * 32768;
    const int c = lane & 15, q4 = 4 * (lane >> 4);
    {
        const int q = lane >> 4;
        bf16x8 af[2];
#pragma unroll
        for (int ks = 0; ks < 2; ++ks) af[ks] = *(const LAS bf16x8*)(KdT + (16 * w + c) * 72 + (((ks * 4 + q) ^ w) << 3));
#pragma unroll
        for (int nb = 0; nb < 16; ++nb) {
            f32x4 a = {0.f, 0.f, 0.f, 0.f};
#pragma unroll
            for (int ks = 0; ks < 2; ++ks) a = __builtin_amdgcn_mfma_f32_16x16x32_bf16(af[ks], *(const LAS bf16x8*)(VT + (16 * nb + c) * 72 + (((ks * 4 + q) ^ (nb >> 1)) << 3)), a, 0, 0, 0);
            *(v2u*)(gBS + (nb * 16 + c) * 128 + 16 * w + q4) = pk4(a);
        }
    }
    __syncthreads();
}
__device__ __forceinline__ void gla_scan(Frame& F, int bidx, int nblk) {
    const int tid = opq(F.tid);
    for (int item = bidx * NTHREADS + tid; item < BG * 4 * 4096; item += nblk * NTHREADS) {
        const int bh = item >> 12, rem = item & 4095, dv = rem >> 4, d8 = (rem & 15) * 8;
        bf16* base = (bf16*)(F.wsb + WS_GL_BS) + (size_t)bh * 32 * 32768 + dv * 128 + d8;
        const float* an = (const float*)(F.wsb + WS_GL_AN) + (size_t)bh * 32 * 128 + d8;
        float s[8];
#pragma unroll
        for (int e = 0; e < 8; ++e) s[e] = 0.f;
#pragma unroll 4
        for (int n = 0; n < 32; ++n) {
            const v4u bw = *(const v4u*)(base + (size_t)n * 32768);
            const f32x4 a0 = *(const f32x4*)(an + n * 128), a1 = *(const f32x4*)(an + n * 128 + 4);
            if (n >= 1) { v4u o; o.x = pk2(s[0], s[1]); o.y = pk2(s[2], s[3]); o.z = pk2(s[4], s[5]); o.w = pk2(s[6], s[7]); *(v4u*)(base + (size_t)(n - 1) * 32768) = o; }
            s[0] = a0[0] * s[0] + bflo(bw.x); s[1] = a0[1] * s[1] + bfhi(bw.x); s[2] = a0[2] * s[2] + bflo(bw.y); s[3] = a0[3] * s[3] + bfhi(bw.y);
            s[4] = a1[0] * s[4] + bflo(bw.z); s[5] = a1[1] * s[5] + bfhi(bw.z); s[6] = a1[2] * s[6] + bflo(bw.w); s[7] = a1[3] * s[7] + bfhi(bw.w);
        }
    }
}
__device__ __forceinline__ void gla_post_unit(Frame& F, int l, int unit) {
    const int tid = opq(F.tid), lane = tid & 63, w = __builtin_amdgcn_readfirstlane(tid >> 6);
    const int n = unit & 31, bh = unit >> 5, bl = bh >> 2, h = bh & 3, row0 = bl * SEQ + n * 64;
    LAS float* laL = (LAS float*)(F.lds + GL_LA);
    LAS bf16* QdL = (LAS bf16*)(F.lds + GL_QD); LAS bf16* KtL = (LAS bf16*)(F.lds + GL_KT); LAS bf16* AttL = (LAS bf16*)(F.lds + GL_ATT); LAS bf16* VT = (LAS bf16*)(F.lds + GL_VT);
    LAS float* Of = (LAS float*)F.lds;
    gla_gam(F, l, h, row0, tid);
    {
        const int i = tid >> 3, sub = tid & 7;
        const bf16* qp = F.P + (size_t)(row0 + i) * NP + PC_LQ + h * 128 + sub * 16;
        const v4u q0 = *(const v4u*)qp, q1 = *(const v4u*)(qp + 8), k0 = *(const v4u*)(qp + 512), k1 = *(const v4u*)(qp + 520);
        const float qq[16] = {bflo(q0.x), bfhi(q0.x), bflo(q0.y), bfhi(q0.y), bflo(q0.z), bfhi(q0.z), bflo(q0.w), bfhi(q0.w), bflo(q1.x), bfhi(q1.x), bflo(q1.y), bfhi(q1.y), bflo(q1.z), bfhi(q1.z), bflo(q1.w), bfhi(q1.w)};
        const float kk[16] = {bflo(k0.x), bfhi(k0.x), bflo(k0.y), bfhi(k0.y), bflo(k0.z), bfhi(k0.z), bflo(k0.w), bfhi(k0.w), bflo(k1.x), bfhi(k1.x), bflo(k1.y), bfhi(k1.y), bflo(k1.z), bfhi(k1.z), bflo(k1.w), bfhi(k1.w)};
        float qd[16], kt[16];
#pragma unroll
        for (int e = 0; e < 16; ++e) { const float gm = laL[i * 132 + sub * 16 + e]; qd[e] = qq[e] * 0.08838834764831845f * __expf(gm); kt[e] = kk[e] * __expf(-gm); }
        v4u o0, o1; o0.x = pk2(qd[0], qd[1]); o0.y = pk2(qd[2], qd[3]); o0.z = pk2(qd[4], qd[5]); o0.w = pk2(qd[6], qd[7]);
        o1.x = pk2(qd[8], qd[9]); o1.y = pk2(qd[10], qd[11]); o1.z = pk2(qd[12], qd[13]); o1.w = pk2(qd[14], qd[15]);
        *(LAS v4u*)(QdL + i * 136 + sub * 16) = o0; *(LAS v4u*)(QdL + i * 136 + sub * 16 + 8) = o1;
        o0.x = pk2(kt[0], kt[1]); o0.y = pk2(kt[2], kt[3]); o0.z = pk2(kt[4], kt[5]); o0.w = pk2(kt[6], kt[7]);
        o1.x = pk2(kt[8], kt[9]); o1.y = pk2(kt[10], kt[11]); o1.z = pk2(kt[12], kt[13]); o1.w = pk2(kt[14], kt[15]);
        *(LAS v4u*)(KtL + i * 136 + sub * 16) = o0; *(LAS v4u*)(KtL + i * 136 + sub * 16 + 8) = o1;
        const bf16* vp = F.P + (size_t)(row0 + i) * NP + PC_LV + h * 256 + sub * 32;
#pragma unroll
        for (int k = 0; k < 4; ++k) { const v4u vw = *(const v4u*)(vp + 8 * k); const int dv = sub * 32 + 8 * k;
            const int si = swz(i, sub);
            VT[(dv + 0) * 72 + si] = (bf16)(vw.x & 0xffff); VT[(dv + 1) * 72 + si] = (bf16)(vw.x >> 16); VT[(dv + 2) * 72 + si] = (bf16)(vw.y & 0xffff); VT[(dv + 3) * 72 + si] = (bf16)(vw.y >> 16);
            VT[(dv + 4) * 72 + si] = (bf16)(vw.z & 0xffff); VT[(dv + 5) * 72 + si] = (bf16)(vw.z >> 16); VT[(dv + 6) * 72 + si] = (bf16)(vw.w & 0xffff); VT[(dv + 7) * 72 + si] = (bf16)(vw.w >> 16); }
    }
    __syncthreads();
    const int c = lane & 15, q4 = 4 * (lane >> 4);
#pragma unroll
    for (int t = 0; t < 2; ++t) {
        const int idx = 2 * w + t, mb = idx >> 2, nb = idx & 3;
        const f32x4 z4 = {0.f, 0.f, 0.f, 0.f};
        const f32x4 a = mm16(QdL, 136, mb * 16, KtL, 136, nb * 16, 128, lane, z4);
        const int j = nb * 16 + c;
#pragma unroll
        for (int e = 0; e < 4; ++e) { const int ii = mb * 16 + q4 + e; AttL[ii * 72 + j] = (bf16)f2bf((ii >= j) ? a[e] : 0.f); }
    }
    __syncthreads();
    f32x4 acc[2][4];
    const bf16* gS = (const bf16*)(F.wsb + WS_GL_BS) + (size_t)(unit - 1) * 32768;
#pragma unroll
    for (int t = 0; t < 2; ++t) {
        const int nb = 2 * w + t;
        bf16x8 bfr[4];
#pragma unroll
        for (int ks = 0; ks < 4; ++ks) { if (n >= 1) bfr[ks] = *(const bf16x8*)(gS + (size_t)(nb * 16 + c) * 128 + ks * 32 + 8 * (lane >> 4)); else bfr[ks] = (bf16x8){0, 0, 0, 0, 0, 0, 0, 0}; }
#pragma unroll
        for (int mb = 0; mb < 4; ++mb) {
            f32x4 a = {0.f, 0.f, 0.f, 0.f};
#pragma unroll
            for (int ks = 0; ks < 4; ++ks) a = __builtin_amdgcn_mfma_f32_16x16x32_bf16(*(const LAS bf16x8*)(QdL + (mb * 16 + c) * 136 + ks * 32 + 8 * (lane >> 4)), bfr[ks], a, 0, 0, 0);
            acc[t][mb] = mm16k64(AttL, mb * 16, 0, VT, nb * 16, 5, lane, a);
        }
    }
    __syncthreads();
#pragma unroll
    for (int t = 0; t < 2; ++t)
#pragma unroll
        for (int mb = 0; mb < 4; ++mb)
#pragma unroll
            for (int e = 0; e < 4; ++e) Of[(mb * 16 + q4 + e) * 260 + (2 * w + t) * 16 + c] = acc[t][mb][e];
    __syncthreads();
    {
        const int i = tid >> 3, sub = tid & 7, c32 = sub * 32; const size_t row = (size_t)row0 + i;
        float x[32]; float ss = 0.f;
#pragma unroll
        for (int e = 0; e < 32; ++e) { x[e] = Of[i * 260 + c32 + e]; ss += x[e] * x[e]; }
        ss += __shfl_xor(ss, 1); ss += __shfl_xor(ss, 2); ss += __shfl_xor(ss, 4);
        const float r = 1.f / sqrtf(ss * (1.f / 256.f) + RMS_EPS);
        const float* gn = F.gla_onorm + l * 256 + c32;
        const bf16* zp = F.P + row * NP + PC_LZ + h * 256 + c32; bf16* yp = F.Y + row * YW + YC_GLA + h * 256 + c32;
#pragma unroll
        for (int k = 0; k < 4; ++k) { const v4u zw = *(const v4u*)(zp + 8 * k);
            const float zg[8] = {bflo(zw.x), bfhi(zw.x), bflo(zw.y), bfhi(zw.y), bflo(zw.z), bfhi(zw.z), bflo(zw.w), bfhi(zw.w)};
            float y[8];
#pragma unroll
            for (int e = 0; e < 8; ++e) y[e] = x[8 * k + e] * r * gn[8 * k + e] * zg[e];
            v4u o; o.x = pk2(y[0], y[1]); o.y = pk2(y[2], y[3]); o.z = pk2(y[4], y[5]); o.w = pk2(y[6], y[7]);
            *(v4u*)(yp + 8 * k) = o; }
    }
    __syncthreads();
}
constexpr int SB_QS = 0, SB_KS = 34816, SB_VT = 52224, SB_FL = 70656;
__device__ __forceinline__ void sb_unit(Frame& F, int unit) {
    const int tid = opq(F.tid), lane = tid & 63, w = __builtin_amdgcn_readfirstlane(tid >> 6);
    const int qt = ((unit >> 8) & 1) ? (unit & 15) : 15 - (unit & 15), bh = unit >> 4, bl = bh >> 2, h = bh & 3;
    LAS bf16* Qs = (LAS bf16*)(F.lds + SB_QS); LAS bf16* Ks = (LAS bf16*)(F.lds + SB_KS); LAS bf16* Vt = (LAS bf16*)(F.lds + SB_VT);
    volatile LAS unsigned* flags = (volatile LAS unsigned*)(F.lds + SB_FL);
    const size_t rowb = (size_t)bl * SEQ;
    const int c = lane & 15, q = lane >> 4, q4 = 4 * q;
#pragma unroll
    for (int k = 0; k < 4; ++k) { const int p = tid + 512 * k; *(LAS v4u*)(Qs + (p >> 4) * 136 + (p & 15) * 8) = *(const v4u*)(F.P + (rowb + qt * 128 + (p >> 4)) * NP + PC_SQ + h * 128 + (p & 15) * 8); }
    f32x4 o[8];
#pragma unroll
    for (int mb = 0; mb < 8; ++mb) o[mb] = (f32x4){0.f, 0.f, 0.f, 0.f};
    float R = 0.f;
    const int t = qt * 128 + 16 * w + c;
    for (int kb = 2 * qt + 1; kb >= 0; --kb) {
        {
            const int key = tid >> 3, sub = tid & 7;
            const bf16* kp = F.P + (rowb + kb * 64 + key) * NP + PC_SK + h * 128 + sub * 16;
            const v4u k0 = *(const v4u*)kp, k1 = *(const v4u*)(kp + 8), v0 = *(const v4u*)(kp + 512), v1 = *(const v4u*)(kp + 520);
            *(LAS v4u*)(Ks + key * 136 + sub * 16) = k0; *(LAS v4u*)(Ks + key * 136 + sub * 16 + 8) = k1;
            const int d0 = sub * 16, sk = swz(key, sub);
            Vt[(d0 + 0) * 72 + sk] = (bf16)(v0.x & 0xffff); Vt[(d0 + 1) * 72 + sk] = (bf16)(v0.x >> 16); Vt[(d0 + 2) * 72 + sk] = (bf16)(v0.y & 0xffff); Vt[(d0 + 3) * 72 + sk] = (bf16)(v0.y >> 16);
            Vt[(d0 + 4) * 72 + sk] = (bf16)(v0.z & 0xffff); Vt[(d0 + 5) * 72 + sk] = (bf16)(v0.z >> 16); Vt[(d0 + 6) * 72 + sk] = (bf16)(v0.w & 0xffff); Vt[(d0 + 7) * 72 + sk] = (bf16)(v0.w >> 16);
            Vt[(d0 + 8) * 72 + sk] = (bf16)(v1.x & 0xffff); Vt[(d0 + 9) * 72 + sk] = (bf16)(v1.x >> 16); Vt[(d0 + 10) * 72 + sk] = (bf16)(v1.y & 0xffff); Vt[(d0 + 11) * 72 + sk] = (bf16)(v1.y >> 16);
            Vt[(d0 + 12) * 72 + sk] = (bf16)(v1.z & 0xffff); Vt[(d0 + 13) * 72 + sk] = (bf16)(v1.z >> 16); Vt[(d0 + 14) * 72 + sk] = (bf16)(v1.w & 0xffff); Vt[(d0 + 15) * 72 + sk] = (bf16)(v1.w >> 16);
        }
        __syncthreads();
        const bool active = (kb * 64 < qt * 128 + 16 * w + 15);
        if (active) {
            float wgt[4][4], l1m[4][4], tot[4], hi[4];
#pragma unroll
            for (int kk = 0; kk < 4; ++kk) {
                const f32x4 z4 = {0.f, 0.f, 0.f, 0.f};
                const f32x4 a = mm16(Ks, 136, kk * 16, Qs, 136, 16 * w, 128, lane, z4);
                float g = 0.f;
#pragma unroll
                for (int e = 0; e < 4; ++e) {
                    const int s = kb * 64 + kk * 16 + q4 + e; const bool valid = s < t;
                    const float z = a[e] * 0.08838834764831845f;
                    const float sp = fmaxf(z, 0.f) + __logf(1.f + __expf(-fabsf(z)));
                    l1m[kk][e] = valid ? -sp : 0.f;
                    wgt[kk][e] = valid ? (z - sp) : -1e30f;
                    g += l1m[kk][e];
                }
                const float b = __shfl_xor(g, 16), pr = g + b, d = __shfl_xor(pr, 32);
                hi[kk] = ((q & 1) == 0 ? b : 0.f) + ((q & 2) == 0 ? d : 0.f);
                tot[kk] = pr + d;
            }
            float after = R;
#pragma unroll
            for (int kk = 3; kk >= 0; --kk) {
                float tail = after + hi[kk];
#pragma unroll
                for (int e = 3; e >= 0; --e) { const float lw = wgt[kk][e] + tail; wgt[kk][e] = __expf(lw); tail += l1m[kk][e]; }
                after += tot[kk];
            }
            R = after;
#pragma unroll
            for (int ks = 0; ks < 2; ++ks) {
                v4u pb; pb.x = pk2(wgt[2 * ks][0], wgt[2 * ks][1]); pb.y = pk2(wgt[2 * ks][2], wgt[2 * ks][3]); pb.z = pk2(wgt[2 * ks + 1][0], wgt[2 * ks + 1][1]); pb.w = pk2(wgt[2 * ks + 1][2], wgt[2 * ks + 1][3]);
                const bf16x8 bfrag = __builtin_bit_cast(bf16x8, pb);
#pragma unroll
                for (int mb = 0; mb < 8; ++mb) {
                    const LAS bf16* vp = Vt + (mb * 16 + c) * 72 + 4 * (q & 1);
                    const v2u lo = *(const LAS v2u*)(vp + (((4 * ks + (q >> 1)) ^ mb) << 3)), hi2 = *(const LAS v2u*)(vp + (((4 * ks + 2 + (q >> 1)) ^ mb) << 3));
                    v4u av; av.x = lo.x; av.y = lo.y; av.z = hi2.x; av.w = hi2.y;
                    o[mb] = __builtin_amdgcn_mfma_f32_16x16x32_bf16(__builtin_bit_cast(bf16x8, av), bfrag, o[mb], 0, 0, 0);
                }
            }
        }
        const bool done = __all(R < -104.f || !active) && active;
        if (lane == 0) flags[w] = done ? 1u : 0u;
        __syncthreads();
        unsigned alldone = 1u;
#pragma unroll
        for (int k = 0; k < 8; ++k) alldone &= flags[k];
        if (alldone) break;
    }
    {
        const size_t row = rowb + qt * 128 + 16 * w + c;
#pragma unroll
        for (int mb = 0; mb < 8; ++mb) {
            const int d = mb * 16 + q4;
            const v2u zw = *(const v2u*)(F.P + row * NP + PC_SZ + h * 128 + d);
            v2u ow; ow.x = pk2(o[mb][0] * bflo(zw.x), o[mb][1] * bfhi(zw.x)); ow.y = pk2(o[mb][2] * bflo(zw.y), o[mb][3] * bfhi(zw.y));
            *(v2u*)(F.Y + row * YW + YC_SB + h * 128 + d) = ow;
        }
    }
    __syncthreads();
}
__global__ void __launch_bounds__(NTHREADS, 2) fwd_kernel(Args args) {
    extern __shared__ __attribute__((aligned(16))) unsigned char lds_raw[];
    Frame F;
    F.lds = (LAS unsigned char*)lds_raw;
    volatile LAS unsigned* MISC = (volatile LAS unsigned*)(F.lds + MISC_OFF);
    F.tid = threadIdx.x; F.lane = F.tid & 63; F.wave = __builtin_amdgcn_readfirstlane(F.tid >> 6); F.G = gridDim.x;
    unsigned char* ws = args.ws;
    F.x = args.in[0]; F.c = args.in[1]; F.ada_w = args.in[2]; F.ada_b = args.in[3]; F.norm_g = args.in[4]; F.w_in = args.in[5]; F.sb_qnorm = args.in[6]; F.sb_knorm = args.in[7];
    F.gdn_conv = args.in[8]; F.gdn_a_log = args.in[9]; F.gdn_dt_bias = args.in[10]; F.gdn_onorm = args.in[11]; F.gla_w2 = args.in[12]; F.gla_b = args.in[13]; F.gla_onorm = args.in[14];
    F.merge_b = args.in[15]; F.proj_sb = args.in[16]; F.proj_gdn = args.in[17]; F.proj_gla = args.in[18]; F.w_out = args.in[19];
    F.out = args.out; F.wsb = ws;
    F.MODP = (float*)(ws + WS_MODP); F.MODA = (float*)(ws + WS_MOD); F.MODB = F.MODA + DEPTH * BATCH * D; F.MODG = F.MODB + DEPTH * BATCH * D;
    F.PS = (float*)(ws + WS_PS); F.MGF = (float*)(ws + WS_MGF);
    F.WIN = (bf16*)(ws + WS_WIN); F.WP = (bf16*)(ws + WS_WP); F.WO = (bf16*)(ws + WS_WO); F.H = (bf16*)(ws + WS_H); F.MGB = (bf16*)(ws + WS_MGB);
    F.P = (bf16*)(ws + WS_P); F.Y = (bf16*)(ws + WS_Y); F.GQKV = (bf16*)(ws + WS_H);
    for (int u = F.tid; u < 32; u += NTHREADS) MISC[u] = 0u;
    __syncthreads();
    XcdBarrier bar = xcd_barrier_post((unsigned*)(ws + WS_CTL) + CW_BAR, MISC + 8);
#define GRID_BAR() do { XcdBarrier b2_ = bar; asm volatile("" : "+s"(b2_.x)); xcd_barrier(b2_); } while (0)

    p0_ada(F);
    GRID_BAR();
    p1_mod(F);
    GRID_BAR();
    for (int l = 0; l < DEPTH; ++l) {
        const float* xin = (l == 0) ? F.x : F.out;
        for (int g = 0; g < NGRP; ++g) {
            if (g == 0) wconv_layer(F, l);
            phase_norm(F, xin, l, g);
            GRID_BAR();
#define PH_G1() do { pg8::Gemm gm{F.H, F.WIN, D, D, D}; pg8::StaticOrder S; S.init(TG, NWT, F.G, (int)blockIdx.x); \
                EpiG1 E{F.P, F.PS, F.merge_b + l * 3072}; \
                pg8::gemm_phase<EpiG1, pg8::StaticOrder, true>(F.lds, gm, S, E); GRID_BAR(); } while (0)
            PH_G1();
#ifdef PROBE_G1
            PH_G1();
#endif
            phase_prep(F, l);
#define PH_PRE() do { for (int u = blockIdx.x; u < BG * 4 * 32; u += F.G) gdn_pre_unit(F, l, u); \
                for (int u = blockIdx.x; u < BG * 4 * 32; u += F.G) gla_pre_unit(F, l, u); GRID_BAR(); } while (0)
            PH_PRE();
#ifdef PROBE_PRE
            PH_PRE();
#endif
#ifdef PROBE_GDNPRE
            for (int u = blockIdx.x; u < BG * 4 * 32; u += F.G) gdn_pre_unit(F, l, u); GRID_BAR();
#endif
#ifdef PROBE_GLAPRE
            for (int u = blockIdx.x; u < BG * 4 * 32; u += F.G) gla_pre_unit(F, l, u); GRID_BAR();
#endif
#define PH_MIX() do { const int bx = blockIdx.x; if (bx < 32) gdn_chain(F, bx); else { for (int u = bx - 32; u < BG * 4 * 16; u += F.G - 32) sb_unit(F, u); gla_scan(F, bx - 32, F.G - 32); } GRID_BAR(); } while (0)
#ifdef PROBE_CHAIN
            if (blockIdx.x < 32) gdn_chain(F, blockIdx.x); GRID_BAR();
#endif
#ifdef PROBE_SB
            if (blockIdx.x >= 32) { for (int u = blockIdx.x - 32; u < BG * 4 * 16; u += F.G - 32) sb_unit(F, u); } GRID_BAR();
#endif
            PH_MIX();
#define PH_POST() do { for (int u = blockIdx.x; u < BG * 4 * 32; u += F.G) gdn_post_unit(F, l, u); \
                for (int u = blockIdx.x; u < BG * 4 * 32; u += F.G) gla_post_unit(F, l, u); GRID_BAR(); } while (0)
            PH_POST();
#ifdef PROBE_GDNPOST
            for (int u = blockIdx.x; u < BG * 4 * 32; u += F.G) gdn_post_unit(F, l, u); GRID_BAR();
#endif
#ifdef PROBE_GLAPOST
            for (int u = blockIdx.x; u < BG * 4 * 32; u += F.G) gla_post_unit(F, l, u); GRID_BAR();
#endif
#define PH_G2() do { pg8::StaticOrder S; S.init(TG, D, F.G, (int)blockIdx.x); \
                pg8::Gemm gm{F.Y, F.WP, YW, 2048, 2048}; EpiG2R E{F.P, F.MGB}; \
                pg8::gemm_phase<EpiG2R, pg8::StaticOrder, false>(F.lds, gm, S, E); GRID_BAR(); } while (0)
            PH_G2();
#ifdef PROBE_G2
            PH_G2();
#endif
#ifndef NO_G3
            {   pg8::Gemm gm{F.MGB, F.WO, D, D, D}; pg8::StaticOrder S; S.init(TG, D, F.G, (int)blockIdx.x);
                EpiG3 E{xin, F.out, F.MODG + (size_t)l * BATCH * D, g * TG};
                pg8::gemm_phase<EpiG3, pg8::StaticOrder, false>(F.lds, gm, S, E); }
#endif
            GRID_BAR();
        }
    }
}

extern "C" void kernel_launch(void* const* d_in, const int* in_sizes, int n_in, void* d_out, int out_size, void* d_ws, size_t ws_size, hipStream_t stream) {
    static int grid = 0;
    if (grid == 0) {
        if (n_in != 20 || out_size != T * D || ws_size < WS_END) { fprintf(stderr, "kernel_launch: unexpected shapes / workspace (%d inputs, out %d, ws %zu)\n", n_in, out_size, ws_size); grid = -1; return; }
        int dev = 0, cus = 0, per_cu = 0;
        if (hipGetDevice(&dev) != hipSuccess || hipDeviceGetAttribute(&cus, hipDeviceAttributeMultiprocessorCount, dev) != hipSuccess) { grid = -1; return; }
        if (hipFuncSetAttribute((const void*)fwd_kernel, hipFuncAttributeMaxDynamicSharedMemorySize, LDS_BYTES) != hipSuccess) { grid = -1; return; }
        if (hipOccupancyMaxActiveBlocksPerMultiprocessor(&per_cu, (const void*)fwd_kernel, NTHREADS, LDS_BYTES) != hipSuccess || per_cu < 1) fprintf(stderr, "kernel_launch: occupancy query reports %d\n", per_cu);
        (void)hipGetLastError();
        grid = cus;
    }
    if (grid < 0) return;
    if (hipMemsetAsync((char*)d_ws + WS_CTL, 0, CTL_ZERO_BYTES, stream) != hipSuccess) return;
    Args a{};
    for (int i = 0; i < 20; ++i) a.in[i] = (const float*)d_in[i];
    a.out = (float*)d_out; a.ws = (unsigned char*)d_ws; a.ph_lo = 0; a.ph_hi = 0;
    hipLaunchKernelGGL(fwd_kernel, dim3(grid), dim3(NTHREADS), LDS_BYTES, stream, a);
}
```

```cpp
#include <hip/hip_runtime.h>
#include <cstdio>
#include <cstdint>

#define GAS __attribute__((address_space(1)))
#define LAS __attribute__((address_space(3)))

#define XB_TMO      128
#define XB_XCNT(j)  (256  + 64 * (j))
#define XB_XSUB(j)  (1280 + 64 * (j))
#define XB_XGEN(j)  (2304 + 64 * (j))
#define XB_TOP      3328
#define XB_TOPGEN   3392
#define XCD_BAR_WORDS 3456
#define XB_SPIN_CAP (1u << 24)

__device__ __forceinline__ unsigned xb_ld(unsigned* p)              { return __hip_atomic_load(p, __ATOMIC_RELAXED, __HIP_MEMORY_SCOPE_AGENT); }
__device__ __forceinline__ unsigned xb_add(unsigned* p, unsigned v) { return __hip_atomic_fetch_add(p, v, __ATOMIC_RELAXED, __HIP_MEMORY_SCOPE_AGENT); }
__device__ __forceinline__ unsigned xb_xcc_id() { return (unsigned)__builtin_amdgcn_s_getreg((3 << 11) | 20) & 0xFu; }
#define XB_SPIN(cond, bar) do { unsigned _sp = 0; while (cond) { __builtin_amdgcn_s_sleep(1); \
    if ((++_sp & 255u) == 0u) { if (xb_ld(&(bar)[XB_TMO])) break; if (_sp > XB_SPIN_CAP) { atomicAdd(&(bar)[XB_TMO], 1u); break; } } } } while (0)

struct XcdBarrier { unsigned* bar; unsigned x; volatile LAS unsigned* st; };

__device__ __forceinline__ XcdBarrier xcd_barrier_post(unsigned* bar, volatile LAS unsigned* st) {
    XcdBarrier b; b.bar = bar; b.x = xb_xcc_id(); b.st = st;
    if (threadIdx.x == 0) (void)xb_add(&bar[XB_XCNT(b.x)], 1u);
    return b;
}
__device__ __forceinline__ void xcd_barrier_complete(unsigned* bar, unsigned x, unsigned& nloc, unsigned& nx) {
    const unsigned G = gridDim.x * gridDim.y * gridDim.z;
    unsigned sum, cnt, mine, sp = 0u;
    for (;;) {
        sum = 0u; cnt = 0u; mine = 0u;
#pragma unroll
        for (unsigned j = 0; j < 16; ++j) { const unsigned c = xb_ld(&bar[XB_XCNT(j)]); sum += c; cnt += (c > 0u) ? 1u : 0u; mine = (j == x) ? c : mine; }
        if (sum == G) break;
        __builtin_amdgcn_s_sleep(1);
        if ((++sp & 255u) == 0u) { if (xb_ld(&bar[XB_TMO])) break; if (sp > XB_SPIN_CAP) { atomicAdd(&bar[XB_TMO], 1u); break; } }
    }
    nloc = mine > 0u ? mine : 1u; nx = cnt > 0u ? cnt : 1u;
}
__device__ __forceinline__ void xcd_barrier(const XcdBarrier& b) {
    asm volatile("s_waitcnt vmcnt(0)" ::: "memory");
    __syncthreads();
    if (threadIdx.x == 0) {
        unsigned* bar = b.bar;
        __builtin_amdgcn_s_waitcnt(0);
        unsigned nloc = b.st[0], nx = b.st[1];
        if (nloc == 0u) { xcd_barrier_complete(bar, b.x, nloc, nx); b.st[0] = nloc; b.st[1] = nx; }
        const unsigned old = xb_add(&bar[XB_XSUB(b.x)], 1u);
        const unsigned gen = old / nloc;
        if (old + 1u == (gen + 1u) * nloc) {
            __builtin_amdgcn_fence(__ATOMIC_RELEASE, "agent");
            asm volatile("s_waitcnt vmcnt(0)" ::: "memory");
            const unsigned og = xb_add(&bar[XB_TOP], 1u);
            const unsigned tg = og / nx;
            if (og + 1u == (tg + 1u) * nx) xb_add(&bar[XB_TOPGEN], 1u);
            else XB_SPIN(xb_ld(&bar[XB_TOPGEN]) == tg, bar);
            __builtin_amdgcn_fence(__ATOMIC_ACQUIRE, "agent");
            xb_add(&bar[XB_XGEN(b.x)], 1u);
            asm volatile("s_waitcnt vmcnt(0)" ::: "memory");
        } else {
            XB_SPIN(xb_ld(&bar[XB_XGEN(b.x)]) == gen, bar);
            __builtin_amdgcn_fence(__ATOMIC_ACQUIRE, "agent");
            asm volatile("s_waitcnt vmcnt(0)" ::: "memory");
        }
    }
    __syncthreads();
}
namespace pg8 {
#define PG8_LAS __attribute__((address_space(3)))
typedef unsigned short bf16_t;
typedef short bf16x8 __attribute__((ext_vector_type(8)));
typedef float f32x4 __attribute__((ext_vector_type(4)));
typedef unsigned u32x4 __attribute__((ext_vector_type(4)));
typedef unsigned u32x2 __attribute__((ext_vector_type(2)));
constexpr int BM = 256, BK = 64, HALF = 128, HTB = HALF * BK * 2, STAGE_BYTES = 8 * HTB, NXCD = 8, WGM = 8;

__host__ __device__ __forceinline__ int lds_byte(int r, int c) { const int st = (r >> 4) * 2 + (c >> 5), rr = r & 15, cc = c & 31, ob = rr * 64 + cc * 2; return st * 1024 + (ob ^ (((ob >> 9) & 1) << 5)); }
__host__ __device__ __forceinline__ void stage_rc(int b, int& R, int& C) { const int st = b / 1024, sb = b % 1024, swz = sb ^ (((sb >> 9) & 1) << 5); R = (st >> 1) * 16 + swz / 64; C = (st & 1) * 32 + (swz % 64) / 2; }
__host__ __device__ __forceinline__ int perm32(int rho) { const int n = rho >> 4, i = rho & 15; return 8 * (i >> 2) + 4 * n + (i & 3); }

struct Unit { int pm, pn, seg; };
struct Gemm { const bf16_t* A; const bf16_t* Bt; int lda, ldb, K; };

struct StaticOrder {
    int nM, nN, nwg, G, c;
    __host__ __device__ void init(int M, int N, int G_, int c_) { nM = M / BM; nN = N / BM; nwg = nM * nN; G = G_; c = c_; }
    __host__ __device__ bool next(int i, Unit& u) const {
        const long L = (long)i * G + c; if (L >= nwg) return false;
        int wgid = (int)L; { const int q = nwg / NXCD, r = nwg % NXCD, xcd = wgid % NXCD, off = wgid / NXCD; wgid = (xcd < r ? xcd * (q + 1) : r * (q + 1) + (xcd - r) * q) + off; }
        const int nig = WGM * nN, gid = wgid / nig, fm = gid * WGM, gsz = (nM - fm) < WGM ? (nM - fm) : WGM;
        u.pm = fm + ((wgid % nig) % gsz); u.pn = (wgid % nig) / gsz; u.seg = 0; return true;
    }
    __device__ __forceinline__ size_t k_off(const Unit&) const { return 0; }
    __device__ __forceinline__ void a_ready(const Unit&) const {}
    __device__ __forceinline__ void done(const Unit&) const {}
};

template <int NSEG> struct SegOrder : StaticOrder {
    int segk;
    __host__ __device__ bool next(int i, Unit& u) const { if (!StaticOrder::next(i / NSEG, u)) return false; u.seg = i % NSEG; return true; }
    __device__ __forceinline__ size_t k_off(const Unit& u) const { return (size_t)u.seg * segk * 2; }
};
__device__ __forceinline__ unsigned cvt_pk_bf16(float lo, float hi) { unsigned r; asm volatile("v_cvt_pk_bf16_f32 %0, %1, %2" : "=v"(r) : "v"(lo), "v"(hi)); return r; }

template <class Epi, class Sched, bool ALIGN_EPI>
__device__ __forceinline__ void gemm_phase(PG8_LAS unsigned char* lds, const Gemm g, const Sched& S, const Epi& E) {
    int tid = threadIdx.x; asm volatile("" : "+v"(tid));
    const int wid = __builtin_amdgcn_readfirstlane(tid >> 6), lane = tid & 63, wr = wid >> 2, wc = wid & 3, fr = lane & 15, fq = lane >> 4;
    const int K = g.K, nt = K / BK;
    unsigned voffA[2], voffB[2];
#pragma unroll
    for (int i = 0; i < 2; ++i) { int R, C; stage_rc(tid * 16 + i * 8192, R, C); const int Rb = Epi::PERM ? ((R & ~31) + perm32(R & 31)) : R;
        voffA[i] = (unsigned)(R * g.lda + C) * 2u; voffB[i] = (unsigned)(Rb * g.ldb + C) * 2u; }
    const size_t kstep = (size_t)(BK * 2);
    const size_t hstepA = (size_t)HALF * g.lda * 2, hstepB = (size_t)HALF * g.ldb * 2;
    const size_t tstepA = 2 * hstepA, tstepB = 2 * hstepB;
    const unsigned ldsw = (unsigned)wid * 1024u;
    const int aoff = lds_byte(wr * 64 + fr, fq * 8), boff = lds_byte(wc * 32 + fr, fq * 8);
#define PG8_SA(b, h) (((b) * 2 + (h)) * HTB)
#define PG8_SB(b, h) ((4 + (b) * 2 + (h)) * HTB)
#define PG8_STAGE(bufoff, gbase, voff) do { _Pragma("unroll") for (int _i = 0; _i < 2; ++_i) \
        __builtin_amdgcn_global_load_lds((const unsigned*)((const char*)(gbase) + (voff)[_i]), (PG8_LAS unsigned*)(lds + (bufoff) + ldsw + _i * 8192), 16, 0, 0); } while (0)
#define PG8_LDA(dst, b, h) do { _Pragma("unroll") for (int m = 0; m < 4; ++m) _Pragma("unroll") for (int k = 0; k < 2; ++k) dst[m][k] = *(const PG8_LAS bf16x8*)(lds + PG8_SA(b, h) + aoff + m * 2048 + k * 1024); } while (0)
#define PG8_LDB(dst, b, h) do { _Pragma("unroll") for (int n = 0; n < 2; ++n) _Pragma("unroll") for (int k = 0; k < 2; ++k) dst[n][k] = *(const PG8_LAS bf16x8*)(lds + PG8_SB(b, h) + boff + n * 2048 + k * 1024); } while (0)
#define PG8_MMA(ai, bj, At, Bt) do { __builtin_amdgcn_s_setprio(1); _Pragma("unroll") for (int m = 0; m < 4; ++m) _Pragma("unroll") for (int n = 0; n < 2; ++n) _Pragma("unroll") for (int k = 0; k < 2; ++k) \
        acc[ai][bj][m][n] = __builtin_amdgcn_mfma_f32_16x16x32_bf16(Bt[n][k], At[m][k], acc[ai][bj][m][n], 0, 0, 0); __builtin_amdgcn_s_setprio(0); } while (0)
#define PG8_WAIT_V(n) asm volatile("s_waitcnt vmcnt(" #n ")" ::: "memory")
#define PG8_WAIT_L(n) asm volatile("s_waitcnt lgkmcnt(" #n ")" ::: "memory")
#define PG8_BAR __builtin_amdgcn_s_barrier()
#define PG8_SCHED __builtin_amdgcn_sched_barrier(0)
    Unit cur, nxt; int ui = 0;
    if (!S.next(0, cur)) return;
    f32x4 acc[2][2][4][2];
#pragma unroll
    for (int a = 0; a < 2; ++a)
#pragma unroll
        for (int b = 0; b < 2; ++b)
#pragma unroll
            for (int m = 0; m < 4; ++m)
#pragma unroll
                for (int n = 0; n < 2; ++n) acc[a][b][m][n] = (f32x4){0.f, 0.f, 0.f, 0.f};
    bf16x8 At[4][2], B0[2][2], B1[2][2];
    const char* cA = (const char*)g.A + (size_t)cur.pm * tstepA + S.k_off(cur); const char* cB = (const char*)g.Bt + (size_t)cur.pn * tstepB + S.k_off(cur);
    S.a_ready(cur);
    PG8_STAGE(PG8_SB(0, 0), cB, voffB); PG8_STAGE(PG8_SB(0, 1), cB + hstepB, voffB); PG8_STAGE(PG8_SA(0, 0), cA, voffA); PG8_STAGE(PG8_SA(0, 1), cA + hstepA, voffA);
    if (wr == 1) PG8_BAR;
    PG8_WAIT_V(2); PG8_BAR;
    PG8_STAGE(PG8_SB(1, 0), cB + kstep, voffB); PG8_STAGE(PG8_SA(1, 0), cA + kstep, voffA); PG8_STAGE(PG8_SB(1, 1), cB + hstepB + kstep, voffB);
    PG8_WAIT_V(6); PG8_BAR;
    for (;;) {
        const bool has_next = S.next(ui + 1, nxt);
        const char* nA = has_next ? (const char*)g.A + (size_t)nxt.pm * tstepA + S.k_off(nxt) : cA; const char* nB = has_next ? (const char*)g.Bt + (size_t)nxt.pn * tstepB + S.k_off(nxt) : cB;
        for (int t = 0; t < nt; t += 2) {
            const bool last = (t == nt - 2);
            const char* a1 = cA + (size_t)(t + 1) * kstep;
            const char* a2 = last ? nA : cA + (size_t)(t + 2) * kstep; const char* b2 = last ? nB : cB + (size_t)(t + 2) * kstep;
            const char* a3 = a2 + kstep; const char* b3 = b2 + kstep;
            if (last && has_next) S.a_ready(nxt);
            if constexpr (Epi::MID) { if (t == Epi::MID_T0 || t == Epi::MID_T1) E.mid(acc, cur, t, wr, wc, fr, fq); }
            PG8_LDB(B0, 0, 0); PG8_LDB(B1, 0, 1); PG8_SCHED; PG8_LDA(At, 0, 0); PG8_STAGE(PG8_SA(1, 1), a1 + hstepA, voffA);
            PG8_WAIT_V(8); PG8_WAIT_L(0); PG8_BAR; PG8_MMA(0, 0, At, B0); PG8_MMA(0, 1, At, B1); PG8_BAR; PG8_SCHED;
            PG8_LDA(At, 0, 1); PG8_STAGE(PG8_SB(0, 0), b2, voffB); PG8_STAGE(PG8_SB(0, 1), b2 + hstepB, voffB); PG8_STAGE(PG8_SA(0, 0), a2, voffA);
            PG8_WAIT_V(8); PG8_WAIT_L(0); PG8_BAR; PG8_MMA(1, 0, At, B0); PG8_MMA(1, 1, At, B1); PG8_BAR; PG8_SCHED;
            PG8_LDB(B0, 1, 0); PG8_LDB(B1, 1, 1); PG8_SCHED; PG8_LDA(At, 1, 0); PG8_STAGE(PG8_SA(0, 1), a2 + hstepA, voffA);
            PG8_WAIT_V(8); PG8_WAIT_L(0); PG8_BAR; PG8_MMA(0, 0, At, B0); PG8_MMA(0, 1, At, B1); PG8_BAR; PG8_SCHED;
            PG8_LDA(At, 1, 1); PG8_STAGE(PG8_SB(1, 0), b3, voffB); PG8_STAGE(PG8_SB(1, 1), b3 + hstepB, voffB); PG8_STAGE(PG8_SA(1, 0), a3, voffA);
            PG8_WAIT_V(8); PG8_WAIT_L(0); PG8_BAR; PG8_MMA(1, 0, At, B0); PG8_MMA(1, 1, At, B1); PG8_BAR; PG8_SCHED;
        }
        if constexpr (ALIGN_EPI) { if (wr == 0) PG8_BAR; }
        E(acc, cur, wr, wc, fr, fq);
        if (!has_next) break;
        {
#pragma unroll
        for (int a = 0; a < 2; ++a)
#pragma unroll
            for (int b = 0; b < 2; ++b)
#pragma unroll
                for (int m = 0; m < 4; ++m)
#pragma unroll
                    for (int n = 0; n < 2; ++n) acc[a][b][m][n] = (f32x4){0.f, 0.f, 0.f, 0.f};
        }
        cur = nxt; cA = nA; cB = nB; ++ui;
        if constexpr (ALIGN_EPI) { if (wr == 1) PG8_BAR; }
    }
    PG8_WAIT_V(0);
    if constexpr (!ALIGN_EPI) { if (wr == 0) PG8_BAR; }
    PG8_BAR;
#undef PG8_SA
#undef PG8_SB
#undef PG8_STAGE
#undef PG8_LDA
#undef PG8_LDB
#undef PG8_MMA
#undef PG8_WAIT_V
#undef PG8_WAIT_L
#undef PG8_BAR
#undef PG8_SCHED
}
}
constexpr int D = 1024, BATCH = 16, SEQ = 2048, DEPTH = 4, T = BATCH * SEQ;
constexpr int NGRP = 2, TG = T / NGRP, BG = BATCH / NGRP;
constexpr int N_IN = 10264, NP = 10240, NWT = 10496;
constexpr int PC_SQ = 0, PC_SK = 512, PC_SV = 1024, PC_SZ = 1536, PC_DQ = 2048, PC_DZ = 3584, PC_LQ = 4096, PC_LK = 4608, PC_LV = 5120, PC_LZ = 6144, PC_MG = 7168;
constexpr int YC_SB = 0, YC_GDN = 512, YC_GLA = 1024, YW = 2048;
constexpr int NTHREADS = 512, NWAVES = 8;
constexpr float RMS_EPS = 1e-6f, L2_EPS = 1e-6f;

constexpr size_t MiB = 1u << 20;
constexpr size_t WS_CTL = 0, CTL_ZERO_BYTES = 1 * MiB;
constexpr size_t WS_MODP = 2 * MiB;
constexpr size_t WS_MOD = 8 * MiB;
constexpr size_t WS_WIN = 10 * MiB;
constexpr size_t WS_WP = 31 * MiB;
constexpr size_t WS_WO = 35 * MiB;
constexpr size_t WS_H = 40 * MiB;
constexpr size_t WS_MGB = 72 * MiB;
constexpr size_t WS_P = 104 * MiB;
constexpr size_t WS_PS = 424 * MiB;
constexpr size_t WS_Y = 426 * MiB;
constexpr size_t WS_END = 640 * MiB;
constexpr size_t WS_GD_WN = 490 * MiB;
constexpr size_t WS_GD_BT = 522 * MiB;
constexpr size_t WS_GD_ST = 554 * MiB;
constexpr size_t WS_GD_QE = 586 * MiB;
constexpr size_t WS_GD_OL = 602 * MiB;
constexpr size_t WS_GD_CD = 618 * MiB;
constexpr int CW_BAR = 4096;

constexpr int RING_BYTES = 131072;
constexpr int MISC_OFF = RING_BYTES + 320;
constexpr int LDS_BYTES = 147456;

typedef unsigned short bf16;
typedef unsigned v4u __attribute__((ext_vector_type(4)));
typedef unsigned v2u __attribute__((ext_vector_type(2)));
typedef float f32x4 __attribute__((ext_vector_type(4)));
#define LDS_WAIT() asm volatile("s_waitcnt lgkmcnt(0)" ::: "memory")
#define WG_SYNC() do { asm volatile("s_waitcnt lgkmcnt(0)" ::: "memory"); __builtin_amdgcn_s_barrier(); asm volatile("" ::: "memory"); } while (0)

__device__ __forceinline__ float bf2f(unsigned v) { return __uint_as_float(v << 16); }
__device__ __forceinline__ float bflo(unsigned w) { return __uint_as_float(w << 16); }
__device__ __forceinline__ float bfhi(unsigned w) { return __uint_as_float(w & 0xffff0000u); }
typedef __bf16 bf2_t __attribute__((ext_vector_type(2)));
typedef float f2_t __attribute__((ext_vector_type(2)));
__device__ __forceinline__ unsigned f2bf(float f) { return (unsigned)__builtin_bit_cast(unsigned short, (__bf16)f); }
__device__ __forceinline__ unsigned pk2(float lo, float hi) { return __builtin_bit_cast(unsigned, __builtin_convertvector((f2_t){lo, hi}, bf2_t)); }
__device__ __forceinline__ float sigmoidf_(float x) { return __builtin_amdgcn_rcpf(1.f + __expf(-x)); }
__device__ __forceinline__ float siluf_(float x) { return x * __builtin_amdgcn_rcpf(1.f + __expf(-x)); }
__device__ __forceinline__ float softplusf_(float x) { return fmaxf(x, 0.f) + log1pf(expf(-fabsf(x))); }
__device__ __forceinline__ float logsigf_(float x) { return fminf(x, 0.f) - log1pf(expf(-fabsf(x))); }

__device__ __forceinline__ int opq(int v) { asm volatile("" : "+v"(v)); return v; }
struct Args {
    const float* in[20];
    float* out; unsigned char* ws;
    int ph_lo, ph_hi;
};
struct Frame {
    LAS unsigned char* lds;
    int tid, lane, wave, G, lyr;
    const float *x, *c, *ada_w, *ada_b, *norm_g, *w_in, *sb_qnorm, *sb_knorm, *gdn_conv, *gdn_a_log, *gdn_dt_bias, *gdn_onorm, *gla_w2, *gla_b, *gla_onorm, *merge_b, *proj_sb, *proj_gdn, *proj_gla, *w_out;
    float* out; unsigned char* wsb;
    float *MODP, *MODA, *MODB, *MODG, *PS;
    bf16 *WIN, *WP, *WO, *H, *MGB, *P, *Y;
};

#ifdef PROF_SEL
#ifndef PROF_DIV
#define PROF_DIV 1
#endif
#define PROF_SLOT ((volatile LAS long long*)(F.lds + MISC_OFF + 64))
#define TIC(k) do { if ((k) == PROF_SEL && threadIdx.x == 0) PROF_SLOT[0] = clock64(); } while (0)
#define TOC(k) do { if ((k) == PROF_SEL && threadIdx.x == 0) PROF_SLOT[1] += clock64() - PROF_SLOT[0]; } while (0)
#else
#define TIC(k) do { } while (0)
#define TOC(k) do { } while (0)
#endif
template <int G1VAR> struct EpiG1T {
    static constexpr bool PERM = true, MID = false;
    bf16* P; float* PS; const float* mb;
    __device__ __forceinline__ bool operator()(pg8::f32x4 (&acc)[2][2][4][2], const pg8::Unit& u, int wr, int wc, int fr, int fq) const {
        if (G1VAR & 4) return false;
        const int row0 = u.pm * 256 + wr * 64 + fr, pn = u.pn;
        {
            const int mode = (G1VAR & 2) ? 0 : (pn == 6 || pn == 7 || pn == 14 || pn == 15 || (pn >= 24 && pn < 28)) ? 1 : (pn >= 28 ? 2 : 0);
            const int col0 = pn * 256 + wc * 32 + 8 * fq;
            pg8::f32x4 bv[2][2];
#pragma unroll
            for (int bj = 0; bj < 2; ++bj)
#pragma unroll
                for (int n = 0; n < 2; ++n) bv[bj][n] = (mode == 2) ? *(const pg8::f32x4*)(mb + (col0 - PC_MG) + bj * 128 + 4 * n) : (pg8::f32x4){0.f, 0.f, 0.f, 0.f};
#pragma unroll
            for (int ai = 0; ai < 2; ++ai)
#pragma unroll
                for (int m = 0; m < 4; ++m) { bf16* rowp = P + (size_t)(row0 + ai * 128 + m * 16) * NP + col0;
#pragma unroll
                    for (int bj = 0; bj < 2; ++bj) { pg8::f32x4 v0 = acc[ai][bj][m][0], v1 = acc[ai][bj][m][1];
                        if (mode == 1) {
#pragma unroll
                            for (int j = 0; j < 4; ++j) { v0[j] = siluf_(v0[j]); v1[j] = siluf_(v1[j]); } }
                        else if (mode == 2) { v0 = v0 + bv[bj][0]; v1 = v1 + bv[bj][1];
#pragma unroll
                            for (int j = 0; j < 4; ++j) { v0[j] = sigmoidf_(v0[j]); v1[j] = sigmoidf_(v1[j]); } }
                        pg8::u32x4 w; w.x = pg8::cvt_pk_bf16(v0[0], v0[1]); w.y = pg8::cvt_pk_bf16(v0[2], v0[3]); w.z = pg8::cvt_pk_bf16(v1[0], v1[1]); w.w = pg8::cvt_pk_bf16(v1[2], v1[3]);
                        if (!(G1VAR & 1)) *(pg8::u32x4*)(rowp + bj * 128) = w; else asm volatile("" :: "v"(w)); } }
        }
        return false;
    }
};
template <int G2VAR> struct EpiG2RT {
    static constexpr bool PERM = true, MID = !(G2VAR & 1);
    static constexpr int MID_T0 = 8, MID_T1 = 16;
    const bf16* P; bf16* MGB;
    template <bool RCP> __device__ __forceinline__ void scale_by(pg8::f32x4 (&acc)[2][2][4][2], const char* Pb, unsigned po0, unsigned gcol) const {
        pg8::u32x4 gw[2][4][2];
#pragma unroll
        for (int ai = 0; ai < 2; ++ai)
#pragma unroll
            for (int m = 0; m < 4; ++m)
#pragma unroll
                for (int bj = 0; bj < 2; ++bj) gw[ai][m][bj] = *(const pg8::u32x4*)(Pb + (po0 + (unsigned)((ai * 128 + m * 16) * NP + bj * 128) * 2u + gcol));
#pragma unroll
        for (int ai = 0; ai < 2; ++ai)
#pragma unroll
            for (int m = 0; m < 4; ++m)
#pragma unroll
                for (int bj = 0; bj < 2; ++bj) { const pg8::u32x4 g = gw[ai][m][bj];
                    pg8::f32x4 f0, f1; f0[0] = bflo(g.x); f0[1] = bfhi(g.x); f0[2] = bflo(g.y); f0[3] = bfhi(g.y); f1[0] = bflo(g.z); f1[1] = bfhi(g.z); f1[2] = bflo(g.w); f1[3] = bfhi(g.w);
                    if (RCP) {
#pragma unroll
                        for (int j = 0; j < 4; ++j) { f0[j] = __builtin_amdgcn_rcpf(fmaxf(f0[j], 1e-30f)); f1[j] = __builtin_amdgcn_rcpf(fmaxf(f1[j], 1e-30f)); } }
                    acc[ai][bj][m][0] = acc[ai][bj][m][0] * f0; acc[ai][bj][m][1] = acc[ai][bj][m][1] * f1; }
    }
    __device__ __forceinline__ void apply(pg8::f32x4 (&acc)[2][2][4][2], const pg8::Unit& u, int which, int wr, int wc, int fr, int fq) const {
        const unsigned row0 = u.pm * 256 + wr * 64 + fr, col0 = u.pn * 256 + wc * 32 + 8 * fq;
        const unsigned gn = (PC_MG + which * D) * 2, gd = (PC_MG + (which + 1) * D) * 2;
        const char* Pb = (const char*)P; char* Mb = (char*)MGB;
        const unsigned po0 = (row0 * NP + col0) * 2u;
        scale_by<false>(acc, Pb, po0, gn);
        if (which < 2) { asm volatile("" ::: "memory"); scale_by<true>(acc, Pb, po0, gd); }
        else {
#pragma unroll
            for (int ai = 0; ai < 2; ++ai)
#pragma unroll
                for (int m = 0; m < 4; ++m) { const unsigned mo = ((row0 + ai * 128 + m * 16) * D + col0) * 2u;
#pragma unroll
                    for (int bj = 0; bj < 2; ++bj) { const pg8::f32x4 v0 = acc[ai][bj][m][0], v1 = acc[ai][bj][m][1]; pg8::u32x4 w;
                        w.x = pg8::cvt_pk_bf16(v0[0], v0[1]); w.y = pg8::cvt_pk_bf16(v0[2], v0[3]); w.z = pg8::cvt_pk_bf16(v1[0], v1[1]); w.w = pg8::cvt_pk_bf16(v1[2], v1[3]);
                        *(pg8::u32x4*)(Mb + (mo + (unsigned)(bj * 128) * 2u)) = w; } }
        }
    }
    __device__ __forceinline__ void mid(pg8::f32x4 (&acc)[2][2][4][2], const pg8::Unit& u, int t, int wr, int wc, int fr, int fq) const { apply(acc, u, t == MID_T0 ? 0 : 1, wr, wc, fr, fq); }
    __device__ __forceinline__ bool operator()(pg8::f32x4 (&acc)[2][2][4][2], const pg8::Unit& u, int wr, int wc, int fr, int fq) const { if (!(G2VAR & 2)) apply(acc, u, 2, wr, wc, fr, fq); return false; }
};
typedef EpiG2RT<0> EpiG2R;
struct EpiG3 {
    static constexpr bool PERM = false, MID = false;
    const float* xin; float* out; const float* gate; int grow0;
    __device__ __forceinline__ bool operator()(pg8::f32x4 (&acc)[2][2][4][2], const pg8::Unit& u, int wr, int wc, int fr, int fq) const {
        const int row0 = grow0 + u.pm * 256 + wr * 64 + fr, col0 = u.pn * 256 + wc * 32 + 4 * fq;
        const float* gp = gate + (size_t)((grow0 + u.pm * 256) / SEQ) * D;
        pg8::f32x4 gv[2][2];
#pragma unroll
        for (int bj = 0; bj < 2; ++bj)
#pragma unroll
            for (int n = 0; n < 2; ++n) gv[bj][n] = *(const pg8::f32x4*)(gp + col0 + bj * 128 + n * 16);
#pragma unroll
        for (int ai = 0; ai < 2; ++ai)
#pragma unroll
            for (int m = 0; m < 4; ++m) { const size_t off = (size_t)(row0 + ai * 128 + m * 16) * D + col0;
#pragma unroll
                for (int bj = 0; bj < 2; ++bj)
#pragma unroll
                    for (int n = 0; n < 2; ++n) { const pg8::f32x4 xv = *(const pg8::f32x4*)(xin + off + bj * 128 + n * 16);
                        *(pg8::f32x4*)(out + off + bj * 128 + n * 16) = xv + gv[bj][n] * acc[ai][bj][m][n]; } }
        return false;
    }
};

typedef EpiG1T<0> EpiG1;
__device__ __forceinline__ void transpose_item(const float* W, int ldw, int col0, bf16* WT, int ldd, int drow0, int dk0, int nblk, LAS float* scr, int item, int lane) {
    const int kb = item / nblk, nb = item % nblk, k0 = 64 * kb, n0 = 32 * nb;
#pragma unroll 8
    for (int i = 0; i < 32; ++i) { const int kk = 2 * i + (lane >> 5); scr[kk * 33 + (lane & 31)] = W[(size_t)(k0 + kk) * ldw + col0 + n0 + (lane & 31)]; }
    LDS_WAIT(); asm volatile("" ::: "memory");
    const int c = lane & 7;
#pragma unroll
    for (int j = 0; j < 4; ++j) { const int n = (lane >> 3) + 8 * j; const LAS float* s = scr + (8 * c) * 33 + n;
        v4u o; o.x = pk2(s[0 * 33], s[1 * 33]); o.y = pk2(s[2 * 33], s[3 * 33]); o.z = pk2(s[4 * 33], s[5 * 33]); o.w = pk2(s[6 * 33], s[7 * 33]);
        *(v4u*)(WT + (size_t)(drow0 + n0 + n) * ldd + dk0 + k0 + 8 * c) = o; }
    LDS_WAIT(); asm volatile("" ::: "memory");
}
__device__ __forceinline__ void p0_ada(Frame& F) {
    LAS float* cact = (LAS float*)F.lds;
    for (int i = F.tid; i < BATCH * D; i += NTHREADS) cact[i] = siluf_(F.c[i]);
    __syncthreads();
    for (int it = blockIdx.x; it < 4 * 8 * 6; it += F.G) {
        const int l = it / 48, ks = (it % 48) / 6, jc = it % 6, j = jc * 512 + F.tid;
        float a[16];
#pragma unroll
        for (int b = 0; b < 16; ++b) a[b] = 0.f;
        const float* wp = F.ada_w + ((size_t)l * D + ks * 128) * 3072 + j;
#pragma unroll 4
        for (int k = 0; k < 128; ++k) { const float w = wp[(size_t)k * 3072];
#pragma unroll
            for (int b = 0; b < 16; ++b) a[b] += cact[b * D + ks * 128 + k] * w; }
#pragma unroll
        for (int b = 0; b < 16; ++b) F.MODP[((size_t)(ks * 4 + l) * 16 + b) * 3072 + j] = a[b];
    }
}
__device__ __forceinline__ void wconv_layer(Frame& F, int l) {
    const int lane = opq(F.lane);
    LAS float* scr = (LAS float*)(F.lds + F.wave * 16384);
    const int gw = blockIdx.x * NWAVES + F.wave, NGW = F.G * NWAVES;
    constexpr int I_A = 16 * 128, I_B = 16 * 96, I_C = 16 * 96, I_SB = 8 * 32, I_GDN = 8 * 32, I_GLA = 16 * 32, I_WO = 16 * 32;
    constexpr int I_L = I_A + I_B + I_C + I_SB + I_GDN + I_GLA + I_WO;
    const float* win = F.w_in + (size_t)l * D * N_IN;
    for (int it = gw; it < I_L; it += NGW) {
        int r = it;
        if (r < I_A) { transpose_item(win, N_IN, 0, F.WIN, D, 0, 0, 128, scr, r, lane); continue; } r -= I_A;
        if (r < I_B) { transpose_item(win, N_IN, 4104, F.WIN, D, 4096, 0, 96, scr, r, lane); continue; } r -= I_B;
        if (r < I_C) { transpose_item(win, N_IN, 7192, F.WIN, D, 7168, 0, 96, scr, r, lane); continue; } r -= I_C;
        if (r < I_SB) { transpose_item(F.proj_sb + (size_t)l * 512 * D, D, 0, F.WP, 2048, 0, 0, 32, scr, r, lane); continue; } r -= I_SB;
        if (r < I_GDN) { transpose_item(F.proj_gdn + (size_t)l * 512 * D, D, 0, F.WP, 2048, 0, 512, 32, scr, r, lane); continue; } r -= I_GDN;
        if (r < I_GLA) { transpose_item(F.proj_gla + (size_t)l * D * D, D, 0, F.WP, 2048, 0, 1024, 32, scr, r, lane); continue; } r -= I_GLA;
        transpose_item(F.w_out + (size_t)l * D * D, D, 0, F.WO + (size_t)(l & 1) * D * D, D, 0, 0, 32, scr, r, lane);
    }
    for (int i = blockIdx.x * NTHREADS + opq(F.tid); i < 32 * D; i += F.G * NTHREADS) {
        const int r = i / D, k = i % D;
        float v = 0.f;
        if (r < 8) v = win[(size_t)k * N_IN + 4096 + r];
        else if (r < 24) v = win[(size_t)k * N_IN + 7176 + (r - 8)];
        F.WIN[(size_t)(10240 + r) * D + k] = (bf16)f2bf(v);
    }
    __syncthreads();
}
__device__ __forceinline__ void p1_mod(Frame& F) {
    for (int i = blockIdx.x * NTHREADS + F.tid; i < DEPTH * BATCH * D; i += F.G * NTHREADS) {
        const int l = i / (BATCH * D), b = (i / D) % BATCH, c = i % D;
        float sh = F.ada_b[l * 3072 + c], sc = F.ada_b[l * 3072 + D + c], gt = F.ada_b[l * 3072 + 2 * D + c];
#pragma unroll
        for (int ks = 0; ks < 8; ++ks) { const float* p = F.MODP + ((size_t)(ks * 4 + l) * 16 + b) * 3072; sh += p[c]; sc += p[D + c]; gt += p[2 * D + c]; }
        F.MODA[i] = F.norm_g[l * D + c] * (1.f + sc); F.MODB[i] = sh; F.MODG[i] = gt;
    }
}
__device__ __forceinline__ float wave_sum(float v) {
#pragma unroll
    for (int o = 1; o < 64; o <<= 1) v += __shfl_xor(v, o);
    return v;
}
__device__ __forceinline__ void phase_norm(Frame& F, const float* xin, int l, int g) {
    const int gw = blockIdx.x * NWAVES + F.wave, NGW = F.G * NWAVES, lane = opq(F.lane);
    for (int m = gw; m < TG; m += NGW) {
        const int grow = g * TG + m, b = grow / SEQ;
        const f32x4* xr = (const f32x4*)(xin + (size_t)grow * D) + lane;
        const f32x4* ma = (const f32x4*)(F.MODA + (size_t)(l * BATCH + b) * D) + lane;
        const f32x4* mb = (const f32x4*)(F.MODB + (size_t)(l * BATCH + b) * D) + lane;
        f32x4 v[4]; float s = 0.f;
#pragma unroll
        for (int j = 0; j < 4; ++j) { v[j] = xr[64 * j]; s += (v[j].x * v[j].x + v[j].y * v[j].y) + (v[j].z * v[j].z + v[j].w * v[j].w); }
        const float rstd = 1.f / sqrtf(wave_sum(s) * (1.f / D) + RMS_EPS);
        unsigned long long* o8 = (unsigned long long*)(F.H + (size_t)m * D) + lane;
#pragma unroll
        for (int j = 0; j < 4; ++j) { const f32x4 a = ma[64 * j], sh = mb[64 * j]; const f32x4 y = v[j] * rstd * a + sh;
            o8[64 * j] = (unsigned long long)pk2(y.x, y.y) | ((unsigned long long)pk2(y.z, y.w) << 32); }
    }
}
typedef short bf16x8 __attribute__((ext_vector_type(8)));
__device__ __forceinline__ f32x4 mm16(const LAS bf16* A, int lda, int m0, const LAS bf16* Bt, int ldb, int n0, int K, int lane, f32x4 acc) {
    const LAS bf16* ap = A + (m0 + (lane & 15)) * lda + (lane >> 4) * 8;
    const LAS bf16* bp = Bt + (n0 + (lane & 15)) * ldb + (lane >> 4) * 8;
#pragma unroll
    for (int k0 = 0; k0 < K; k0 += 32) acc = __builtin_amdgcn_mfma_f32_16x16x32_bf16(*(const LAS bf16x8*)(ap + k0), *(const LAS bf16x8*)(bp + k0), acc, 0, 0, 0);
    return acc;
}
__device__ __forceinline__ int swz(int i, int g) { return (((i >> 3) ^ g) << 3) | (i & 7); }
__device__ __forceinline__ f32x4 mm16k64(const LAS bf16* A, int m0, int shA, const LAS bf16* Bt, int n0, int shB, int lane, f32x4 acc) {
    const int ga = shA ? ((m0 >> shA) & 7) : 0, gb = shB ? ((n0 >> shB) & 7) : 0, q = lane >> 4;
    const LAS bf16* ap = A + (m0 + (lane & 15)) * 72; const LAS bf16* bp = Bt + (n0 + (lane & 15)) * 72;
#pragma unroll
    for (int ks = 0; ks < 2; ++ks) acc = __builtin_amdgcn_mfma_f32_16x16x32_bf16(*(const LAS bf16x8*)(ap + (((ks * 4 + q) ^ ga) << 3)), *(const LAS bf16x8*)(bp + (((ks * 4 + q) ^ gb) << 3)), acc, 0, 0, 0);
    return acc;
}
__device__ __forceinline__ v2u pk4(const f32x4 a) { v2u r; r.x = pk2(a[0], a[1]); r.y = pk2(a[2], a[3]); return r; }

constexpr int GP_QS = 0, GP_KN = 17408, GP_AM = 34816, GP_QK = 54272, GP_TM = 63488, GP_VBT = 72704, GP_KBT = 91136, GP_KDT = 109568, GP_SC = 128000;
constexpr int GP_UBT = 17408, GP_WKT = 35840;
__device__ __forceinline__ void gdn_pre_unit(Frame& F, int l, int unit) {
    const int tid = opq(F.tid), lane = tid & 63, w = __builtin_amdgcn_readfirstlane(tid >> 6);
    const int n = unit & 31, bh = unit >> 5, bl = bh >> 2, h = bh & 3;
    LAS bf16* Qs = (LAS bf16*)(F.lds + GP_QS); LAS bf16* Kn = (LAS bf16*)(F.lds + GP_KN); LAS float* Am = (LAS float*)(F.lds + GP_AM);
    LAS bf16* QKm = (LAS bf16*)(F.lds + GP_QK); LAS bf16* Tm = (LAS bf16*)(F.lds + GP_TM); LAS bf16* VbT = (LAS bf16*)(F.lds + GP_VBT);
    LAS bf16* KbT = (LAS bf16*)(F.lds + GP_KBT); LAS bf16* KdT = (LAS bf16*)(F.lds + GP_KDT); LAS bf16* UbT = (LAS bf16*)(F.lds + GP_UBT); LAS bf16* WkT = (LAS bf16*)(F.lds + GP_WKT);
    LAS float* gamA = (LAS float*)(F.lds + GP_SC); LAS float* betaA = gamA + 64; LAS float* gA = betaA + 64;
    const int row0 = bl * SEQ + n * 64;
    TIC(1);
    if (w == 7) {
        const float db = F.PS[(size_t)(row0 + lane) * 32 + h], da = F.PS[(size_t)(row0 + lane) * 32 + 4 + h];
        betaA[lane] = sigmoidf_(db);
        const float xs = da + F.gdn_dt_bias[l * 4 + h];
        float v = -__expf(F.gdn_a_log[l * 4 + h]) * (fmaxf(xs, 0.f) + __logf(1.f + __expf(-fabsf(xs))));
#pragma unroll
        for (int off = 1; off < 64; off <<= 1) { const float t = __shfl_up(v, off); if (lane >= off) v += t; }
        gamA[lane] = v;
    }
    const int mat = __builtin_amdgcn_readfirstlane(tid >> 7), tg = (tid & 127) >> 4, sub = tid & 15;
    float y[8][8];
    TIC(71);
    if (mat < 3) {
        const bf16* prow = F.P + (size_t)(row0 + 8 * tg - 3) * NP + PC_DQ + mat * 512 + h * 128 + 8 * sub;
        const float* cw = F.gdn_conv + (size_t)l * 4 * 1536 + mat * 512 + h * 128 + 8 * sub;
        v4u xr[11];
#pragma unroll
        for (int j = 0; j < 11; ++j) { if (n * 64 + 8 * tg - 3 + j >= 0) xr[j] = *(const v4u*)(prow + (size_t)j * NP); else xr[j] = (v4u){0u, 0u, 0u, 0u}; }
        f32x4 cwv[4][2];
#pragma unroll
        for (int tap = 0; tap < 4; ++tap) { cwv[tap][0] = *(const f32x4*)(cw + tap * 1536); cwv[tap][1] = *(const f32x4*)(cw + tap * 1536 + 4); }
        __builtin_amdgcn_sched_barrier(0);
#pragma unroll
        for (int t = 0; t < 8; ++t) {
#pragma unroll
            for (int e = 0; e < 8; ++e) y[t][e] = 0.f;
#pragma unroll
            for (int tap = 0; tap < 4; ++tap) { const v4u xw = xr[t + tap]; const f32x4 c0 = cwv[tap][0], c1 = cwv[tap][1];
                y[t][0] += c0[0] * bflo(xw.x); y[t][1] += c0[1] * bfhi(xw.x); y[t][2] += c0[2] * bflo(xw.y); y[t][3] += c0[3] * bfhi(xw.y);
                y[t][4] += c1[0] * bflo(xw.z); y[t][5] += c1[1] * bfhi(xw.z); y[t][6] += c1[2] * bflo(xw.w); y[t][7] += c1[3] * bfhi(xw.w); }
#pragma unroll
            for (int e = 0; e < 8; ++e) y[t][e] = siluf_(y[t][e]);
            if (mat < 2) {
                float ss = 0.f;
#pragma unroll
                for (int e = 0; e < 8; ++e) ss += y[t][e] * y[t][e];
                ss += __shfl_xor(ss, 1); ss += __shfl_xor(ss, 2); ss += __shfl_xor(ss, 4); ss += __shfl_xor(ss, 8);
                const float r = (mat == 0 ? 0.08838834764831845f : 1.f) / sqrtf(ss + L2_EPS);
#pragma unroll
                for (int e = 0; e < 8; ++e) y[t][e] *= r;
                v4u o; o.x = pk2(y[t][0], y[t][1]); o.y = pk2(y[t][2], y[t][3]); o.z = pk2(y[t][4], y[t][5]); o.w = pk2(y[t][6], y[t][7]);
                *(LAS v4u*)((mat == 0 ? Qs : Kn) + (8 * tg + t) * 136 + 8 * sub) = o;
            }
        }
    }
    TOC(71); TIC(70); WG_SYNC(); TOC(70); TIC(72);
    const float gl = gamA[63];
    if (mat == 1 || mat == 2) {
        float fb[8], fd[8];
#pragma unroll
        for (int t = 0; t < 8; ++t) { const float gm = gamA[8 * tg + t], bt = betaA[8 * tg + t]; fb[t] = (mat == 1) ? bt * __expf(gm) : bt; fd[t] = __expf(gl - gm); }
        const int cg = ((tg ^ (sub >> 1)) << 3);
#pragma unroll
        for (int e = 0; e < 8; ++e) {
            v4u o; o.x = pk2(y[0][e] * fb[0], y[1][e] * fb[1]); o.y = pk2(y[2][e] * fb[2], y[3][e] * fb[3]); o.z = pk2(y[4][e] * fb[4], y[5][e] * fb[5]); o.w = pk2(y[6][e] * fb[6], y[7][e] * fb[7]);
            *(LAS v4u*)((mat == 1 ? KbT : VbT) + (8 * sub + e) * 72 + cg) = o;
            if (mat == 1) { v4u o2; o2.x = pk2(y[0][e] * fd[0], y[1][e] * fd[1]); o2.y = pk2(y[2][e] * fd[2], y[3][e] * fd[3]); o2.z = pk2(y[4][e] * fd[4], y[5][e] * fd[5]); o2.w = pk2(y[6][e] * fd[6], y[7][e] * fd[7]);
                *(LAS v4u*)(KdT + (8 * sub + e) * 72 + cg) = o2; }
        }
    }
    TOC(72); TIC(73); WG_SYNC(); TOC(73); TOC(1); TIC(2);
#pragma unroll
    for (int t = 0; t < 2; ++t) {
        const int idx = 2 * w + t, mb = idx >> 2, nb = idx & 3;
        const f32x4 z4 = {0.f, 0.f, 0.f, 0.f};
        const f32x4 akk = mm16(Kn, 136, mb * 16, Kn, 136, nb * 16, 128, lane, z4);
        const f32x4 aqk = mm16(Qs, 136, mb * 16, Kn, 136, nb * 16, 128, lane, z4);
        const int j = nb * 16 + (lane & 15); const float gj = gamA[j];
#pragma unroll
        for (int e = 0; e < 4; ++e) { const int ii = mb * 16 + 4 * (lane >> 4) + e; const float dc = __expf(fminf(gamA[ii] - gj, 0.f));
            Am[ii * 68 + j] = (ii > j) ? betaA[ii] * akk[e] * dc : 0.f;
            QKm[ii * 72 + j] = (bf16)f2bf((ii >= j) ? aqk[e] * dc : 0.f); }
    }
    WG_SYNC(); TOC(2); TIC(3);
#ifdef PROBE_TINV
    for (int rep_ = 0; rep_ < 3; ++rep_)
#endif
    if (w == 0) {
        LAS bf16* A21b = (LAS bf16*)(F.lds + GP_KN);
        LAS bf16* T11T = A21b + 32 * 40;
        LAS bf16* XT = T11T + 32 * 40;
        const int hb = lane >> 5, c = lane & 31;
        const LAS float* Ab = Am + (32 * hb) * 68 + 32 * hb;
        float Tc[32];
#pragma clang loop unroll(full)
        for (int ii = 0; ii < 32; ++ii) {
            float s = (ii == c) ? 1.f : 0.f;
#pragma clang loop unroll(full)
            for (int j = 0; j < ii; ++j) s -= Ab[ii * 68 + j] * Tc[j];
            Tc[ii] = s;
            Tm[(32 * hb + ii) * 72 + 32 * hb + c] = (bf16)f2bf(s);
            if (hb == 0) Tm[ii * 72 + 32 + c] = (bf16)0;
        }
        if (hb == 0) {
#pragma unroll
            for (int k = 0; k < 4; ++k) { v4u o; o.x = pk2(Tc[8 * k], Tc[8 * k + 1]); o.y = pk2(Tc[8 * k + 2], Tc[8 * k + 3]); o.z = pk2(Tc[8 * k + 4], Tc[8 * k + 5]); o.w = pk2(Tc[8 * k + 6], Tc[8 * k + 7]);
                *(LAS v4u*)(T11T + c * 40 + 8 * k) = o; }
        }
        {
            const int r = lane >> 1, k0 = (lane & 1) * 16; const LAS float* ap = Am + (32 + r) * 68 + k0;
            v4u o0, o1; o0.x = pk2(ap[0], ap[1]); o0.y = pk2(ap[2], ap[3]); o0.z = pk2(ap[4], ap[5]); o0.w = pk2(ap[6], ap[7]);
            o1.x = pk2(ap[8], ap[9]); o1.y = pk2(ap[10], ap[11]); o1.z = pk2(ap[12], ap[13]); o1.w = pk2(ap[14], ap[15]);
            *(LAS v4u*)(A21b + r * 40 + k0) = o0; *(LAS v4u*)(A21b + r * 40 + k0 + 8) = o1;
        }
        asm volatile("s_waitcnt lgkmcnt(0)" ::: "memory");
        const int c16 = lane & 15, q = lane >> 4;
#pragma unroll
        for (int mbx = 0; mbx < 2; ++mbx)
#pragma unroll
            for (int nbx = 0; nbx < 2; ++nbx) {
                const f32x4 z4 = {0.f, 0.f, 0.f, 0.f};
                const f32x4 x = __builtin_amdgcn_mfma_f32_16x16x32_bf16(*(const LAS bf16x8*)(A21b + (16 * mbx + c16) * 40 + 8 * q), *(const LAS bf16x8*)(T11T + (16 * nbx + c16) * 40 + 8 * q), z4, 0, 0, 0);
                *(LAS v2u*)(XT + (16 * nbx + c16) * 40 + 16 * mbx + 4 * q) = pk4(x);
            }
        asm volatile("s_waitcnt lgkmcnt(0)" ::: "memory");
#pragma unroll
        for (int mbx = 0; mbx < 2; ++mbx)
#pragma unroll
            for (int nbx = 0; nbx < 2; ++nbx) {
                const f32x4 z4 = {0.f, 0.f, 0.f, 0.f};
                const f32x4 t = __builtin_amdgcn_mfma_f32_16x16x32_bf16(*(const LAS bf16x8*)(Tm + (32 + 16 * mbx + c16) * 72 + 32 + 8 * q), *(const LAS bf16x8*)(XT + (16 * nbx + c16) * 40 + 8 * q), z4, 0, 0, 0);
#pragma unroll
                for (int e = 0; e < 4; ++e) Tm[(32 + 16 * mbx + 4 * q + e) * 72 + 16 * nbx + c16] = (bf16)f2bf(-t[e]);
            }
    }
    WG_SYNC(); TOC(3); TIC(4);
    {
        const int q = lane >> 4, c = lane & 15, mb = w & 3;
        const LAS bf16* Bsrc = (w >> 2) ? KbT : VbT; LAS bf16* dst = (w >> 2) ? WkT : UbT;
        bf16x8 af[2];
#pragma unroll
        for (int ks = 0; ks < 2; ++ks) af[ks] = *(const LAS bf16x8*)(Tm + (16 * mb + c) * 72 + (ks * 4 + q) * 8);
#pragma unroll
        for (int nb = 0; nb < 8; ++nb) {
            f32x4 a = {0.f, 0.f, 0.f, 0.f};
#pragma unroll
            for (int ks = 0; ks < 2; ++ks) a = __builtin_amdgcn_mfma_f32_16x16x32_bf16(af[ks], *(const LAS bf16x8*)(Bsrc + (16 * nb + c) * 72 + (((ks * 4 + q) ^ nb) << 3)), a, 0, 0, 0);
            *(LAS v2u*)(dst + (nb * 16 + c) * 72 + mb * 16 + 4 * q) = pk4(a);
        }
    }
    WG_SYNC(); TOC(4); TIC(5);
    bf16* gWN = (bf16*)(F.wsb + WS_GD_WN) + (size_t)unit * 16384; bf16* gBT = (bf16*)(F.wsb + WS_GD_BT) + (size_t)unit * 16384;
    bf16* gQE = (bf16*)(F.wsb + WS_GD_QE) + (size_t)unit * 8192; bf16* gOL = (bf16*)(F.wsb + WS_GD_OL) + (size_t)unit * 8192;
    if (tid == 0) ((float*)(F.wsb + WS_GD_CD))[unit] = __expf(gl);
    {
        const int q = lane >> 4, c = lane & 15, q4 = 4 * q, mq = w >> 1;
        LAS bf16* STG = (LAS bf16*)(F.lds + GP_TM);
        LAS bf16* STG2 = STG + 64 * 136;
        bf16x8 aW[2], aK[2], aQ[2];
#pragma unroll
        for (int ks = 0; ks < 2; ++ks) { aW[ks] = *(const LAS bf16x8*)(WkT + (16 * w + c) * 72 + (ks * 4 + q) * 8);
            aK[ks] = *(const LAS bf16x8*)(KdT + (16 * w + c) * 72 + (((ks * 4 + q) ^ w) << 3));
            aQ[ks] = *(const LAS bf16x8*)(QKm + (16 * mq + c) * 72 + (ks * 4 + q) * 8); }
#pragma unroll
        for (int nb = 0; nb < 8; ++nb) {
            f32x4 a = {0.f, 0.f, 0.f, 0.f};
#pragma unroll
            for (int ks = 0; ks < 2; ++ks) a = __builtin_amdgcn_mfma_f32_16x16x32_bf16(aW[ks], *(const LAS bf16x8*)(KdT + (16 * nb + c) * 72 + (((ks * 4 + q) ^ nb) << 3)), a, 0, 0, 0);
            a = -a;
            *(LAS v2u*)(STG + (nb * 16 + c) * 136 + 16 * w + q4) = pk4(a);
        }
        WG_SYNC();
#pragma unroll
        for (int k = 0; k < 4; ++k) { const int p = tid + 512 * k; *(v4u*)(gWN + (p >> 4) * 128 + (p & 15) * 8) = *(const LAS v4u*)(STG + (p >> 4) * 136 + (p & 15) * 8); }
        WG_SYNC();
#pragma unroll
        for (int nb = 0; nb < 8; ++nb) {
            f32x4 b2 = {0.f, 0.f, 0.f, 0.f};
#pragma unroll
            for (int ks = 0; ks < 2; ++ks) b2 = __builtin_amdgcn_mfma_f32_16x16x32_bf16(aK[ks], *(const LAS bf16x8*)(UbT + (16 * nb + c) * 72 + (ks * 4 + q) * 8), b2, 0, 0, 0);
            *(LAS v2u*)(STG + (nb * 16 + c) * 136 + 16 * w + q4) = pk4(b2);
        }
        WG_SYNC();
#pragma unroll
        for (int k = 0; k < 4; ++k) {
            const int p = tid + 512 * k, ln = p & 63, jj = (p >> 6) & 3, dvr = 16 * (p >> 8) + (ln & 15), qq = ln >> 4;
            const v2u lo = *(const LAS v2u*)(STG + dvr * 136 + 32 * jj + 4 * qq), hi = *(const LAS v2u*)(STG + dvr * 136 + 32 * jj + 16 + 4 * qq);
            v4u o; o.x = lo.x; o.y = lo.y; o.z = hi.x; o.w = hi.y; *(v4u*)(gBT + (size_t)p * 8) = o; }
        WG_SYNC();
#pragma unroll
        for (int t = 0; t < 4; ++t) {
            const int nb = 4 * (w & 1) + t;
            f32x4 o = {0.f, 0.f, 0.f, 0.f};
#pragma unroll
            for (int ks = 0; ks < 2; ++ks) o = __builtin_amdgcn_mfma_f32_16x16x32_bf16(aQ[ks], *(const LAS bf16x8*)(UbT + (16 * nb + c) * 72 + (ks * 4 + q) * 8), o, 0, 0, 0);
            *(LAS v2u*)(STG2 + (nb * 16 + c) * 72 + 16 * mq + q4) = pk4(o);
        }
#pragma unroll
        for (int nb = 0; nb < 4; ++nb) {
            f32x4 a = {0.f, 0.f, 0.f, 0.f};
#pragma unroll
            for (int ks = 0; ks < 2; ++ks) a = __builtin_amdgcn_mfma_f32_16x16x32_bf16(aW[ks], *(const LAS bf16x8*)(QKm + (16 * nb + c) * 72 + (ks * 4 + q) * 8), a, 0, 0, 0);
            const int ii = nb * 16 + c, d0 = 16 * w + q4; const float eg = __expf(gamA[ii]);
            const v2u qw = *(const LAS v2u*)(Qs + ii * 136 + d0);
            f32x4 r; r[0] = bflo(qw.x) * eg - a[0]; r[1] = bfhi(qw.x) * eg - a[1]; r[2] = bflo(qw.y) * eg - a[2]; r[3] = bfhi(qw.y) * eg - a[3];
            *(LAS v2u*)(STG + ii * 136 + d0) = pk4(r);
        }
        WG_SYNC();
#pragma unroll
        for (int k = 0; k < 2; ++k) { const int p = tid + 512 * k;
            *(v4u*)(gQE + (p >> 4) * 128 + (p & 15) * 8) = *(const LAS v4u*)(STG + (p >> 4) * 136 + (p & 15) * 8);
            {
                const int ln = p & 63, tp = (p >> 6) & 1, ww = p >> 7, cc = ln & 15, qq = ln >> 4, nb0 = 4 * (ww & 1) + 2 * tp, i0 = 16 * (ww >> 1) + 4 * qq;
                const v2u lo = *(const LAS v2u*)(STG2 + (16 * nb0 + cc) * 72 + i0), hi = *(const LAS v2u*)(STG2 + (16 * (nb0 + 1) + cc) * 72 + i0);
                v4u o; o.x = lo.x; o.y = lo.y; o.z = hi.x; o.w = hi.y; *(v4u*)(gOL + (size_t)p * 8) = o; } }
    }
    WG_SYNC(); TOC(5);
}
template <int CHAIN_EXP> __device__ __forceinline__ void gdn_chain(Frame& F, int bh) {
    const int tid = opq(F.tid), lane = tid & 63, w = __builtin_amdgcn_readfirstlane(tid >> 6);
    LAS bf16* Wl = (LAS bf16*)F.lds;
    LAS bf16* Sw = (LAS bf16*)(F.lds + 2 * 34816) + w * (16 * 136);
    const bf16* gWN = (const bf16*)(F.wsb + WS_GD_WN) + (size_t)bh * 32 * 16384;
    const bf16* gBT = (const bf16*)(F.wsb + WS_GD_BT) + (size_t)bh * 32 * 16384;
    bf16* gST = (bf16*)(F.wsb + WS_GD_ST) + (size_t)bh * 32 * 16384;
    const float* gCD = (const float*)(F.wsb + WS_GD_CD) + bh * 32;
    f32x4 acc[8];
#pragma unroll
    for (int mb = 0; mb < 8; ++mb) acc[mb] = (f32x4){0.f, 0.f, 0.f, 0.f};
    const int c = lane & 15, q4 = 4 * (lane >> 4);
    v4u wrA[4], wrB[4]; v4u breg[4]; float cd;
#define GDN_LOADW(dst, nn) do { _Pragma("unroll") for (int k = 0; k < 4; ++k) { const int p = tid + 512 * k; dst[k] = *(const v4u*)(gWN + (size_t)(nn) * 16384 + (size_t)(p >> 4) * 128 + (p & 15) * 8); } } while (0)
#define GDN_STOREW(buf, src) do { _Pragma("unroll") for (int k = 0; k < 4; ++k) { const int p = tid + 512 * k; *(LAS v4u*)((buf) + (p >> 4) * 136 + (p & 15) * 8) = src[k]; } } while (0)
    GDN_LOADW(wrA, 0);
#pragma unroll
    for (int j = 0; j < 4; ++j) breg[j] = *(const v4u*)(gBT + (size_t)((w * 4 + j) * 64 + lane) * 8);
    cd = gCD[0];
    GDN_LOADW(wrB, 1);
    GDN_STOREW(Wl, wrA);
#define GDN_STEP(n, WCUR, WNXT) do { \
        LAS bf16* Wc = Wl + ((n) & 1) * (128 * 136); LAS bf16* Wn = Wl + (((n) + 1) & 1) * (128 * 136); TIC(50); \
        _Pragma("unroll") for (int mb = 0; mb < 8; ++mb) { const v2u pk = pk4(acc[mb]); \
            *(LAS v2u*)(Sw + c * 136 + mb * 16 + q4) = pk; } \
        TOC(50); TIC(54); WG_SYNC(); TOC(54); TIC(51); \
        v4u bcur[4]; const float cdc = cd; \
        _Pragma("unroll") for (int j = 0; j < 4; ++j) bcur[j] = breg[j]; \
        if ((n) + 1 < 32 && !(CHAIN_EXP & 4)) { _Pragma("unroll") for (int j = 0; j < 4; ++j) breg[j] = *(const v4u*)(gBT + (size_t)((n) + 1) * 16384 + (size_t)((w * 4 + j) * 64 + lane) * 8); cd = gCD[(n) + 1]; } \
        if ((n) + 2 < 32 && !(CHAIN_EXP & 2)) GDN_LOADW(WNXT, (n) + 2); \
        __builtin_amdgcn_sched_barrier(0); TOC(51); TIC(52); \
        { const int qq = lane >> 4; bf16x8 bs[4]; \
          _Pragma("unroll") for (int ks = 0; ks < 4; ++ks) bs[ks] = *(const LAS bf16x8*)(Sw + c * 136 + ks * 32 + 8 * qq); \
          _Pragma("unroll") for (int mp = 0; mp < 4; ++mp) { bf16x8 af[2][4]; \
            _Pragma("unroll") for (int j = 0; j < 2; ++j) _Pragma("unroll") for (int ks = 0; ks < 4; ++ks) af[j][ks] = *(const LAS bf16x8*)(Wc + ((2 * mp + j) * 16 + c) * 136 + ks * 32 + 8 * qq); \
            __builtin_amdgcn_sched_barrier(0); \
            _Pragma("unroll") for (int j = 0; j < 2; ++j) { const int mb = 2 * mp + j; \
                const unsigned bx_ = j ? bcur[mp].z : bcur[mp].x, by_ = j ? bcur[mp].w : bcur[mp].y; \
                f32x4 a = acc[mb] * cdc; a[0] += bflo(bx_); a[1] += bfhi(bx_); a[2] += bflo(by_); a[3] += bfhi(by_); \
                if (!(CHAIN_EXP & 8)) _Pragma("unroll") for (int ks = 0; ks < 4; ++ks) a = __builtin_amdgcn_mfma_f32_16x16x32_bf16(af[j][ks], bs[ks], a, 0, 0, 0); \
                acc[mb] = a; } \
            __builtin_amdgcn_sched_barrier(0); } } \
        TOC(52); TIC(53); if ((n) + 1 < 32) GDN_STOREW(Wn, WCUR); \
          \
        if (!(CHAIN_EXP & 1)) _Pragma("unroll") for (int k = 0; k < 4; ++k) { const int rr = 4 * k + (lane >> 4), cc = (lane & 15) * 8; \
            *(v4u*)(gST + (size_t)(n) * 16384 + (16 * w + rr) * 128 + cc) = *(const LAS v4u*)(Sw + rr * 136 + cc); } TOC(53); \
        __builtin_amdgcn_sched_barrier(0); \
    } while (0)
    for (int n2 = 0; n2 < 32; n2 += 2) { GDN_STEP(n2, wrB, wrA); GDN_STEP(n2 + 1, wrA, wrB); }
#undef GDN_STEP
#undef GDN_LOADW
#undef GDN_STOREW
    WG_SYNC();
}
__device__ __forceinline__ void gdn_post_unit(Frame& F, int l, int unit) {
    const int tid = opq(F.tid), lane = tid & 63, w = __builtin_amdgcn_readfirstlane(tid >> 6);
    const int n = unit & 31, bh = unit >> 5, bl = bh >> 2, h = bh & 3;
    LAS bf16* QEl = (LAS bf16*)F.lds;
    LAS bf16* STl = (LAS bf16*)(F.lds + 17408);
    LAS float* Of = (LAS float*)(F.lds + 52224);
    const bf16* gQE = (const bf16*)(F.wsb + WS_GD_QE) + (size_t)unit * 8192; const bf16* gST = (const bf16*)(F.wsb + WS_GD_ST) + (size_t)unit * 16384;
    const bf16* gOL = (const bf16*)(F.wsb + WS_GD_OL) + (size_t)unit * 8192;
#pragma unroll
    for (int k = 0; k < 2; ++k) { const int p = tid + 512 * k; *(LAS v4u*)(QEl + (p >> 4) * 136 + (p & 15) * 8) = *(const v4u*)(gQE + (size_t)(p >> 4) * 128 + (p & 15) * 8); }
#pragma unroll
    for (int k = 0; k < 4; ++k) { const int p = tid + 512 * k; *(LAS v4u*)(STl + (p >> 4) * 136 + (p & 15) * 8) = *(const v4u*)(gST + (size_t)(p >> 4) * 128 + (p & 15) * 8); }
    WG_SYNC();
    const int c = lane & 15, q4 = 4 * (lane >> 4);
    v4u olp[2];
#pragma unroll
    for (int tp = 0; tp < 2; ++tp) olp[tp] = *(const v4u*)(gOL + (size_t)((w * 2 + tp) * 64 + lane) * 8);
#pragma unroll
    for (int t = 0; t < 4; ++t) {
        const int mb = w >> 1, nb = (w & 1) * 4 + t, dv = nb * 16 + c, i0 = mb * 16 + q4;
        const unsigned ox = (t & 1) ? olp[t >> 1].z : olp[t >> 1].x, oy = (t & 1) ? olp[t >> 1].w : olp[t >> 1].y;
        f32x4 a; a[0] = bflo(ox); a[1] = bfhi(ox); a[2] = bflo(oy); a[3] = bfhi(oy);
        a = mm16(QEl, 136, mb * 16, STl, 136, nb * 16, 128, lane, a);
#pragma unroll
        for (int e = 0; e < 4; ++e) Of[(i0 + e) * 132 + dv] = a[e];
    }
    WG_SYNC();
    {
        const int i = tid >> 3, sub = tid & 7, c16 = sub * 16; const size_t row = (size_t)bl * SEQ + n * 64 + i;
        float x[16]; float ss = 0.f;
#pragma unroll
        for (int e = 0; e < 16; ++e) { x[e] = Of[i * 132 + c16 + e]; ss += x[e] * x[e]; }
        ss += __shfl_xor(ss, 1); ss += __shfl_xor(ss, 2); ss += __shfl_xor(ss, 4);
        const float r = 1.f / sqrtf(ss * (1.f / 128.f) + RMS_EPS);
        const float* gn = F.gdn_onorm + l * 128 + c16;
        const v4u z0 = *(const v4u*)(F.P + row * NP + PC_DZ + h * 128 + c16), z1 = *(const v4u*)(F.P + row * NP + PC_DZ + h * 128 + c16 + 8);
        const float zg[16] = {bflo(z0.x), bfhi(z0.x), bflo(z0.y), bfhi(z0.y), bflo(z0.z), bfhi(z0.z), bflo(z0.w), bfhi(z0.w), bflo(z1.x), bfhi(z1.x), bflo(z1.y), bfhi(z1.y), bflo(z1.z), bfhi(z1.z), bflo(z1.w), bfhi(z1.w)};
#pragma unroll
        for (int e = 0; e < 16; ++e) x[e] = x[e] * r * gn[e] * zg[e];
        v4u o0, o1; o0.x = pk2(x[0], x[1]); o0.y = pk2(x[2], x[3]); o0.z = pk2(x[4], x[5]); o0.w = pk2(x[6], x[7]);
        o1.x = pk2(x[8], x[9]); o1.y = pk2(x[10], x[11]); o1.z = pk2(x[12], x[13]); o1.w = pk2(x[14], x[15]);
        bf16* yp = F.Y + row * YW + YC_GDN + h * 128 + c16;
        *(v4u*)yp = o0; *(v4u*)(yp + 8) = o1;
    }
    WG_SYNC();
}
constexpr size_t WS_GL_BS = 40 * MiB;
constexpr size_t WS_GL_AN = 619 * MiB;
constexpr int GL_LA = 0, GL_QD = 33792, GL_KT = 51200, GL_ATT = 68608, GL_VT = 77824, GL_LR = 114688, GL_GL = 118784;
__device__ __forceinline__ void gla_gam(Frame& F, int l, int h, int row0, int tid) {
    LAS float* laL = (LAS float*)(F.lds + GL_LA); LAS float* lrL = (LAS float*)(F.lds + GL_LR); LAS float* glL = (LAS float*)(F.lds + GL_GL); LAS float* totL = glL + 256;
#pragma unroll
    for (int k = 0; k < 2; ++k) { const int p = tid + 512 * k; lrL[p] = F.PS[(size_t)(row0 + (p >> 4)) * 32 + 8 + (p & 15)]; }
    const int d = tid & 127, ig = tid >> 7;
    float w2r[16]; const float bb = F.gla_b[l * 512 + h * 128 + d];
#pragma unroll
    for (int r = 0; r < 16; ++r) w2r[r] = F.gla_w2[((size_t)l * 16 + r) * 512 + h * 128 + d];
    WG_SYNC();
    float la[16]; float run = 0.f;
#pragma unroll
    for (int ii = 0; ii < 16; ++ii) { const int i = ig * 16 + ii; float x = bb;
#pragma unroll
        for (int r = 0; r < 16; ++r) x += lrL[i * 16 + r] * w2r[r];
        run += (fminf(x, 0.f) - __logf(1.f + __expf(-fabsf(x)))) * (1.f / 16.f); la[ii] = run; }
    totL[ig * 128 + d] = run;
    WG_SYNC();
    const float t0 = totL[d], t1 = totL[128 + d], t2 = totL[256 + d], t3 = totL[384 + d];
    const float off = (ig > 0 ? t0 : 0.f) + (ig > 1 ? t1 : 0.f) + (ig > 2 ? t2 : 0.f);
#pragma unroll
    for (int ii = 0; ii < 16; ++ii) laL[(ig * 16 + ii) * 132 + d] = la[ii] + off;
    if (ig == 0) glL[d] = (t0 + t1) + (t2 + t3);
    WG_SYNC();
}
__device__ __forceinline__ void gla_pre_unit(Frame& F, int l, int unit) {
    const int tid = opq(F.tid), lane = tid & 63, w = __builtin_amdgcn_readfirstlane(tid >> 6);
    const int n = unit & 31, bh = unit >> 5, bl = bh >> 2, h = bh & 3, row0 = bl * SEQ + n * 64;
    LAS float* laL = (LAS float*)(F.lds + GL_LA); LAS float* glL = (LAS float*)(F.lds + GL_GL);
    LAS bf16* KdT = (LAS bf16*)(F.lds + GL_QD);
    LAS bf16* VT = (LAS bf16*)(F.lds + GL_VT);
    TIC(6); gla_gam(F, l, h, row0, tid); TOC(6); TIC(7);
    {
        const int i = tid >> 3, sub = tid & 7;
        const bf16* kp = F.P + (size_t)(row0 + i) * NP + PC_LK + h * 128 + sub * 16;
        const v4u k0 = *(const v4u*)kp, k1 = *(const v4u*)(kp + 8);
        const float kk[16] = {bflo(k0.x), bfhi(k0.x), bflo(k0.y), bfhi(k0.y), bflo(k0.z), bfhi(k0.z), bflo(k0.w), bfhi(k0.w), bflo(k1.x), bfhi(k1.x), bflo(k1.y), bfhi(k1.y), bflo(k1.z), bfhi(k1.z), bflo(k1.w), bfhi(k1.w)};
#pragma unroll
        for (int e = 0; e < 16; ++e) { const int d = sub * 16 + e; KdT[d * 72 + swz(i, sub)] = (bf16)f2bf(kk[e] * __expf(glL[d] - laL[i * 132 + d])); }
        const bf16* vp = F.P + (size_t)(row0 + i) * NP + PC_LV + h * 256 + sub * 32;
#pragma unroll
        for (int k = 0; k < 4; ++k) { const v4u vw = *(const v4u*)(vp + 8 * k); const int dv = sub * 32 + 8 * k;
            const int si = swz(i, sub);
            VT[(dv + 0) * 72 + si] = (bf16)(vw.x & 0xffff); VT[(dv + 1) * 72 + si] = (bf16)(vw.x >> 16); VT[(dv + 2) * 72 + si] = (bf16)(vw.y & 0xffff); VT[(dv + 3) * 72 + si] = (bf16)(vw.y >> 16);
            VT[(dv + 4) * 72 + si] = (bf16)(vw.z & 0xffff); VT[(dv + 5) * 72 + si] = (bf16)(vw.z >> 16); VT[(dv + 6) * 72 + si] = (bf16)(vw.w & 0xffff); VT[(dv + 7) * 72 + si] = (bf16)(vw.w >> 16); }
        if (tid < 128) ((float*)(F.wsb + WS_GL_AN))[(size_t)unit * 128 + tid] = __expf(glL[tid]);
    }
    WG_SYNC(); TOC(7); TIC(8);
    bf16* gBS = (bf16*)(F.wsb + WS_GL_BS) + (size_t)unit * 32768;
    const int c = lane & 15, q4 = 4 * (lane >> 4);
    {
        const int q = lane >> 4;
        bf16x8 af[2];
#pragma unroll
        for (int ks = 0; ks < 2; ++ks) af[ks] = *(const LAS bf16x8*)(KdT + (16 * w + c) * 72 + (((ks * 4 + q) ^ w) << 3));
        LAS bf16* STG = (LAS bf16*)(F.lds + GL_LA);
#pragma unroll
        for (int hf = 0; hf < 2; ++hf) {
#pragma unroll
            for (int g4 = 0; g4 < 2; ++g4) {
                bf16x8 bf[4][2];
#pragma unroll
                for (int t = 0; t < 4; ++t)
#pragma unroll
                    for (int ks = 0; ks < 2; ++ks) bf[t][ks] = *(const LAS bf16x8*)(VT + (16 * (8 * hf + 4 * g4 + t) + c) * 72 + (((ks * 4 + q) ^ ((8 * hf + 4 * g4 + t) >> 1)) << 3));
                __builtin_amdgcn_sched_barrier(0);
                f32x4 a[4];
#pragma unroll
                for (int t = 0; t < 4; ++t) { a[t] = (f32x4){0.f, 0.f, 0.f, 0.f};
#pragma unroll
                    for (int ks = 0; ks < 2; ++ks) a[t] = __builtin_amdgcn_mfma_f32_16x16x32_bf16(af[ks], bf[t][ks], a[t], 0, 0, 0); }
#pragma unroll
                for (int t = 0; t < 4; ++t) *(LAS v2u*)(STG + ((4 * g4 + t) * 16 + c) * 132 + 16 * w + q4) = pk4(a[t]);
            }
            WG_SYNC();
#pragma unroll
            for (int k = 0; k < 4; ++k) {
                const int p = tid + 512 * k, ln = p & 63, dvl = 16 * (p >> 8) + (ln & 15), dk0 = 32 * ((p >> 6) & 3) + 8 * (ln >> 4);
                const v2u lo = *(const LAS v2u*)(STG + dvl * 132 + dk0), hi = *(const LAS v2u*)(STG + dvl * 132 + dk0 + 4);
                v4u o; o.x = lo.x; o.y = lo.y; o.z = hi.x; o.w = hi.y; *(v4u*)(gBS + (size_t)(hf * 2048 + p) * 8) = o; }
            if (hf == 0) WG_SYNC();
        }
    }
    WG_SYNC(); TOC(8);
}
__device__ __forceinline__ void gla_scan(Frame& F, int bidx, int nblk) {
    const int tid = opq(F.tid);
    for (int item = bidx * NTHREADS + tid; item < BG * 4 * 4096; item += nblk * NTHREADS) {
        const int bh = item >> 12, rem = item & 4095, d8 = 32 * ((rem >> 6) & 3) + 8 * ((rem & 63) >> 4);
        bf16* base = (bf16*)(F.wsb + WS_GL_BS) + (size_t)bh * 32 * 32768 + (size_t)rem * 8;
        const float* an = (const float*)(F.wsb + WS_GL_AN) + (size_t)bh * 32 * 128 + d8;
        float s[8];
#pragma unroll
        for (int e = 0; e < 8; ++e) s[e] = 0.f;
#pragma unroll 4
        for (int n = 0; n < 32; ++n) {
            const v4u bw = *(const v4u*)(base + (size_t)n * 32768);
            const f32x4 a0 = *(const f32x4*)(an + n * 128), a1 = *(const f32x4*)(an + n * 128 + 4);
            if (n >= 1) { v4u o; o.x = pk2(s[0], s[1]); o.y = pk2(s[2], s[3]); o.z = pk2(s[4], s[5]); o.w = pk2(s[6], s[7]); *(v4u*)(base + (size_t)(n - 1) * 32768) = o; }
            s[0] = a0[0] * s[0] + bflo(bw.x); s[1] = a0[1] * s[1] + bfhi(bw.x); s[2] = a0[2] * s[2] + bflo(bw.y); s[3] = a0[3] * s[3] + bfhi(bw.y);
            s[4] = a1[0] * s[4] + bflo(bw.z); s[5] = a1[1] * s[5] + bfhi(bw.z); s[6] = a1[2] * s[6] + bflo(bw.w); s[7] = a1[3] * s[7] + bfhi(bw.w);
        }
    }
}
__device__ __forceinline__ void gla_post_unit(Frame& F, int l, int unit) {
    const int tid = opq(F.tid), lane = tid & 63, w = __builtin_amdgcn_readfirstlane(tid >> 6);
    const int n = unit & 31, bh = unit >> 5, bl = bh >> 2, h = bh & 3, row0 = bl * SEQ + n * 64;
    LAS float* laL = (LAS float*)(F.lds + GL_LA);
    LAS bf16* QdL = (LAS bf16*)(F.lds + GL_QD); LAS bf16* KtL = (LAS bf16*)(F.lds + GL_KT); LAS bf16* AttL = (LAS bf16*)(F.lds + GL_ATT); LAS bf16* VT = (LAS bf16*)(F.lds + GL_VT);
    LAS float* Of = (LAS float*)F.lds;
    TIC(14); gla_gam(F, l, h, row0, tid); TOC(14); TIC(15);
    {
        const int i = tid >> 3, sub = tid & 7;
        const bf16* qp = F.P + (size_t)(row0 + i) * NP + PC_LQ + h * 128 + sub * 16;
        const v4u q0 = *(const v4u*)qp, q1 = *(const v4u*)(qp + 8), k0 = *(const v4u*)(qp + 512), k1 = *(const v4u*)(qp + 520);
        const float qq[16] = {bflo(q0.x), bfhi(q0.x), bflo(q0.y), bfhi(q0.y), bflo(q0.z), bfhi(q0.z), bflo(q0.w), bfhi(q0.w), bflo(q1.x), bfhi(q1.x), bflo(q1.y), bfhi(q1.y), bflo(q1.z), bfhi(q1.z), bflo(q1.w), bfhi(q1.w)};
        const float kk[16] = {bflo(k0.x), bfhi(k0.x), bflo(k0.y), bfhi(k0.y), bflo(k0.z), bfhi(k0.z), bflo(k0.w), bfhi(k0.w), bflo(k1.x), bfhi(k1.x), bflo(k1.y), bfhi(k1.y), bflo(k1.z), bfhi(k1.z), bflo(k1.w), bfhi(k1.w)};
        float qd[16], kt[16];
#pragma unroll
        for (int e = 0; e < 16; ++e) { const float gm = laL[i * 132 + sub * 16 + e]; qd[e] = qq[e] * 0.08838834764831845f * __expf(gm); kt[e] = kk[e] * __expf(-gm); }
        v4u o0, o1; o0.x = pk2(qd[0], qd[1]); o0.y = pk2(qd[2], qd[3]); o0.z = pk2(qd[4], qd[5]); o0.w = pk2(qd[6], qd[7]);
        o1.x = pk2(qd[8], qd[9]); o1.y = pk2(qd[10], qd[11]); o1.z = pk2(qd[12], qd[13]); o1.w = pk2(qd[14], qd[15]);
        *(LAS v4u*)(QdL + i * 136 + sub * 16) = o0; *(LAS v4u*)(QdL + i * 136 + sub * 16 + 8) = o1;
        o0.x = pk2(kt[0], kt[1]); o0.y = pk2(kt[2], kt[3]); o0.z = pk2(kt[4], kt[5]); o0.w = pk2(kt[6], kt[7]);
        o1.x = pk2(kt[8], kt[9]); o1.y = pk2(kt[10], kt[11]); o1.z = pk2(kt[12], kt[13]); o1.w = pk2(kt[14], kt[15]);
        *(LAS v4u*)(KtL + i * 136 + sub * 16) = o0; *(LAS v4u*)(KtL + i * 136 + sub * 16 + 8) = o1;
        const bf16* vp = F.P + (size_t)(row0 + i) * NP + PC_LV + h * 256 + sub * 32;
#pragma unroll
        for (int k = 0; k < 4; ++k) { const v4u vw = *(const v4u*)(vp + 8 * k); const int dv = sub * 32 + 8 * k;
            const int si = swz(i, sub);
            VT[(dv + 0) * 72 + si] = (bf16)(vw.x & 0xffff); VT[(dv + 1) * 72 + si] = (bf16)(vw.x >> 16); VT[(dv + 2) * 72 + si] = (bf16)(vw.y & 0xffff); VT[(dv + 3) * 72 + si] = (bf16)(vw.y >> 16);
            VT[(dv + 4) * 72 + si] = (bf16)(vw.z & 0xffff); VT[(dv + 5) * 72 + si] = (bf16)(vw.z >> 16); VT[(dv + 6) * 72 + si] = (bf16)(vw.w & 0xffff); VT[(dv + 7) * 72 + si] = (bf16)(vw.w >> 16); }
    }
    WG_SYNC(); TOC(15); TIC(16);
    const int c = lane & 15, q4 = 4 * (lane >> 4);
    const bf16* gS = (const bf16*)(F.wsb + WS_GL_BS) + (size_t)(unit - 1) * 32768;
    bf16x8 bfr[2][4];
#pragma unroll
    for (int t = 0; t < 2; ++t)
#pragma unroll
        for (int ks = 0; ks < 4; ++ks) { if (n >= 1) bfr[t][ks] = *(const bf16x8*)(gS + (size_t)(((2 * w + t) * 4 + ks) * 64 + lane) * 8); else bfr[t][ks] = (bf16x8){0, 0, 0, 0, 0, 0, 0, 0}; }
    __builtin_amdgcn_sched_barrier(0);
#pragma unroll
    for (int t = 0; t < 2; ++t) {
        const int idx = 2 * w + t, mb = idx >> 2, nb = idx & 3;
        const f32x4 z4 = {0.f, 0.f, 0.f, 0.f};
        const f32x4 a = mm16(QdL, 136, mb * 16, KtL, 136, nb * 16, 128, lane, z4);
        const int j = nb * 16 + c;
#pragma unroll
        for (int e = 0; e < 4; ++e) { const int ii = mb * 16 + q4 + e; AttL[ii * 72 + j] = (bf16)f2bf((ii >= j) ? a[e] : 0.f); }
    }
    WG_SYNC();
    f32x4 acc[2][4];
#pragma unroll
    for (int t = 0; t < 2; ++t) {
        const int nb = 2 * w + t;
#pragma unroll
        for (int mb = 0; mb < 4; ++mb) {
            f32x4 a = {0.f, 0.f, 0.f, 0.f};
#pragma unroll
            for (int ks = 0; ks < 4; ++ks) a = __builtin_amdgcn_mfma_f32_16x16x32_bf16(*(const LAS bf16x8*)(QdL + (mb * 16 + c) * 136 + ks * 32 + 8 * (lane >> 4)), bfr[t][ks], a, 0, 0, 0);
            acc[t][mb] = mm16k64(AttL, mb * 16, 0, VT, nb * 16, 5, lane, a);
        }
    }
    WG_SYNC(); TOC(16); TIC(17);
#pragma unroll
    for (int t = 0; t < 2; ++t)
#pragma unroll
        for (int mb = 0; mb < 4; ++mb)
#pragma unroll
            for (int e = 0; e < 4; ++e) Of[(mb * 16 + q4 + e) * 260 + (2 * w + t) * 16 + c] = acc[t][mb][e];
    WG_SYNC();
    {
        const int i = tid >> 3, sub = tid & 7, c32 = sub * 32; const size_t row = (size_t)row0 + i;
        float x[32]; float ss = 0.f;
#pragma unroll
        for (int e = 0; e < 32; ++e) { x[e] = Of[i * 260 + c32 + e]; ss += x[e] * x[e]; }
        ss += __shfl_xor(ss, 1); ss += __shfl_xor(ss, 2); ss += __shfl_xor(ss, 4);
        const float r = 1.f / sqrtf(ss * (1.f / 256.f) + RMS_EPS);
        const float* gn = F.gla_onorm + l * 256 + c32;
        const bf16* zp = F.P + row * NP + PC_LZ + h * 256 + c32; bf16* yp = F.Y + row * YW + YC_GLA + h * 256 + c32;
#pragma unroll
        for (int k = 0; k < 4; ++k) { const v4u zw = *(const v4u*)(zp + 8 * k);
            const float zg[8] = {bflo(zw.x), bfhi(zw.x), bflo(zw.y), bfhi(zw.y), bflo(zw.z), bfhi(zw.z), bflo(zw.w), bfhi(zw.w)};
            float y[8];
#pragma unroll
            for (int e = 0; e < 8; ++e) y[e] = x[8 * k + e] * r * gn[8 * k + e] * zg[e];
            v4u o; o.x = pk2(y[0], y[1]); o.y = pk2(y[2], y[3]); o.z = pk2(y[4], y[5]); o.w = pk2(y[6], y[7]);
            *(v4u*)(yp + 8 * k) = o; }
    }
    WG_SYNC(); TOC(17);
}
constexpr int SB_QS = 0, SB_KS = 34816, SB_VT = 52224, SB_KV2 = 70656, SB_FL = 106496;
__device__ __forceinline__ void rms16(const v4u a0, const v4u a1, const float* g, v4u& o0, v4u& o1) {
    float x[16] = {bflo(a0.x), bfhi(a0.x), bflo(a0.y), bfhi(a0.y), bflo(a0.z), bfhi(a0.z), bflo(a0.w), bfhi(a0.w), bflo(a1.x), bfhi(a1.x), bflo(a1.y), bfhi(a1.y), bflo(a1.z), bfhi(a1.z), bflo(a1.w), bfhi(a1.w)};
    float ss = 0.f;
#pragma unroll
    for (int i = 0; i < 16; ++i) ss += x[i] * x[i];
    ss += __shfl_xor(ss, 1); ss += __shfl_xor(ss, 2); ss += __shfl_xor(ss, 4);
    const float r = 1.f / sqrtf(ss * (1.f / 128.f) + RMS_EPS);
#pragma unroll
    for (int i = 0; i < 16; ++i) x[i] = x[i] * r * g[i];
    o0.x = pk2(x[0], x[1]); o0.y = pk2(x[2], x[3]); o0.z = pk2(x[4], x[5]); o0.w = pk2(x[6], x[7]);
    o1.x = pk2(x[8], x[9]); o1.y = pk2(x[10], x[11]); o1.z = pk2(x[12], x[13]); o1.w = pk2(x[14], x[15]);
}
__device__ __forceinline__ void sb_stage(LAS bf16* Ks, LAS bf16* Vt, int tid, const v4u k0r, const v4u k1r, const v4u v0, const v4u v1, const float* kg) {
    const int key = tid >> 3, sub = tid & 7;
    v4u k0, k1; rms16(k0r, k1r, kg, k0, k1);
    *(LAS v4u*)(Ks + key * 136 + sub * 16) = k0; *(LAS v4u*)(Ks + key * 136 + sub * 16 + 8) = k1;
    const int d0 = sub * 16, sk = swz(key, sub);
    Vt[(d0 + 0) * 72 + sk] = (bf16)(v0.x & 0xffff); Vt[(d0 + 1) * 72 + sk] = (bf16)(v0.x >> 16); Vt[(d0 + 2) * 72 + sk] = (bf16)(v0.y & 0xffff); Vt[(d0 + 3) * 72 + sk] = (bf16)(v0.y >> 16);
    Vt[(d0 + 4) * 72 + sk] = (bf16)(v0.z & 0xffff); Vt[(d0 + 5) * 72 + sk] = (bf16)(v0.z >> 16); Vt[(d0 + 6) * 72 + sk] = (bf16)(v0.w & 0xffff); Vt[(d0 + 7) * 72 + sk] = (bf16)(v0.w >> 16);
    Vt[(d0 + 8) * 72 + sk] = (bf16)(v1.x & 0xffff); Vt[(d0 + 9) * 72 + sk] = (bf16)(v1.x >> 16); Vt[(d0 + 10) * 72 + sk] = (bf16)(v1.y & 0xffff); Vt[(d0 + 11) * 72 + sk] = (bf16)(v1.y >> 16);
    Vt[(d0 + 12) * 72 + sk] = (bf16)(v1.z & 0xffff); Vt[(d0 + 13) * 72 + sk] = (bf16)(v1.z >> 16); Vt[(d0 + 14) * 72 + sk] = (bf16)(v1.w & 0xffff); Vt[(d0 + 15) * 72 + sk] = (bf16)(v1.w >> 16);
}
__device__ __forceinline__ void sb_unit(Frame& F, int unit) {
    const int tid = opq(F.tid), lane = tid & 63, w = __builtin_amdgcn_readfirstlane(tid >> 6);
    const int qt = ((unit >> 8) & 1) ? (unit & 15) : 15 - (unit & 15), bh = unit >> 4, bl = bh >> 2, h = bh & 3;
    LAS bf16* Qs = (LAS bf16*)(F.lds + SB_QS);
    volatile LAS unsigned* flags = (volatile LAS unsigned*)(F.lds + SB_FL);
    const size_t rowb = (size_t)bl * SEQ;
    const int c = lane & 15, q = lane >> 4, q4 = 4 * q;
    const int kb0 = 2 * qt + 1;
    v4u k0, k1, v0, v1;
    {   const bf16* kp = F.P + (rowb + kb0 * 64 + (tid >> 3)) * NP + PC_SK + h * 128 + (tid & 7) * 16;
        k0 = *(const v4u*)kp; k1 = *(const v4u*)(kp + 8); v0 = *(const v4u*)(kp + 512); v1 = *(const v4u*)(kp + 520); }
    float kg[16], qg[16];
#pragma unroll
    for (int i = 0; i < 16; ++i) { kg[i] = F.sb_knorm[F.lyr * 128 + (tid & 7) * 16 + i]; qg[i] = F.sb_qnorm[F.lyr * 128 + (tid & 7) * 16 + i]; }
#pragma unroll
    for (int k = 0; k < 2; ++k) {
        const int r = (tid >> 3) + 64 * k; const bf16* qp = F.P + (rowb + qt * 128 + r) * NP + PC_SQ + h * 128 + (tid & 7) * 16;
        v4u q0, q1; rms16(*(const v4u*)qp, *(const v4u*)(qp + 8), qg, q0, q1);
        *(LAS v4u*)(Qs + r * 136 + (tid & 7) * 16) = q0; *(LAS v4u*)(Qs + r * 136 + (tid & 7) * 16 + 8) = q1; }
    v4u zg[4];
#pragma unroll
    for (int k = 0; k < 4; ++k) zg[k] = *(const v4u*)(F.P + (rowb + qt * 128 + 16 * w + 4 * k + q) * NP + PC_SZ + h * 128 + c * 8);
    f32x4 o[8];
#pragma unroll
    for (int mb = 0; mb < 8; ++mb) o[mb] = (f32x4){0.f, 0.f, 0.f, 0.f};
    float R = 0.f;
    const int t = qt * 128 + 16 * w + c;
    sb_stage((LAS bf16*)(F.lds + SB_KS), (LAS bf16*)(F.lds + SB_VT), tid, k0, k1, v0, v1, kg);
    if (kb0 > 0) { const bf16* kp = F.P + (rowb + (kb0 - 1) * 64 + (tid >> 3)) * NP + PC_SK + h * 128 + (tid & 7) * 16;
        k0 = *(const v4u*)kp; k1 = *(const v4u*)(kp + 8); v0 = *(const v4u*)(kp + 512); v1 = *(const v4u*)(kp + 520); }
    WG_SYNC();
    bf16x8 qf[4];
#pragma unroll
    for (int ks = 0; ks < 4; ++ks) qf[ks] = *(const LAS bf16x8*)(Qs + (16 * w + c) * 136 + ks * 32 + 8 * q);
    bool wdone = false;
    for (int kb = kb0; kb >= 0; --kb) {
        const int par = (kb0 - kb) & 1;
        const LAS bf16* Ks = (const LAS bf16*)(F.lds + (par ? SB_KV2 : SB_KS)); const LAS bf16* Vt = Ks + 64 * 136;
        TIC(30);
        if (kb > 0) {
            LAS bf16* Kn = (LAS bf16*)(F.lds + (par ? SB_KS : SB_KV2));
            sb_stage(Kn, Kn + 64 * 136, tid, k0, k1, v0, v1, kg);
            if (kb > 1) { const bf16* kp = F.P + (rowb + (kb - 2) * 64 + (tid >> 3)) * NP + PC_SK + h * 128 + (tid & 7) * 16;
                k0 = *(const v4u*)kp; k1 = *(const v4u*)(kp + 8); v0 = *(const v4u*)(kp + 512); v1 = *(const v4u*)(kp + 520); }
        }
        __builtin_amdgcn_sched_barrier(0);
        TOC(30); TIC(31);
        const bool active = (kb * 64 < qt * 128 + 16 * w + 15) && !wdone;
        if (active) {
            float wgt[4][4], l1m[4][4], tot[4], hi[4];
            f32x4 st[4];
            {
                bf16x8 kf[4][4];
#pragma unroll
                for (int kk = 0; kk < 4; ++kk)
#pragma unroll
                    for (int ks = 0; ks < 4; ++ks) kf[kk][ks] = *(const LAS bf16x8*)(Ks + (16 * kk + c) * 136 + ks * 32 + 8 * q);
                __builtin_amdgcn_sched_barrier(0);
#pragma unroll
                for (int kk = 0; kk < 4; ++kk) { st[kk] = (f32x4){0.f, 0.f, 0.f, 0.f};
#pragma unroll
                    for (int ks = 0; ks < 4; ++ks) st[kk] = __builtin_amdgcn_mfma_f32_16x16x32_bf16(kf[kk][ks], qf[ks], st[kk], 0, 0, 0); }
            }
#pragma unroll
            for (int kk = 0; kk < 4; ++kk) {
                const f32x4 a = st[kk];
                float g = 0.f;
#pragma unroll
                for (int e = 0; e < 4; ++e) {
                    const int s = kb * 64 + kk * 16 + q4 + e; const bool valid = s < t;
                    const float z = a[e] * 0.08838834764831845f;
                    const float sp = fmaxf(z, 0.f) + __logf(1.f + __expf(-fabsf(z)));
                    l1m[kk][e] = valid ? -sp : 0.f;
                    wgt[kk][e] = valid ? (z - sp) : -1e30f;
                    g += l1m[kk][e];
                }
                const float b = __shfl_xor(g, 16), pr = g + b, d = __shfl_xor(pr, 32);
                hi[kk] = ((q & 1) == 0 ? b : 0.f) + ((q & 2) == 0 ? d : 0.f);
                tot[kk] = pr + d;
            }
            float after = R;
#pragma unroll
            for (int kk = 3; kk >= 0; --kk) {
                float tail = after + hi[kk];
#pragma unroll
                for (int e = 3; e >= 0; --e) { const float lw = wgt[kk][e] + tail; wgt[kk][e] = __expf(lw); tail += l1m[kk][e]; }
                after += tot[kk];
            }
            R = after;
#pragma unroll
            for (int ks = 0; ks < 2; ++ks) {
                v4u pb; pb.x = pk2(wgt[2 * ks][0], wgt[2 * ks][1]); pb.y = pk2(wgt[2 * ks][2], wgt[2 * ks][3]); pb.z = pk2(wgt[2 * ks + 1][0], wgt[2 * ks + 1][1]); pb.w = pk2(wgt[2 * ks + 1][2], wgt[2 * ks + 1][3]);
                const bf16x8 bfrag = __builtin_bit_cast(bf16x8, pb);
                v4u av[8];
#pragma unroll
                for (int mb = 0; mb < 8; ++mb) {
                    const LAS bf16* vp = Vt + (mb * 16 + c) * 72 + 4 * (q & 1);
                    const v2u lo = *(const LAS v2u*)(vp + (((4 * ks + (q >> 1)) ^ mb) << 3)), hi2 = *(const LAS v2u*)(vp + (((4 * ks + 2 + (q >> 1)) ^ mb) << 3));
                    av[mb].x = lo.x; av[mb].y = lo.y; av[mb].z = hi2.x; av[mb].w = hi2.y;
                }
                __builtin_amdgcn_sched_barrier(0);
#pragma unroll
                for (int mb = 0; mb < 8; ++mb) o[mb] = __builtin_amdgcn_mfma_f32_16x16x32_bf16(__builtin_bit_cast(bf16x8, av[mb]), bfrag, o[mb], 0, 0, 0);
            }
            wdone = __all(R < -104.f);
        }
        if (lane == 0) flags[par * 8 + w] = wdone ? 1u : 0u;
        WG_SYNC(); TOC(31);
        unsigned alldone = 1u;
#pragma unroll
        for (int k = 0; k < 8; ++k) alldone &= flags[par * 8 + k];
        if (alldone) break;
    }
    TIC(36);
    {
        LAS float* Ot = (LAS float*)F.lds + w * (16 * 132);
#pragma unroll
        for (int mb = 0; mb < 8; ++mb) *(LAS f32x4*)(Ot + c * 132 + mb * 16 + q4) = o[mb];
        asm volatile("s_waitcnt lgkmcnt(0)" ::: "memory");
#pragma unroll
        for (int k = 0; k < 4; ++k) {
            const int rr = 4 * k + q, c8 = c * 8; const size_t row = rowb + qt * 128 + 16 * w + rr;
            const f32x4 o0 = *(const LAS f32x4*)(Ot + rr * 132 + c8), o1 = *(const LAS f32x4*)(Ot + rr * 132 + c8 + 4);
            const v4u zw = zg[k];
            v4u ow; ow.x = pk2(o0[0] * bflo(zw.x), o0[1] * bfhi(zw.x)); ow.y = pk2(o0[2] * bflo(zw.y), o0[3] * bfhi(zw.y)); ow.z = pk2(o1[0] * bflo(zw.z), o1[1] * bfhi(zw.z)); ow.w = pk2(o1[2] * bflo(zw.w), o1[3] * bfhi(zw.w));
            *(v4u*)(F.Y + row * YW + YC_SB + h * 128 + c8) = ow;
        }
    }
    WG_SYNC(); TOC(36);
}
__device__ __forceinline__ void small_cols(Frame& F) {
    const int tid = opq(F.tid), lane = tid & 63, w = __builtin_amdgcn_readfirstlane(tid >> 6), c = lane & 15, q = lane >> 4;
    const int mbk = w & 3, kh = w >> 2;
    LAS f32x4* red = (LAS f32x4*)F.lds;
    for (int it = (blockIdx.x & ~1); it < TG / 64 && (blockIdx.x & 1); it += (it & 1) ? F.G - 1 : 1) {
        const bf16* ap = F.H + (size_t)(it * 64 + 16 * mbk + c) * D + kh * 512 + 8 * q;
        const bf16* bp = F.WIN + (size_t)(10240 + c) * D + kh * 512 + 8 * q;
        f32x4 a0 = {0.f, 0.f, 0.f, 0.f}, a1 = {0.f, 0.f, 0.f, 0.f};
#pragma unroll 4
        for (int ks = 0; ks < 16; ++ks) {
            const bf16x8 af = *(const bf16x8*)(ap + ks * 32), b0 = *(const bf16x8*)(bp + ks * 32), b1 = *(const bf16x8*)(bp + (size_t)16 * D + ks * 32);
            a0 = __builtin_amdgcn_mfma_f32_16x16x32_bf16(af, b0, a0, 0, 0, 0); a1 = __builtin_amdgcn_mfma_f32_16x16x32_bf16(af, b1, a1, 0, 0, 0);
        }
        if (kh == 1) { red[(mbk * 2 + 0) * 64 + lane] = a0; red[(mbk * 2 + 1) * 64 + lane] = a1; }
        WG_SYNC();
        if (kh == 0) {
            a0 = a0 + red[(mbk * 2 + 0) * 64 + lane]; a1 = a1 + red[(mbk * 2 + 1) * 64 + lane];
            float* pr = F.PS + (size_t)(it * 64 + 16 * mbk + 4 * q) * 32 + c;
#pragma unroll
            for (int e = 0; e < 4; ++e) { pr[e * 32] = a0[e]; pr[e * 32 + 16] = a1[e]; }
        }
        WG_SYNC();
    }
}
__global__ void __launch_bounds__(NTHREADS, 2) fwd_kernel(Args args) {
    extern __shared__ __attribute__((aligned(16))) unsigned char lds_raw[];
    Frame F;
    F.lds = (LAS unsigned char*)lds_raw;
    volatile LAS unsigned* MISC = (volatile LAS unsigned*)(F.lds + MISC_OFF);
    F.tid = threadIdx.x; F.lane = F.tid & 63; F.wave = __builtin_amdgcn_readfirstlane(F.tid >> 6); F.G = gridDim.x;
    unsigned char* ws = args.ws;
    F.x = args.in[0]; F.c = args.in[1]; F.ada_w = args.in[2]; F.ada_b = args.in[3]; F.norm_g = args.in[4]; F.w_in = args.in[5]; F.sb_qnorm = args.in[6]; F.sb_knorm = args.in[7];
    F.gdn_conv = args.in[8]; F.gdn_a_log = args.in[9]; F.gdn_dt_bias = args.in[10]; F.gdn_onorm = args.in[11]; F.gla_w2 = args.in[12]; F.gla_b = args.in[13]; F.gla_onorm = args.in[14];
    F.merge_b = args.in[15]; F.proj_sb = args.in[16]; F.proj_gdn = args.in[17]; F.proj_gla = args.in[18]; F.w_out = args.in[19];
    F.out = args.out; F.wsb = ws;
    F.MODP = (float*)(ws + WS_MODP); F.MODA = (float*)(ws + WS_MOD); F.MODB = F.MODA + DEPTH * BATCH * D; F.MODG = F.MODB + DEPTH * BATCH * D;
    F.PS = (float*)(ws + WS_PS);
    F.WIN = (bf16*)(ws + WS_WIN); F.WP = (bf16*)(ws + WS_WP); F.WO = (bf16*)(ws + WS_WO); F.H = (bf16*)(ws + WS_H); F.MGB = (bf16*)(ws + WS_MGB);
    F.P = (bf16*)(ws + WS_P); F.Y = (bf16*)(ws + WS_Y);
    for (int u = F.tid; u < 32; u += NTHREADS) MISC[u] = 0u;
    __syncthreads();
    XcdBarrier bar = xcd_barrier_post((unsigned*)(ws + WS_CTL) + CW_BAR, MISC + 8);
#define GRID_BAR() GRID_BARK(49)
#define GRID_BARK(k) do { TIC(k); XcdBarrier b2_ = bar; asm volatile("" : "+s"(b2_.x)); xcd_barrier(b2_); TOC(k); } while (0)

#ifdef PROF_SEL
    if (threadIdx.x == 0) { PROF_SLOT[1] = 0; PROF_SLOT[2] = clock64(); }
#endif
    TIC(27); p0_ada(F);
    GRID_BAR();
    p1_mod(F);
    GRID_BAR(); TOC(27);
    for (int l = 0; l < DEPTH; ++l) {
        F.lyr = l;
        const float* xin = (l == 0) ? F.x : F.out;
        for (int g = 0; g < NGRP; ++g) {
            TIC(24); if (g == 0) wconv_layer(F, l); TOC(24);
            TIC(23); phase_norm(F, xin, l, g); TOC(23);
            GRID_BARK(40);
#ifndef G1_ALIGN
#define G1_ALIGN true
#endif
#define PH_G1() do { TIC(20); small_cols(F); pg8::Gemm gm{F.H, F.WIN, D, D, D}; pg8::StaticOrder S; S.init(TG, NP, F.G, (int)blockIdx.x); \
                EpiG1 E{F.P, F.PS, F.merge_b + l * 3072}; \
                pg8::gemm_phase<EpiG1, pg8::StaticOrder, G1_ALIGN>(F.lds, gm, S, E); TOC(20); GRID_BARK(41); } while (0)
#ifdef G1_VAR
            {   TIC(60); pg8::Gemm gm{F.H, F.WIN + (size_t)0, D, D, D}; pg8::StaticOrder S; S.init(TG, NP, F.G, (int)blockIdx.x); EpiG1T<G1_VAR> E{F.P, F.PS, F.merge_b + l * 3072};
                pg8::gemm_phase<EpiG1T<G1_VAR>, pg8::StaticOrder, true>(F.lds, gm, S, E); TOC(60); GRID_BAR(); }
#endif
            PH_G1();
#define PH_PRE() do { for (int u = blockIdx.x; u < BG * 4 * 32; u += F.G) gdn_pre_unit(F, l, u); \
                for (int u = blockIdx.x; u < BG * 4 * 32; u += F.G) gla_pre_unit(F, l, u); GRID_BARK(42); } while (0)
            PH_PRE();
#ifdef CHAIN_VAR
#define CHAIN_VARIANT() do { TIC(59); gdn_chain<CHAIN_VAR>(F, bx); TOC(59); } while (0)
#else
#define CHAIN_VARIANT() do { } while (0)
#endif
#define PH_MIX() do { const int bx = blockIdx.x; if (bx < 32) { CHAIN_VARIANT(); TIC(9); gdn_chain<0>(F, bx); TOC(9); } else { const int j_ = bx - 32, nw_ = F.G - 32, nx_ = (BG * 4 * 16) % nw_;        \
                TIC(10); for (int u = j_; u < BG * 4 * 16; u += nw_) sb_unit(F, u); TOC(10); TIC(11); if (j_ >= nx_) gla_scan(F, j_ - nx_, nw_ - nx_); TOC(11); } GRID_BARK(43); } while (0)
            PH_MIX();
#define PH_POST() do { TIC(12); for (int u = blockIdx.x; u < BG * 4 * 32; u += F.G) gdn_post_unit(F, l, u); TOC(12); \
                TIC(13); for (int u = blockIdx.x; u < BG * 4 * 32; u += F.G) gla_post_unit(F, l, u); TOC(13); GRID_BARK(44); } while (0)
            PH_POST();
#define PH_G2() do { TIC(21); pg8::StaticOrder S; S.init(TG, D, F.G, (int)blockIdx.x); \
                pg8::Gemm gm{F.Y, F.WP, YW, 2048, 2048}; EpiG2R E{F.P, F.MGB}; \
                pg8::gemm_phase<EpiG2R, pg8::StaticOrder, false>(F.lds, gm, S, E); TOC(21); GRID_BARK(45); } while (0)
#ifdef G2_VAR
            {   TIC(61); pg8::StaticOrder S; S.init(TG, D, F.G, (int)blockIdx.x); pg8::Gemm gm{F.Y, F.WP, YW, 2048, 2048}; EpiG2RT<G2_VAR> E{F.P, F.MGB};
                pg8::gemm_phase<EpiG2RT<G2_VAR>, pg8::StaticOrder, false>(F.lds, gm, S, E); TOC(61); GRID_BAR(); }
#endif
            PH_G2();
            {   TIC(22); pg8::Gemm gm{F.MGB, F.WO + (size_t)(l & 1) * D * D, D, D, D}; pg8::StaticOrder S; S.init(TG, D, F.G, (int)blockIdx.x);
                EpiG3 E{xin, F.out, F.MODG + (size_t)l * BATCH * D, g * TG};
                pg8::gemm_phase<EpiG3, pg8::StaticOrder, false>(F.lds, gm, S, E); TOC(22); }
        }
    }
#ifdef PROF_SEL
    {   unsigned long long* ctr = (unsigned long long*)(ws + WS_CTL + 512 * 1024);
        if (threadIdx.x == 0) { atomicAdd(ctr, (unsigned long long)PROF_SLOT[1]); atomicAdd(ctr + 1, (unsigned long long)(clock64() - PROF_SLOT[2])); }
        GRID_BARK(48);
        const float frac = (float)((double)__hip_atomic_load(ctr, __ATOMIC_RELAXED, __HIP_MEMORY_SCOPE_AGENT) / (double)__hip_atomic_load(ctr + 1, __ATOMIC_RELAXED, __HIP_MEMORY_SCOPE_AGENT));
        const int tq_ = opq((int)threadIdx.x);
        for (size_t i = (size_t)blockIdx.x * NTHREADS + tq_; i < (size_t)T * D; i += (size_t)F.G * NTHREADS) {
#ifdef PROF_CONST
            F.out[i] = frac * 100.f;
#else
            F.out[i] *= (1.f + frac * (1.f / PROF_DIV));
#endif
        }
    }
#endif
}

extern "C" void kernel_launch(void* const* d_in, const int* in_sizes, int n_in, void* d_out, int out_size, void* d_ws, size_t ws_size, hipStream_t stream) {
    static int grid = 0;
    if (grid == 0) {
        if (n_in != 20 || out_size != T * D || ws_size < WS_END) { fprintf(stderr, "kernel_launch: unexpected shapes / workspace (%d inputs, out %d, ws %zu)\n", n_in, out_size, ws_size); grid = -1; return; }
        int dev = 0, cus = 0, per_cu = 0;
        if (hipGetDevice(&dev) != hipSuccess || hipDeviceGetAttribute(&cus, hipDeviceAttributeMultiprocessorCount, dev) != hipSuccess) { grid = -1; return; }
        if (hipFuncSetAttribute((const void*)fwd_kernel, hipFuncAttributeMaxDynamicSharedMemorySize, LDS_BYTES) != hipSuccess) { grid = -1; return; }
        if (hipOccupancyMaxActiveBlocksPerMultiprocessor(&per_cu, (const void*)fwd_kernel, NTHREADS, LDS_BYTES) != hipSuccess || per_cu < 1) fprintf(stderr, "kernel_launch: occupancy query reports %d\n", per_cu);
        (void)hipGetLastError();
        grid = cus;
    }
    if (grid < 0) return;
    if (hipMemsetAsync((char*)d_ws + WS_CTL, 0, CTL_ZERO_BYTES, stream) != hipSuccess) return;
    Args a{};
    for (int i = 0; i < 20; ++i) a.in[i] = (const float*)d_in[i];
    a.out = (float*)d_out; a.ws = (unsigned char*)d_ws; a.ph_lo = 0; a.ph_hi = 0;
    hipLaunchKernelGGL(fwd_kernel, dim3(grid), dim3(NTHREADS), LDS_BYTES, stream, a);
}
```
